# Optimizing an MI355X kernel written in HIP

```python
import jax, jax.numpy as jnp
from jax import lax
import numpy as np

D_MODEL = 1024
BATCH = 8
SEQ = 2048
DEPTH = 1
DEC_BATCH = 128
DEC_SEQ = 1
PAST_LEN = 16384
PAGE_SIZE = 128

SSM_EXPAND = 2
D_INNER = SSM_EXPAND * D_MODEL
SSM_HEADDIM = 64
SSM_HEADS = D_INNER // SSM_HEADDIM
SSM_GROUPS = 8
SSM_HPG = SSM_HEADS // SSM_GROUPS
SSM_STATE = 128
CONV_WIDTH = 4
CONV_DIM = D_INNER + 2 * SSM_GROUPS * SSM_STATE
SSD_CHUNK = 128
RWKV_DIM = D_MODEL
RWKV_HEADSIZE = 64
RWKV_HEADS = RWKV_DIM // RWKV_HEADSIZE
DECAY_LORA = 64
AAA_LORA = 64
GATE_LORA = 128
SHIFT_DIM = 3 * RWKV_DIM + DECAY_LORA + AAA_LORA + GATE_LORA
LN_X_EPS = 64e-5
IN_DIM = D_INNER + CONV_DIM + SSM_HEADS + SHIFT_DIM + 2 * D_MODEL
PEER_HEADS = 8
N_KEYS = 128
N_EXPERTS = N_KEYS * N_KEYS
PEER_QDIM = 256
PEER_TOPK = 16
PEER_BLOCK = 128
PLE_DIM = 256
EPS = 1e-6

kernel_name = 'hybrid_ssd_rwkv7_peer_step'


def rmsnorm(x, g):
    xf = x.astype(jnp.float32)
    y = xf * lax.rsqrt(jnp.mean(xf * xf, axis=-1, keepdims=True) + EPS)
    return (y * g.astype(jnp.float32)).astype(x.dtype)


def grouped_rmsnorm(x, g, n_groups):
    shp = x.shape
    xf = x.astype(jnp.float32).reshape(shp[:-1] + (n_groups, shp[-1] // n_groups))
    y = xf * lax.rsqrt(jnp.mean(xf * xf, axis=-1, keepdims=True) + EPS)
    return (y.reshape(shp) * g.astype(jnp.float32)).astype(x.dtype)


def split_proj(u):
    sizes = (D_INNER, CONV_DIM, SSM_HEADS, SHIFT_DIM, D_MODEL, D_MODEL)
    return jnp.split(u, np.cumsum(sizes)[:-1].tolist(), axis=-1)


def causal_conv(xbc, conv_prev, w, b):
    l = xbc.shape[1]
    full = jnp.concatenate([conv_prev, xbc], axis=1)
    out = b + sum(full[:, k:k + l] * w[k] for k in range(CONV_WIDTH))
    return jax.nn.silu(out), full[:, -(CONV_WIDTH - 1):]


def ssd_scan(xh, dt, a, bm, cm, h0, chunk):
    b, l = xh.shape[:2]
    c = l // chunk
    rs = lambda t: t.reshape((b, c, chunk) + t.shape[2:])
    xh, dt, bm, cm = rs(xh), rs(dt), rs(bm), rs(cm)
    a_cum = jnp.cumsum(dt * a, axis=2)
    seg = a_cum[:, :, :, None] - a_cum[:, :, None, :]
    causal = jnp.tril(jnp.ones((chunk, chunk), bool))[:, :, None, None]
    lmat = jnp.exp(jnp.where(causal, seg, -jnp.inf))
    cb = jnp.einsum('bclgn,bcsgn->bclsg', cm, bm)
    m = cb[..., None] * lmat * dt[:, :, None]
    y_diag = jnp.einsum('bclsgr,bcsgrp->bclgrp', m, xh)
    decay_out = jnp.exp(a_cum[:, :, -1:] - a_cum)
    states = jnp.einsum('bcsgn,bcsgr,bcsgrp->bcgrpn', bm, decay_out * dt, xh)
    chunk_decay = jnp.exp(a_cum[:, :, -1])

    def step(h, inp):
        st, dec = inp
        return h * dec[..., None, None] + st, h

    h_last, h_prev = lax.scan(step, h0.astype(states.dtype),
                              (jnp.moveaxis(states, 1, 0), jnp.moveaxis(chunk_decay, 1, 0)))
    h_prev = jnp.moveaxis(h_prev, 0, 1)
    y_off = jnp.einsum('bclgn,bcgrpn,bclgr->bclgrp', cm, h_prev, jnp.exp(a_cum))
    y = (y_diag + y_off).reshape((b, l) + y_diag.shape[3:])
    return y, h_last


def mamba_branch(z, xbc_raw, dt_raw, conv_prev, ssm_prev, conv_w, conv_b, dt_bias, a_log,
                 d_skip, ssm_norm, w_out_ssm):
    b, l, _ = z.shape
    xbc, conv_new = causal_conv(xbc_raw, conv_prev, conv_w, conv_b)
    xs, bm, cm = jnp.split(xbc, [D_INNER, D_INNER + SSM_GROUPS * SSM_STATE], axis=-1)
    xh = xs.reshape(b, l, SSM_GROUPS, SSM_HPG, SSM_HEADDIM)
    bm = bm.reshape(b, l, SSM_GROUPS, SSM_STATE)
    cm = cm.reshape(b, l, SSM_GROUPS, SSM_STATE)
    dt = jax.nn.softplus(dt_raw + dt_bias).reshape(b, l, SSM_GROUPS, SSM_HPG)
    a = -jnp.exp(a_log).reshape(SSM_GROUPS, SSM_HPG)
    h0 = ssm_prev.reshape(b, SSM_GROUPS, SSM_HPG, SSM_HEADDIM, SSM_STATE)
    chunk = SSD_CHUNK if l % SSD_CHUNK == 0 else l
    y, h_last = ssd_scan(xh, dt, a, bm, cm, h0, chunk)
    y = (y + xh * d_skip.reshape(SSM_GROUPS, SSM_HPG, 1)).reshape(b, l, D_INNER)
    y = grouped_rmsnorm(y * jax.nn.silu(z), ssm_norm, SSM_GROUPS)
    return y @ w_out_ssm, conv_new, h_last.reshape(b, SSM_HEADS, SSM_HEADDIM, SSM_STATE)


def wkv_scan(r, decay, k, v, a_vec, b_vec, s0):
    def step(s, inp):
        rt, wt, kt, vt, at, bt = inp
        s = (s * wt[:, :, None, :]
             + jnp.einsum('bhvk,bhk->bhv', s, at)[..., None] * bt[:, :, None, :]
             + vt[..., None] * kt[:, :, None, :])
        return s, jnp.einsum('bhvk,bhk->bhv', s, rt)

    seqs = tuple(jnp.moveaxis(t, 1, 0) for t in (r, decay, k, v, a_vec, b_vec))
    s_last, ys = lax.scan(step, s0.astype(r.dtype), seqs)
    return jnp.moveaxis(ys, 0, 1), s_last


def rwkv_branch(proj, shift_prev, wkv_prev, shift_mu, decay_w0, decay_w2, aaa_a0, aaa_a2,
                gate_g2, k_k, k_a, r_k, lnx_g, lnx_b, w_out_rwkv):
    b, l, _ = proj.shape
    prev = jnp.concatenate([shift_prev[:, None, :], proj[:, :-1]], axis=1)
    xs = proj + (prev - proj) * shift_mu
    offs = np.cumsum((RWKV_DIM, RWKV_DIM, RWKV_DIM, DECAY_LORA, AAA_LORA)).tolist()
    r, k, v, xw, xa, xg = jnp.split(xs, offs, axis=-1)
    w = -jax.nn.softplus(-(decay_w0 + jnp.tanh(xw) @ decay_w2)) - 0.5
    a = jax.nn.sigmoid(aaa_a0 + xa @ aaa_a2)
    g = jax.nn.sigmoid(xg) @ gate_g2
    hs = lambda t: t.reshape(b, l, RWKV_HEADS, RWKV_HEADSIZE)
    r, w, k, v, a = hs(r), hs(w), hs(k), hs(v), hs(a)
    kkf = (k * k_k).astype(jnp.float32)
    kk = (kkf * lax.rsqrt(jnp.sum(kkf * kkf, axis=-1, keepdims=True) + 1e-12)).astype(k.dtype)
    k = k * (1 + (a - 1) * k_a)
    decay = jnp.exp(-jnp.exp(w))
    y, s_last = wkv_scan(r, decay, k, v, -kk, kk * a, wkv_prev)
    yf = y.astype(jnp.float32)
    mu = jnp.mean(yf, axis=-1, keepdims=True)
    var = jnp.mean(jnp.square(yf - mu), axis=-1, keepdims=True)
    yn = ((yf - mu) * lax.rsqrt(var + LN_X_EPS)).reshape(b, l, RWKV_DIM)
    y = (yn * lnx_g.astype(jnp.float32) + lnx_b.astype(jnp.float32)).astype(proj.dtype)
    bonus = (jnp.sum(r * k * r_k, axis=-1, keepdims=True) * v).reshape(b, l, RWKV_DIM)
    return ((y + bonus) * g) @ w_out_rwkv, s_last, proj[:, -1]


def peer(h, peer_wq, peer_k1, peer_k2, peer_u, peer_v):
    b, l, d = h.shape
    t = b * l
    nblk = -(-t // PEER_BLOCK)
    hp = jnp.pad(h.reshape(t, d), ((0, nblk * PEER_BLOCK - t), (0, 0))).reshape(nblk, PEER_BLOCK, d)

    def block(xb):
        q = (xb @ peer_wq).reshape(PEER_BLOCK, PEER_HEADS, 2, PEER_QDIM // 2)
        s1 = jnp.einsum('thd,hnd->thn', q[:, :, 0], peer_k1)
        s2 = jnp.einsum('thd,hnd->thn', q[:, :, 1], peer_k2)
        v1, i1 = lax.top_k(s1, PEER_TOPK)
        v2, i2 = lax.top_k(s2, PEER_TOPK)
        cand = (v1[..., :, None] + v2[..., None, :]).reshape(PEER_BLOCK, PEER_HEADS, -1)
        cidx = (i1[..., :, None] * N_KEYS + i2[..., None, :]).reshape(PEER_BLOCK, PEER_HEADS, -1)
        top, pos = lax.top_k(cand, PEER_TOPK)
        idx = jnp.take_along_axis(cidx, pos, axis=-1)
        gate = jax.nn.softmax(top.astype(jnp.float32), axis=-1).astype(xb.dtype)
        act = jax.nn.gelu(jnp.einsum('thkd,td->thk', peer_u[idx], xb), approximate=False)
        return jnp.einsum('thk,thkd->td', gate * act, peer_v[idx])

    out = lax.map(block, hp).reshape(-1, d)[:t]
    return out.reshape(b, l, d)


def layer(x, p, conv_prev, ssm_prev, wkv_prev, shift_prev, lp):
    h = rmsnorm(x, lp['norm_mix'])
    z, xbc_raw, dt_raw, rw_proj, gate_m, gate_r = split_proj(h @ lp['w_in'])
    y_m, conv_new, ssm_new = mamba_branch(z, xbc_raw, dt_raw, conv_prev, ssm_prev, lp['conv_w'],
                                          lp['conv_b'], lp['dt_bias'], lp['a_log'], lp['d_skip'],
                                          lp['ssm_norm'], lp['w_out_ssm'])
    y_r, wkv_new, shift_new = rwkv_branch(rw_proj, shift_prev, wkv_prev, lp['shift_mu'],
                                          lp['decay_w0'], lp['decay_w2'], lp['aaa_a0'],
                                          lp['aaa_a2'], lp['gate_g2'], lp['k_k'], lp['k_a'],
                                          lp['r_k'], lp['lnx_g'], lp['lnx_b'], lp['w_out_rwkv'])
    x = x + (jax.nn.sigmoid(gate_m) * y_m + jax.nn.sigmoid(gate_r) * y_r) @ lp['w_out']
    x = x + peer(rmsnorm(x, lp['norm_ffn']), lp['peer_wq'], lp['peer_k1'], lp['peer_k2'],
                 lp['peer_u'], lp['peer_v'])
    x = x + jax.nn.sigmoid(rmsnorm(x, lp['norm_ple']) @ lp['w_ple_gate']) * (p @ lp['w_ple_proj'])
    return x, ssm_new, conv_new, wkv_new, shift_new


def setup_inputs(seed: int = 0) -> dict:
    key = jax.random.key(seed)
    ks = list(jax.random.split(key, 48))

    def nrm(shape, scale):
        return jax.random.normal(ks.pop(), shape, jnp.float32) * scale

    def unif(shape, lo, hi):
        return jax.random.uniform(ks.pop(), shape, jnp.float32, lo, hi)

    L = DEPTH
    dt0 = jnp.exp(unif((L, SSM_HEADS), float(np.log(1e-3)), float(np.log(1e-1))))
    return {
        'x_prompt': nrm((BATCH, SEQ, D_MODEL), 1.0),
        'x_sample': nrm((DEC_BATCH, DEC_SEQ, D_MODEL), 1.0),
        'p_prompt': nrm((L, BATCH, SEQ, PLE_DIM), 1.0),
        'p_sample': nrm((L, DEC_BATCH, DEC_SEQ, PLE_DIM), 1.0),
        'state_ssm': nrm((L, DEC_BATCH, SSM_HEADS, SSM_HEADDIM, SSM_STATE), 0.1),
        'state_conv': nrm((L, DEC_BATCH, CONV_WIDTH - 1, CONV_DIM), 1.0),
        'state_wkv': nrm((L, DEC_BATCH, RWKV_HEADS, RWKV_HEADSIZE, RWKV_HEADSIZE), 0.1),
        'state_shift': nrm((L, DEC_BATCH, SHIFT_DIM), 1.0),
        'norm_mix': 1.0 + nrm((L, D_MODEL), 0.02),
        'w_in': nrm((L, D_MODEL, IN_DIM), D_MODEL ** -0.5),
        'conv_w': nrm((L, CONV_WIDTH, CONV_DIM), CONV_WIDTH ** -0.5),
        'conv_b': nrm((L, CONV_DIM), 0.02),
        'dt_bias': dt0 + jnp.log(-jnp.expm1(-dt0)),
        'a_log': jnp.log(unif((L, SSM_HEADS), 1.0, 16.0)),
        'd_skip': 1.0 + nrm((L, SSM_HEADS), 0.02),
        'ssm_norm': 1.0 + nrm((L, D_INNER), 0.02),
        'w_out_ssm': nrm((L, D_INNER, D_MODEL), D_INNER ** -0.5),
        'shift_mu': unif((L, SHIFT_DIM), 0.0, 1.0),
        'decay_w0': unif((L, RWKV_DIM), -6.0, -1.0),
        'decay_w2': nrm((L, DECAY_LORA, RWKV_DIM), 0.5 * DECAY_LORA ** -0.5),
        'aaa_a0': nrm((L, RWKV_DIM), 0.1),
        'aaa_a2': nrm((L, AAA_LORA, RWKV_DIM), AAA_LORA ** -0.5),
        'gate_g2': nrm((L, GATE_LORA, RWKV_DIM), GATE_LORA ** -0.5),
        'k_k': 0.85 + nrm((L, RWKV_HEADS, RWKV_HEADSIZE), 0.02),
        'k_a': 1.0 + nrm((L, RWKV_HEADS, RWKV_HEADSIZE), 0.02),
        'r_k': nrm((L, RWKV_HEADS, RWKV_HEADSIZE), 0.1),
        'lnx_g': 1.0 + nrm((L, RWKV_DIM), 0.02),
        'lnx_b': nrm((L, RWKV_DIM), 0.02),
        'w_out_rwkv': nrm((L, RWKV_DIM, D_MODEL), RWKV_DIM ** -0.5),
        'w_out': nrm((L, D_MODEL, D_MODEL), D_MODEL ** -0.5),
        'norm_ffn': 1.0 + nrm((L, D_MODEL), 0.02),
        'peer_wq': nrm((L, D_MODEL, PEER_HEADS * PEER_QDIM), D_MODEL ** -0.5),
        'peer_k1': nrm((L, PEER_HEADS, N_KEYS, PEER_QDIM // 2), (PEER_QDIM // 2) ** -0.5),
        'peer_k2': nrm((L, PEER_HEADS, N_KEYS, PEER_QDIM // 2), (PEER_QDIM // 2) ** -0.5),
        'peer_u': nrm((L, N_EXPERTS, D_MODEL), D_MODEL ** -0.5),
        'peer_v': nrm((L, N_EXPERTS, D_MODEL), 0.2),
        'norm_ple': 1.0 + nrm((L, D_MODEL), 0.02),
        'w_ple_gate': nrm((L, D_MODEL, D_MODEL), D_MODEL ** -0.5),
        'w_ple_proj': nrm((L, PLE_DIM, D_MODEL), PLE_DIM ** -0.5),
        'norm_final': 1.0 + nrm((D_MODEL,), 0.02),
    }


def reference(x_prompt, x_sample, p_prompt, p_sample, state_ssm, state_conv, state_wkv,
              state_shift, norm_mix, w_in, conv_w, conv_b, dt_bias, a_log, d_skip, ssm_norm,
              w_out_ssm, shift_mu, decay_w0, decay_w2, aaa_a0, aaa_a2, gate_g2, k_k, k_a, r_k,
              lnx_g, lnx_b, w_out_rwkv, w_out, norm_ffn, peer_wq, peer_k1, peer_k2, peer_u,
              peer_v, norm_ple, w_ple_gate, w_ple_proj, norm_final):
    bp = x_prompt.shape[0]
    dt_ = x_prompt.dtype
    xp, xs = x_prompt, x_sample
    ssm_p, conv_p, wkv_p, shift_p = [], [], [], []
    ssm_s, conv_s, wkv_s, shift_s = [], [], [], []
    for i in range(DEPTH):
        lp = {
            'norm_mix': norm_mix[i], 'w_in': w_in[i], 'conv_w': conv_w[i], 'conv_b': conv_b[i],
            'dt_bias': dt_bias[i], 'a_log': a_log[i], 'd_skip': d_skip[i],
            'ssm_norm': ssm_norm[i], 'w_out_ssm': w_out_ssm[i], 'shift_mu': shift_mu[i],
            'decay_w0': decay_w0[i], 'decay_w2': decay_w2[i], 'aaa_a0': aaa_a0[i],
            'aaa_a2': aaa_a2[i], 'gate_g2': gate_g2[i], 'k_k': k_k[i], 'k_a': k_a[i],
            'r_k': r_k[i], 'lnx_g': lnx_g[i], 'lnx_b': lnx_b[i], 'w_out_rwkv': w_out_rwkv[i],
            'w_out': w_out[i], 'norm_ffn': norm_ffn[i], 'peer_wq': peer_wq[i],
            'peer_k1': peer_k1[i], 'peer_k2': peer_k2[i], 'peer_u': peer_u[i],
            'peer_v': peer_v[i], 'norm_ple': norm_ple[i], 'w_ple_gate': w_ple_gate[i],
            'w_ple_proj': w_ple_proj[i],
        }
        xp, s1, s2, s3, s4 = layer(
            xp, p_prompt[i],
            jnp.zeros((bp, CONV_WIDTH - 1, CONV_DIM), dt_),
            jnp.zeros((bp, SSM_HEADS, SSM_HEADDIM, SSM_STATE), dt_),
            jnp.zeros((bp, RWKV_HEADS, RWKV_HEADSIZE, RWKV_HEADSIZE), dt_),
            jnp.zeros((bp, SHIFT_DIM), dt_), lp)
        ssm_p.append(s1); conv_p.append(s2); wkv_p.append(s3); shift_p.append(s4)
        xs, t1, t2, t3, t4 = layer(xs, p_sample[i], state_conv[i], state_ssm[i], state_wkv[i],
                                   state_shift[i], lp)
        ssm_s.append(t1); conv_s.append(t2); wkv_s.append(t3); shift_s.append(t4)
    y_prompt = rmsnorm(xp, norm_final)
    y_sample = rmsnorm(xs, norm_final)
    return (y_prompt, y_sample, jnp.stack(ssm_p), jnp.stack(conv_p), jnp.stack(wkv_p),
            jnp.stack(shift_p), jnp.stack(ssm_s), jnp.stack(conv_s), jnp.stack(wkv_s),
            jnp.stack(shift_s))
```

```cpp
#include <hip/hip_runtime.h>
#include <hip/hip_cooperative_groups.h>
#include <cstdio>
namespace cg = cooperative_groups;
#ifndef MULTI_LAUNCH
#define MULTI_LAUNCH 1
#endif
namespace pg8 {
#define PG8_LAS __attribute__((address_space(3)))
typedef unsigned short bf16_t;
typedef short bf16x8 __attribute__((ext_vector_type(8)));
typedef float f32x4 __attribute__((ext_vector_type(4)));
typedef unsigned u32x4 __attribute__((ext_vector_type(4)));
constexpr int BM = 256, BK = 64, HALF = 128, HTB = HALF * BK * 2  , STAGE_BYTES = 8 * HTB, NXCD = 8, WGM = 8;

__host__ __device__ __forceinline__ int lds_byte(int r, int c) { const int st = (r >> 4) * 2 + (c >> 5), rr = r & 15, cc = c & 31, ob = rr * 64 + cc * 2; return st * 1024 + (ob ^ (((ob >> 9) & 1) << 5)); }
__host__ __device__ __forceinline__ void stage_rc(int b, int& R, int& C) { const int st = b / 1024, sb = b % 1024, swz = sb ^ (((sb >> 9) & 1) << 5); R = (st >> 1) * 16 + swz / 64; C = (st & 1) * 32 + (swz % 64) / 2; }
__host__ __device__ __forceinline__ int perm32(int rho) { const int n = rho >> 4, i = rho & 15; return 8 * (i >> 2) + 4 * n + (i & 3); }

struct Unit { int pm, pn; };
struct Gemm { const bf16_t* A; const bf16_t* Bt; int M, N, K, lda, ldb; };

struct StaticOrder {
    int nM, nN, nwg, G, c;
    __host__ __device__ void init(int M, int N, int G_, int c_) { nM = M / BM; nN = N / BM; nwg = nM * nN; G = G_; c = c_; }
    __host__ __device__ bool next(int i, Unit& u) const {
        const long L = (long)i * G + c; if (L >= nwg) return false;
        int wgid = (int)L; { const int q = nwg / NXCD, r = nwg % NXCD, xcd = wgid % NXCD, off = wgid / NXCD; wgid = (xcd < r ? xcd * (q + 1) : r * (q + 1) + (xcd - r) * q) + off; }
        const int nig = WGM * nN, gid = wgid / nig, fm = gid * WGM, gsz = (nM - fm) < WGM ? (nM - fm) : WGM;
        u.pm = fm + ((wgid % nig) % gsz); u.pn = (wgid % nig) / gsz; return true;
    }
    __device__ __forceinline__ void a_ready(const Unit&) const {}
    __device__ __forceinline__ void done(const Unit&) const {}
};
__device__ __forceinline__ unsigned cvt_pk_bf16(float lo, float hi) { unsigned r; asm volatile("v_cvt_pk_bf16_f32 %0, %1, %2" : "=v"(r) : "v"(lo), "v"(hi)); return r; }
template <class Epi, class Sched>
__device__ __forceinline__ void gemm_phase(PG8_LAS unsigned char* lds, const Gemm g, const Sched& S, const Epi& E) {
    const int tid = threadIdx.x, wid = __builtin_amdgcn_readfirstlane(tid >> 6), lane = tid & 63, wr = wid >> 2, wc = wid & 3, fr = lane & 15, fq = lane >> 4;
    const int K = g.K, nt = K / BK;
    unsigned voffA[2], voffB[2];
#pragma unroll
    for (int i = 0; i < 2; ++i) { int R, C; stage_rc(tid * 16 + i * 8192, R, C); const int Rb = Epi::PERM ? ((R & ~31) + perm32(R & 31)) : R;
        voffA[i] = (unsigned)(R * g.lda + C) * 2u; voffB[i] = (unsigned)(Rb * g.ldb + C) * 2u; }
    const size_t kstep = (size_t)(BK * 2);
    const size_t hstepA = (size_t)HALF * g.lda * 2, hstepB = (size_t)HALF * g.ldb * 2;
    const size_t tstepA = 2 * hstepA, tstepB = 2 * hstepB;
    const unsigned ldsw = (unsigned)wid * 1024u;
    const int aoff = lds_byte(wr * 64 + fr, fq * 8), boff = lds_byte(wc * 32 + fr, fq * 8);
#define PG8_SA(b, h) (((b) * 2 + (h)) * HTB)
#define PG8_SB(b, h) ((4 + (b) * 2 + (h)) * HTB)
#define PG8_STAGE(bufoff, gbase, voff) do { _Pragma("unroll") for (int _i = 0; _i < 2; ++_i) \
        __builtin_amdgcn_global_load_lds((const unsigned*)((const char*)(gbase) + (voff)[_i]), (PG8_LAS unsigned*)(lds + (bufoff) + ldsw + _i * 8192), 16, 0, 0); } while (0)
#define PG8_LDA(dst, b, h) do { _Pragma("unroll") for (int m = 0; m < 4; ++m) _Pragma("unroll") for (int k = 0; k < 2; ++k) dst[m][k] = *(const PG8_LAS bf16x8*)(lds + PG8_SA(b, h) + aoff + m * 2048 + k * 1024); } while (0)
#define PG8_LDB(dst, b, h) do { _Pragma("unroll") for (int n = 0; n < 2; ++n) _Pragma("unroll") for (int k = 0; k < 2; ++k) dst[n][k] = *(const PG8_LAS bf16x8*)(lds + PG8_SB(b, h) + boff + n * 2048 + k * 1024); } while (0)
#define PG8_MMA(ai, bj, At, Bt) do { __builtin_amdgcn_s_setprio(1); _Pragma("unroll") for (int m = 0; m < 4; ++m) _Pragma("unroll") for (int n = 0; n < 2; ++n) _Pragma("unroll") for (int k = 0; k < 2; ++k) \
        acc[ai][bj][m][n] = __builtin_amdgcn_mfma_f32_16x16x32_bf16(Bt[n][k], At[m][k], acc[ai][bj][m][n], 0, 0, 0); __builtin_amdgcn_s_setprio(0); } while (0)
#define PG8_WAIT_V(n) asm volatile("s_waitcnt vmcnt(" #n ")" ::: "memory")
#define PG8_WAIT_L(n) asm volatile("s_waitcnt lgkmcnt(" #n ")" ::: "memory")
#define PG8_BAR __builtin_amdgcn_s_barrier()
#define PG8_SCHED __builtin_amdgcn_sched_barrier(0)
    Unit cur, nxt; int ui = 0;
    if (!S.next(0, cur)) return;
    f32x4 acc[2][2][4][2];
#pragma unroll
    for (int a = 0; a < 2; ++a)
#pragma unroll
        for (int b = 0; b < 2; ++b)
#pragma unroll
            for (int m = 0; m < 4; ++m)
#pragma unroll
                for (int n = 0; n < 2; ++n) acc[a][b][m][n] = (f32x4){0.f, 0.f, 0.f, 0.f};
    bf16x8 At[4][2], B0[2][2], B1[2][2];
    const char* cA = (const char*)g.A + (size_t)cur.pm * tstepA; const char* cB = (const char*)g.Bt + (size_t)cur.pn * tstepB;
    S.a_ready(cur);
    PG8_STAGE(PG8_SB(0, 0), cB, voffB); PG8_STAGE(PG8_SA(0, 0), cA, voffA); PG8_STAGE(PG8_SB(0, 1), cB + hstepB, voffB); PG8_STAGE(PG8_SA(0, 1), cA + hstepA, voffA);
    if (wr == 1) PG8_BAR;
    PG8_WAIT_V(4); PG8_BAR;
    PG8_STAGE(PG8_SB(1, 0), cB + kstep, voffB); PG8_STAGE(PG8_SA(1, 0), cA + kstep, voffA); PG8_STAGE(PG8_SB(1, 1), cB + hstepB + kstep, voffB);
    PG8_WAIT_V(6); PG8_BAR;
    for (;;) {
        const bool has_next = S.next(ui + 1, nxt);
        const char* nA = has_next ? (const char*)g.A + (size_t)nxt.pm * tstepA : cA; const char* nB = has_next ? (const char*)g.Bt + (size_t)nxt.pn * tstepB : cB;
        for (int t = 0; t < nt; t += 2) {
            const bool last = (t == nt - 2);
            const char* a1 = cA + (size_t)(t + 1) * kstep;
            const char* a2 = last ? nA : cA + (size_t)(t + 2) * kstep; const char* b2 = last ? nB : cB + (size_t)(t + 2) * kstep;
            const char* a3 = a2 + kstep; const char* b3 = b2 + kstep;
            if (last && has_next) S.a_ready(nxt);
            PG8_LDB(B0, 0, 0); PG8_SCHED; PG8_LDA(At, 0, 0); PG8_STAGE(PG8_SA(1, 1), a1 + hstepA, voffA);
            PG8_WAIT_L(8); PG8_BAR; PG8_WAIT_L(0); PG8_MMA(0, 0, At, B0); PG8_BAR; PG8_SCHED;
            PG8_LDB(B1, 0, 1); PG8_STAGE(PG8_SB(0, 0), b2, voffB);
            PG8_BAR; PG8_WAIT_L(0); PG8_MMA(0, 1, At, B1); PG8_BAR;
            PG8_LDA(At, 0, 1); PG8_STAGE(PG8_SA(0, 0), a2, voffA);
            PG8_BAR; PG8_WAIT_L(0); PG8_MMA(1, 0, At, B0); PG8_BAR; PG8_SCHED;
            PG8_STAGE(PG8_SB(0, 1), b2 + hstepB, voffB);
            PG8_WAIT_V(6); PG8_BAR; PG8_MMA(1, 1, At, B1); PG8_BAR;
            PG8_LDB(B0, 1, 0); PG8_SCHED; PG8_LDA(At, 1, 0); PG8_STAGE(PG8_SA(0, 1), a2 + hstepA, voffA);
            PG8_WAIT_L(8); PG8_BAR; PG8_WAIT_L(0); PG8_MMA(0, 0, At, B0); PG8_BAR; PG8_SCHED;
            PG8_LDB(B1, 1, 1); PG8_STAGE(PG8_SB(1, 0), b3, voffB);
            PG8_BAR; PG8_WAIT_L(0); PG8_MMA(0, 1, At, B1); PG8_BAR;
            PG8_LDA(At, 1, 1); PG8_STAGE(PG8_SA(1, 0), a3, voffA);
            PG8_BAR; PG8_WAIT_L(0); PG8_MMA(1, 0, At, B0); PG8_BAR; PG8_SCHED;
            PG8_STAGE(PG8_SB(1, 1), b3 + hstepB, voffB);
            PG8_WAIT_V(6); PG8_BAR; PG8_MMA(1, 1, At, B1); PG8_BAR;
        }
        if constexpr (!Epi::AFTER_DRAIN) { E(acc, cur, wr, wc, fr, fq); S.done(cur); }
        if (!has_next) break;
#pragma unroll
        for (int a = 0; a < 2; ++a)
#pragma unroll
            for (int b = 0; b < 2; ++b)
#pragma unroll
                for (int m = 0; m < 4; ++m)
#pragma unroll
                    for (int n = 0; n < 2; ++n) acc[a][b][m][n] = (f32x4){0.f, 0.f, 0.f, 0.f};
        cur = nxt; cA = nA; cB = nB; ++ui;
    }
    PG8_WAIT_V(0);
    if (wr == 0) PG8_BAR;
    PG8_BAR;
    if constexpr (Epi::AFTER_DRAIN) { E.fused(acc, cur, wr, wc, fr, fq, lds, wid, lane); S.done(cur); }
#undef PG8_SA
#undef PG8_SB
#undef PG8_STAGE
#undef PG8_LDA
#undef PG8_LDB
#undef PG8_MMA
#undef PG8_WAIT_V
#undef PG8_WAIT_L
#undef PG8_BAR
#undef PG8_SCHED
}
}

#define LAS __attribute__((address_space(3)))
using pg8::bf16_t; using pg8::bf16x8; using pg8::f32x4; using pg8::u32x4; using pg8::cvt_pk_bf16;
typedef unsigned u32x2 __attribute__((ext_vector_type(2)));
typedef float f32x2 __attribute__((ext_vector_type(2)));
typedef __bf16 bfp2 __attribute__((ext_vector_type(2)));

constexpr int DM = 1024, NBAT = 8, SEQ = 2048, NPR = NBAT * SEQ, NSM = 128, T = NPR + NSM, TP = 16640;
constexpr int NU = 11776;
constexpr int SHIFT = 3328;
constexpr float EPS = 1e-6f;
constexpr size_t O_SSMP = (size_t)T * 1024, O_CONVP = O_SSMP + 8 * 32 * 64 * 128, O_WKVP = O_CONVP + 8 * 3 * 4096, O_SHIFTP = O_WKVP + 8 * 16 * 64 * 64,
                 O_SSMS = O_SHIFTP + 8 * 3328, O_CONVS = O_SSMS + (size_t)128 * 32 * 64 * 128, O_WKVS = O_CONVS + 128 * 3 * 4096, O_SHIFTS = O_WKVS + (size_t)128 * 16 * 64 * 64,
                 O_END = O_SHIFTS + 128 * 3328;
constexpr size_t W_WIN = 0, W_WOS = W_WIN + (size_t)NU * 1024 * 2, W_WOR = W_WOS + 1024 * 2048 * 2, W_WO = W_WOR + 1024 * 1024 * 2, W_WQ = W_WO + 1024 * 1024 * 2,
                 W_WPG = W_WQ + 2048 * 1024 * 2, W_WPP = W_WPG + 1024 * 1024 * 2, W_K12 = W_WPP + 1024 * 256 * 2, W_PU = W_K12 + 8 * 2 * 128 * 128 * 2,
                 W_PV = W_PU + (size_t)16384 * 1024 * 2, W_XB = W_PV + (size_t)16384 * 1024 * 2, W_XBC = W_XB + (size_t)TP * 1024 * 2, W_RW = W_XBC + (size_t)TP * 4096 * 2,
                 W_G = W_RW + (size_t)TP * 3328 * 2, W_DT = W_G + (size_t)TP * 2048 * 2, W_PB = W_DT + (size_t)TP * 32 * 4, W_SS = W_PB + (size_t)TP * 256 * 2,
                 W_SSQ = W_SS + (size_t)4 * TP * 4, W_END = W_SSQ + (size_t)TP * 8 * 4;
constexpr size_t W_P1 = W_XBC, W_X1B = W_XBC + (size_t)TP * 1024 * 4, W_V = W_XB, W_X2B = W_XB, W_Q = W_RW, W_PP = W_RW;
constexpr int LDS_BYTES = 155648;
constexpr int NPHASE = 10;

struct Args { const float* in[40]; float* out; unsigned char* ws; int ph_lo, ph_hi; };
typedef const Args __attribute__((address_space(4)))* KA;

enum { I_XP = 0, I_XS, I_PP, I_PS, I_SSSM, I_SCONV, I_SWKV, I_SSHIFT, I_NMIX, I_WIN, I_CONVW, I_CONVB, I_DTB, I_ALOG, I_DSKIP, I_SSMN, I_WOSSM, I_MU, I_W0, I_W2, I_A0, I_A2, I_G2,
       I_KK, I_KA, I_RK, I_LNG, I_LNB, I_WORW, I_WOUT, I_NFFN, I_WQ, I_K1, I_K2, I_PU, I_PV, I_NPLE, I_WPG, I_WPP, I_NFIN };

__device__ __forceinline__ float bf2f(bf16_t b) { return __uint_as_float(((unsigned)b) << 16); }
__device__ __forceinline__ float bflo(unsigned w) { return __uint_as_float(w << 16); }
__device__ __forceinline__ float bfhi(unsigned w) { return __uint_as_float(w & 0xffff0000u); }
__device__ __forceinline__ bf16_t f2bf(float f) { return (bf16_t)(cvt_pk_bf16(f, 0.f) & 0xffffu); }
__device__ __forceinline__ float sigm(float x) { return 1.0f / (1.0f + __expf(-x)); }
template <int CTRL> __device__ __forceinline__ float dppm(float x) { return __int_as_float(__builtin_amdgcn_update_dpp(0, __float_as_int(x), CTRL, 0xF, 0xF, true)); }
__device__ __forceinline__ float red8(float x) { x += dppm<0xB1>(x); x += dppm<0x4E>(x); x += dppm<0x141>(x); return x; }
__device__ __forceinline__ float red16(float x) { x = red8(x); x += dppm<0x140>(x); return x; }
__device__ __forceinline__ float red64(float x) { x = red16(x); x += __shfl_xor(x, 16); x += __shfl_xor(x, 32); return x; }
__device__ __forceinline__ f32x4 mfma16(bf16x8 a, bf16x8 b, f32x4 c) { return __builtin_amdgcn_mfma_f32_16x16x32_bf16(a, b, c, 0, 0, 0); }
__device__ __forceinline__ void bar() { __syncthreads(); }

__device__ __forceinline__ int win_colmap(int n) { if (n < 6144) return n; if (n < 11520) return n + 32; if (n < 11552) return 6144 + (n - 11520); return -1; }

__device__ __forceinline__ void transpose_tile(LAS float* tl, const float* __restrict__ src, int ld, const float* __restrict__ gain, bf16_t* __restrict__ dst, int K, int k0, int n0, bool remap) {
    const int tid = threadIdx.x, nn = tid & 63, kk0 = tid >> 6;
    const int sc = remap ? win_colmap(n0 + nn) : n0 + nn;
#pragma unroll
    for (int i = 0; i < 8; ++i) { const int k = kk0 + i * 8; float v = 0.f; if (sc >= 0) { v = src[(size_t)(k0 + k) * ld + sc]; if (gain) v *= gain[k0 + k]; } tl[k * 65 + nn] = v; }
    bar();
    const int n = tid >> 3, ks = (tid & 7) * 8;
    u32x4 w; w.x = cvt_pk_bf16(tl[(ks + 0) * 65 + n], tl[(ks + 1) * 65 + n]); w.y = cvt_pk_bf16(tl[(ks + 2) * 65 + n], tl[(ks + 3) * 65 + n]);
    w.z = cvt_pk_bf16(tl[(ks + 4) * 65 + n], tl[(ks + 5) * 65 + n]); w.w = cvt_pk_bf16(tl[(ks + 6) * 65 + n], tl[(ks + 7) * 65 + n]);
    *(u32x4*)(dst + (size_t)(n0 + n) * K + k0 + ks) = w;
    bar();
}

__device__ __forceinline__ void phase_prep(KA a, LAS unsigned char* lds) {
    const int tid = threadIdx.x, nW = gridDim.x, wg = blockIdx.x;
    LAS float* tl = (LAS float*)lds;
    unsigned char* ws = a->ws;
    for (int t = wg; t < 4800; t += nW) {
        int m, r;
        if (t < 2944) { m = 0; r = t; } else if (t < 3456) { m = 1; r = t - 2944; } else if (t < 3712) { m = 2; r = t - 3456; } else if (t < 3968) { m = 3; r = t - 3712; }
        else if (t < 4480) { m = 4; r = t - 3968; } else if (t < 4736) { m = 5; r = t - 4480; } else { m = 6; r = t - 4736; }
        const float* src; const float* gain = nullptr; bf16_t* dst; int ld, K, nk; bool remap = false;
        switch (m) {
            case 0: src = a->in[I_WIN]; gain = a->in[I_NMIX]; dst = (bf16_t*)(ws + W_WIN); ld = 11552; K = 1024; remap = true; break;
            case 1: src = a->in[I_WOSSM]; gain = a->in[I_SSMN]; dst = (bf16_t*)(ws + W_WOS); ld = 1024; K = 2048; break;
            case 2: src = a->in[I_WORW]; dst = (bf16_t*)(ws + W_WOR); ld = 1024; K = 1024; break;
            case 3: src = a->in[I_WOUT]; dst = (bf16_t*)(ws + W_WO); ld = 1024; K = 1024; break;
            case 4: src = a->in[I_WQ]; gain = a->in[I_NFFN]; dst = (bf16_t*)(ws + W_WQ); ld = 2048; K = 1024; break;
            case 5: src = a->in[I_WPG]; gain = a->in[I_NPLE]; dst = (bf16_t*)(ws + W_WPG); ld = 1024; K = 1024; break;
            default: src = a->in[I_WPP]; dst = (bf16_t*)(ws + W_WPP); ld = 1024; K = 256; break;
        }
        nk = K / 64;
        transpose_tile(tl, src, ld, gain, dst, K, (r % nk) * 64, (r / nk) * 64, remap);
    }
    const size_t gt = (size_t)wg * 512 + tid, gs = (size_t)nW * 512;
    {
        const f32x4* pu = (const f32x4*)a->in[I_PU]; const f32x4* pv = (const f32x4*)a->in[I_PV]; const f32x4* gn = (const f32x4*)a->in[I_NFFN];
        u32x2* du = (u32x2*)(ws + W_PU); u32x2* dv = (u32x2*)(ws + W_PV);
        for (size_t i = gt; i < (size_t)16384 * 256; i += gs) {
            const f32x4 g = gn[i & 255]; f32x4 u = pu[i]; const f32x4 v = pv[i]; u = u * g;
            u32x2 o; o.x = cvt_pk_bf16(u[0], u[1]); o.y = cvt_pk_bf16(u[2], u[3]); du[i] = o;
            u32x2 p; p.x = cvt_pk_bf16(v[0], v[1]); p.y = cvt_pk_bf16(v[2], v[3]); dv[i] = p;
        }
        bf16_t* kd = (bf16_t*)(ws + W_K12);
        for (size_t i = gt; i < (size_t)2 * 131072; i += gs) {
            const int half = (int)(i >= 131072), j = (int)(i - (size_t)half * 131072), h = j >> 14, nd = j & 16383;
            kd[((size_t)(h * 2 + half) << 14) + nd] = f2bf(half ? a->in[I_K2][j] : a->in[I_K1][j]);
        }
        u32x2* pb = (u32x2*)(ws + W_PB);
        for (size_t i = gt; i < (size_t)TP * 64; i += gs) {
            const size_t row = i >> 6; f32x4 v = {0.f, 0.f, 0.f, 0.f};
            if (row < (size_t)NPR) v = ((const f32x4*)a->in[I_PP])[i]; else if (row < (size_t)T) v = ((const f32x4*)a->in[I_PS])[i - (size_t)NPR * 64];
            u32x2 o; o.x = cvt_pk_bf16(v[0], v[1]); o.y = cvt_pk_bf16(v[2], v[3]); pb[i] = o;
        }
        float* ss = (float*)(ws + W_SS);
        for (size_t i = gt; i < (size_t)3 * TP; i += gs) ss[TP + i] = 0.f;
        float* ssq = (float*)(ws + W_SSQ);
        for (size_t i = gt; i < (size_t)TP * 8; i += gs) ssq[i] = 0.f;
    }
    {
        const int lane = tid & 63, wv = wg * 8 + (tid >> 6), nwv = nW * 8;
        u32x2* xb = (u32x2*)(ws + W_XB); float* ss0 = (float*)(ws + W_SS);
        for (int row = wv; row < TP; row += nwv) {
            const f32x4* src = row < NPR ? (const f32x4*)(a->in[I_XP] + (size_t)row * 1024) : (const f32x4*)(a->in[I_XS] + (size_t)(row - NPR) * 1024);
            float s = 0.f;
#pragma unroll
            for (int i = 0; i < 4; ++i) {
                f32x4 v = {0.f, 0.f, 0.f, 0.f}; if (row < T) v = src[i * 64 + lane];
                s += v[0] * v[0] + v[1] * v[1] + v[2] * v[2] + v[3] * v[3];
                u32x2 o; o.x = cvt_pk_bf16(v[0], v[1]); o.y = cvt_pk_bf16(v[2], v[3]); xb[(size_t)row * 256 + i * 64 + lane] = o;
            }
            s = red64(s);
            if (lane == 0) ss0[row] = s;
        }
    }
}

typedef const f32x4 (&AccRef)[2][2][4][2];
struct EpiU {
    static constexpr bool PERM = true, AFTER_DRAIN = false;
    bf16_t *Z, *XBC, *RW, *G; float* DT; const float* ss0;
    __device__ __forceinline__ void operator()(AccRef acc, const pg8::Unit& u, int wr, int wc, int fr, int fq) const {
        const int row0 = u.pm * 256 + wr * 64 + fr, pn = u.pn;
        bf16_t* base; int ld, colt, kind;
        if (pn < 8) { base = Z; ld = 2048; colt = pn * 256; kind = 0; }
        else if (pn < 24) { base = XBC; ld = 4096; colt = (pn - 8) * 256; kind = 1; }
        else if (pn < 37) { base = RW; ld = 3328; colt = (pn - 24) * 256; kind = 1; }
        else if (pn < 45) { base = G; ld = 2048; colt = (pn - 37) * 256; kind = 2; }
        else { base = nullptr; ld = 0; colt = 0; kind = 3; }
        const int col0 = colt + wc * 32 + 8 * fq;
#pragma unroll
        for (int ai = 0; ai < 2; ++ai)
#pragma unroll
            for (int m = 0; m < 4; ++m) {
                const int row = row0 + ai * 128 + m * 16;
                const float rs = rsqrtf(ss0[row] * (1.0f / 1024.0f) + EPS);
                if (kind == 3) {
                    if (wc == 0) { const f32x4 v0 = acc[ai][0][m][0] * rs, v1 = acc[ai][0][m][1] * rs; *(f32x4*)(DT + (size_t)row * 32 + 8 * fq) = v0; *(f32x4*)(DT + (size_t)row * 32 + 8 * fq + 4) = v1; }
                } else if (kind != 0 || row < T) {
#pragma unroll
                    for (int bj = 0; bj < 2; ++bj) {
                        f32x4 v0 = acc[ai][bj][m][0] * rs, v1 = acc[ai][bj][m][1] * rs;
                        if (kind == 2) {
#pragma unroll
                            for (int j = 0; j < 4; ++j) { v0[j] = sigm(v0[j]); v1[j] = sigm(v1[j]); } }
                        u32x4 w; w.x = cvt_pk_bf16(v0[0], v0[1]); w.y = cvt_pk_bf16(v0[2], v0[3]); w.z = cvt_pk_bf16(v1[0], v1[1]); w.w = cvt_pk_bf16(v1[2], v1[3]);
                        *(u32x4*)(base + (size_t)row * ld + col0 + bj * 128) = w;
                    }
                }
            }
    }
};
struct EpiQ {
    static constexpr bool PERM = true, AFTER_DRAIN = false;
    bf16_t* O; int ld; const float* ss;
    __device__ __forceinline__ void operator()(AccRef acc, const pg8::Unit& u, int wr, int wc, int fr, int fq) const {
        const int row0 = u.pm * 256 + wr * 64 + fr, col0 = u.pn * 256 + wc * 32 + 8 * fq;
#pragma unroll
        for (int ai = 0; ai < 2; ++ai)
#pragma unroll
            for (int m = 0; m < 4; ++m) {
                const int row = row0 + ai * 128 + m * 16; const float rs = rsqrtf(ss[row] * (1.0f / 1024.0f) + EPS);
#pragma unroll
                for (int bj = 0; bj < 2; ++bj) {
                    const f32x4 v0 = acc[ai][bj][m][0] * rs, v1 = acc[ai][bj][m][1] * rs;
                    u32x4 w; w.x = cvt_pk_bf16(v0[0], v0[1]); w.y = cvt_pk_bf16(v0[2], v0[3]); w.z = cvt_pk_bf16(v1[0], v1[1]); w.w = cvt_pk_bf16(v1[2], v1[3]);
                    *(u32x4*)(O + (size_t)row * ld + col0 + bj * 128) = w;
                }
            }
    }
};
template <int MODE> struct EpiMix {
    static constexpr bool PERM = false, AFTER_DRAIN = false;
    float* P; bf16_t* V; const bf16_t* G; int goff;
    __device__ __forceinline__ void operator()(AccRef acc, const pg8::Unit& u, int wr, int wc, int fr, int fq) const {
        const int row0 = u.pm * 256 + wr * 64 + fr, col0 = u.pn * 256 + wc * 32 + 4 * fq;
#pragma unroll
        for (int ai = 0; ai < 2; ++ai)
#pragma unroll
            for (int m = 0; m < 4; ++m) {
                const int row = row0 + ai * 128 + m * 16;
#pragma unroll
                for (int bj = 0; bj < 2; ++bj)
#pragma unroll
                    for (int n = 0; n < 2; ++n) {
                        const int c = col0 + bj * 128 + n * 16; f32x4 v = acc[ai][bj][m][n];
                        if (MODE != 2) { const u32x2 gw = *(const u32x2*)(G + (size_t)row * 2048 + goff + c); v[0] *= bflo(gw.x); v[1] *= bfhi(gw.x); v[2] *= bflo(gw.y); v[3] *= bfhi(gw.y); }
                        if (MODE == 1) { v = v + *(const f32x4*)(P + (size_t)row * 1024 + c); u32x2 o; o.x = cvt_pk_bf16(v[0], v[1]); o.y = cvt_pk_bf16(v[2], v[3]); *(u32x2*)(V + (size_t)row * 1024 + c) = o; }
                        else *(f32x4*)(P + (size_t)row * 1024 + c) = v;
                    }
                asm volatile("" ::: "memory");
            }
    }
};
template <int MODE> struct EpiRes {
    static constexpr bool PERM = false, AFTER_DRAIN = false;
    const float* xp; const float* xs; float* X; bf16_t* XB; float* ss; const float* ssin; const float* P;
    __device__ __forceinline__ void operator()(AccRef acc, const pg8::Unit& u, int wr, int wc, int fr, int fq) const {
        const int row0 = u.pm * 256 + wr * 64 + fr, col0 = u.pn * 256 + wc * 32 + 4 * fq;
#pragma unroll
        for (int ai = 0; ai < 2; ++ai)
#pragma unroll
            for (int m = 0; m < 4; ++m) {
                const int row = row0 + ai * 128 + m * 16;
                float sq = 0.f;
                if (row < T) {
                    const float* src = MODE == 0 ? (row < NPR ? xp + (size_t)row * 1024 : xs + (size_t)(row - NPR) * 1024) : X + (size_t)row * 1024;
                    const float rs = MODE == 1 ? rsqrtf(ssin[row] * (1.0f / 1024.0f) + EPS) : 0.f;
#pragma unroll
                    for (int bj = 0; bj < 2; ++bj)
#pragma unroll
                        for (int n = 0; n < 2; ++n) {
                            const int c = col0 + bj * 128 + n * 16; f32x4 v = acc[ai][bj][m][n]; const f32x4 xin = *(const f32x4*)(src + c);
                            if (MODE == 1) { const f32x4 pv = *(const f32x4*)(P + (size_t)row * 1024 + c);
#pragma unroll
                                for (int j = 0; j < 4; ++j) v[j] = sigm(v[j] * rs) * pv[j]; }
                            v = v + xin;
                            *(f32x4*)(X + (size_t)row * 1024 + c) = v;
                            if (MODE == 0) { u32x2 o; o.x = cvt_pk_bf16(v[0], v[1]); o.y = cvt_pk_bf16(v[2], v[3]); *(u32x2*)(XB + (size_t)row * 1024 + c) = o; }
                            sq += v[0] * v[0] + v[1] * v[1] + v[2] * v[2] + v[3] * v[3];
                        }
                }
                sq += __shfl_xor(sq, 16); sq += __shfl_xor(sq, 32);
                if (fq == 0 && row < T) atomicAdd(ss + row, sq);
                asm volatile("" ::: "memory");
            }
    }
};
template <class Epi> __device__ __forceinline__ void run_gemm(LAS unsigned char* lds, const bf16_t* A, int lda, const bf16_t* Bt, int ldb, int N, int K, const Epi& E) {
    pg8::Gemm g; g.A = A; g.Bt = Bt; g.M = TP; g.N = N; g.K = K; g.lda = lda; g.ldb = ldb;
    pg8::StaticOrder S; S.init(TP, N, gridDim.x, blockIdx.x);
    pg8::gemm_phase<Epi, pg8::StaticOrder>(lds, g, S, E);
}

__device__ __forceinline__ void rwkv_prompt_item(KA a, LAS unsigned char* lds, int b, int h) {
    const int tid = threadIdx.x, lane = tid & 63, wid = tid >> 6, quad = lane >> 4, l16 = lane & 15;
    LAS bf16_t* WdT = (LAS bf16_t*)(lds);
    LAS bf16_t* WaT = (LAS bf16_t*)(lds + 9216);
    LAS bf16_t* WgT = (LAS bf16_t*)(lds + 18432);
    LAS bf16_t* AL = (LAS bf16_t*)(lds + 35840);
    LAS float* RAW = (LAS float*)(lds + 52736);
    LAS float* sR = (LAS float*)(lds + 78080);
    LAS float* sW = sR + 2048; LAS float* sK = sW + 2048; LAS float* sV = sK + 2048; LAS float* sA = sV + 2048; LAS float* sB = sA + 2048; LAS float* sG = sB + 2048; LAS float* sY = sG + 2048;
    LAS float* sBon = sY + 2048;
    bf16_t* RW = (bf16_t*)(a->ws + W_RW);
    const float* mu = a->in[I_MU];
    for (int i = tid; i < 4096; i += 512) { const int k = i >> 6, n = i & 63; WdT[n * 72 + k] = f2bf(a->in[I_W2][k * 1024 + h * 64 + n]); WaT[n * 72 + k] = f2bf(a->in[I_A2][k * 1024 + h * 64 + n]); }
    for (int i = tid; i < 8192; i += 512) { const int k = i >> 6, n = i & 63; WgT[n * 136 + k] = f2bf(a->in[I_G2][k * 1024 + h * 64 + n]); }
    if (tid < 192) RAW[tid] = 0.f;
    const int et = tid >> 4, j0 = (tid & 15) * 4;
    float c_mur[4], c_muk[4], c_muv[4], c_w0[4], c_a0[4], c_kk[4], c_ka[4], c_rk[4], c_lg[4], c_lb[4];
#pragma unroll
    for (int q = 0; q < 4; ++q) { const int c = h * 64 + j0 + q; c_mur[q] = mu[c]; c_muk[q] = mu[1024 + c]; c_muv[q] = mu[2048 + c]; c_w0[q] = a->in[I_W0][c]; c_a0[q] = a->in[I_A0][c];
        c_kk[q] = a->in[I_KK][c]; c_ka[q] = a->in[I_KA][c]; c_rk[q] = a->in[I_RK][c]; c_lg[q] = a->in[I_LNG][c]; c_lb[q] = a->in[I_LNB][c]; }
    const int li0 = (tid & 15) * 16;
    const int srow = wid * 8 + (lane >> 3), c0 = (lane & 7) * 8;
    f32x2 S[4];
#pragma unroll
    for (int i = 0; i < 4; ++i) S[i] = (f32x2){0.f, 0.f};
    bar();
#pragma unroll 1
    for (int ch = 0; ch < 64; ++ch) {
        const size_t base = (size_t)b * 2048 + ch * 32;
        for (int i = tid; i < 32 * 48; i += 512) {
            const int t = i / 48, rem = i - t * 48, part = rem >> 4, jj = (rem & 15) * 4;
            const u32x2 w = *(const u32x2*)(RW + (base + t) * 3328 + part * 1024 + h * 64 + jj);
            LAS float* d = RAW + (t + 1) * 192 + part * 64 + jj; d[0] = bflo(w.x); d[1] = bfhi(w.x); d[2] = bflo(w.y); d[3] = bfhi(w.y);
        }
        {
            const bf16_t* cp = RW + (base + et) * 3328 + 3072 + li0;
            const u32x4 cA = *(const u32x4*)cp, cB = *(const u32x4*)(cp + 8);
            u32x4 pA = {0u, 0u, 0u, 0u}, pB = {0u, 0u, 0u, 0u};
            if (ch > 0 || et > 0) { pA = *(const u32x4*)(cp - 3328); pB = *(const u32x4*)(cp - 3328 + 8); }
            float o[16];
#pragma unroll
            for (int q = 0; q < 8; ++q) {
                const unsigned cw = q < 4 ? cA[q] : cB[q - 4], pw = q < 4 ? pA[q] : pB[q - 4];
                const float m0 = mu[3072 + li0 + 2 * q], m1 = mu[3072 + li0 + 2 * q + 1];
                const float x0 = bflo(cw), x1 = bfhi(cw);
                o[2 * q] = x0 + (bflo(pw) - x0) * m0; o[2 * q + 1] = x1 + (bfhi(pw) - x1) * m1;
            }
            if (li0 < 64) {
#pragma unroll
                for (int q = 0; q < 16; ++q) o[q] = tanhf(o[q]); }
            else if (li0 >= 128) {
#pragma unroll
                for (int q = 0; q < 16; ++q) o[q] = sigm(o[q]); }
            u32x4 w0, w1;
            w0.x = cvt_pk_bf16(o[0], o[1]); w0.y = cvt_pk_bf16(o[2], o[3]); w0.z = cvt_pk_bf16(o[4], o[5]); w0.w = cvt_pk_bf16(o[6], o[7]);
            w1.x = cvt_pk_bf16(o[8], o[9]); w1.y = cvt_pk_bf16(o[10], o[11]); w1.z = cvt_pk_bf16(o[12], o[13]); w1.w = cvt_pk_bf16(o[14], o[15]);
            *(LAS u32x4*)(AL + et * 264 + li0) = w0; *(LAS u32x4*)(AL + et * 264 + li0 + 8) = w1;
        }
        bar();
        {
            const int rb = wid >> 2, cb = wid & 3;
            const LAS bf16_t* ar = AL + (rb * 16 + l16) * 264 + quad * 8;
            f32x4 lw = {0.f, 0.f, 0.f, 0.f}, la = lw, lg = lw;
#pragma unroll
            for (int kk = 0; kk < 2; ++kk) {
                lw = mfma16(*(const LAS bf16x8*)(ar + kk * 32), *(const LAS bf16x8*)(WdT + (cb * 16 + l16) * 72 + kk * 32 + quad * 8), lw);
                la = mfma16(*(const LAS bf16x8*)(ar + 64 + kk * 32), *(const LAS bf16x8*)(WaT + (cb * 16 + l16) * 72 + kk * 32 + quad * 8), la);
            }
#pragma unroll
            for (int kk = 0; kk < 4; ++kk) lg = mfma16(*(const LAS bf16x8*)(ar + 128 + kk * 32), *(const LAS bf16x8*)(WgT + (cb * 16 + l16) * 136 + kk * 32 + quad * 8), lg);
#pragma unroll
            for (int j = 0; j < 4; ++j) { const int o = (rb * 16 + quad * 4 + j) * 64 + cb * 16 + l16; sW[o] = lw[j]; sA[o] = la[j]; sG[o] = lg[j]; }
        }
        bar();
        {
            float kkf[4], al[4]; float ssk = 0.f, bon = 0.f;
#pragma unroll
            for (int q = 0; q < 4; ++q) {
                const int j = j0 + q, o = et * 64 + j;
                const float rc = RAW[(et + 1) * 192 + j], rp = RAW[et * 192 + j], kc = RAW[(et + 1) * 192 + 64 + j], kp_ = RAW[et * 192 + 64 + j], vc = RAW[(et + 1) * 192 + 128 + j], vp = RAW[et * 192 + 128 + j];
                const float r = rc + (rp - rc) * c_mur[q], k = kc + (kp_ - kc) * c_muk[q], v = vc + (vp - vc) * c_muv[q];
                const float dec = __expf(-0.60653066f * sigm(c_w0[q] + sW[o]));
                al[q] = sigm(c_a0[q] + sA[o]);
                kkf[q] = k * c_kk[q]; ssk += kkf[q] * kkf[q];
                const float kn = k * (1.0f + (al[q] - 1.0f) * c_ka[q]); bon += r * kn * c_rk[q];
                sR[o] = r; sW[o] = dec; sK[o] = kn; sV[o] = v;
            }
            ssk = red16(ssk); bon = red16(bon);
            const float inv = rsqrtf(ssk + 1e-12f);
#pragma unroll
            for (int q = 0; q < 4; ++q) { const int o = et * 64 + j0 + q; const float kk = kkf[q] * inv; sA[o] = -kk; sB[o] = kk * al[q]; }
            if ((tid & 15) == 0) sBon[et] = bon;
        }
        bar();
#pragma unroll 2
        for (int t = 0; t < 32; ++t) {
            const int o = t * 64 + c0;
            const f32x4 a0 = *(const LAS f32x4*)(sA + o), a1 = *(const LAS f32x4*)(sA + o + 4), b0 = *(const LAS f32x4*)(sB + o), b1 = *(const LAS f32x4*)(sB + o + 4);
            const f32x4 w0 = *(const LAS f32x4*)(sW + o), w1 = *(const LAS f32x4*)(sW + o + 4), k0 = *(const LAS f32x4*)(sK + o), k1 = *(const LAS f32x4*)(sK + o + 4);
            const f32x4 r0 = *(const LAS f32x4*)(sR + o), r1 = *(const LAS f32x4*)(sR + o + 4);
            const float v = sV[t * 64 + srow];
            const f32x2 av[4] = {{a0[0], a0[1]}, {a0[2], a0[3]}, {a1[0], a1[1]}, {a1[2], a1[3]}}, bv[4] = {{b0[0], b0[1]}, {b0[2], b0[3]}, {b1[0], b1[1]}, {b1[2], b1[3]}};
            const f32x2 wv[4] = {{w0[0], w0[1]}, {w0[2], w0[3]}, {w1[0], w1[1]}, {w1[2], w1[3]}}, kv[4] = {{k0[0], k0[1]}, {k0[2], k0[3]}, {k1[0], k1[1]}, {k1[2], k1[3]}};
            const f32x2 rv[4] = {{r0[0], r0[1]}, {r0[2], r0[3]}, {r1[0], r1[1]}, {r1[2], r1[3]}};
            f32x2 p = S[0] * av[0]; p = S[1] * av[1] + p; p = S[2] * av[2] + p; p = S[3] * av[3] + p;
            float sa = red8(p.x + p.y);
            const f32x2 vv = {v, v}, sav = {sa, sa};
#pragma unroll
            for (int i = 0; i < 4; ++i) { const f32x2 u = S[i] * wv[i] + vv * kv[i]; S[i] = sav * bv[i] + u; }
            f32x2 y2 = S[0] * rv[0]; y2 = S[1] * rv[1] + y2; y2 = S[2] * rv[2] + y2; y2 = S[3] * rv[3] + y2;
            const float y = red8(y2.x + y2.y);
            if ((lane & 7) == 0) sY[t * 64 + srow] = y;
        }
        bar();
        {
            float y[4]; float s = 0.f;
#pragma unroll
            for (int q = 0; q < 4; ++q) { y[q] = sY[et * 64 + j0 + q]; s += y[q]; }
            const float mean = red16(s) * (1.0f / 64.0f); float vs = 0.f;
#pragma unroll
            for (int q = 0; q < 4; ++q) { y[q] -= mean; vs += y[q] * y[q]; }
            const float inv = rsqrtf(red16(vs) * (1.0f / 64.0f) + 64e-5f), bon = sBon[et];
            float o[4];
#pragma unroll
            for (int q = 0; q < 4; ++q) { const int oo = et * 64 + j0 + q; o[q] = ((y[q] * inv * c_lg[q] + c_lb[q]) + bon * sV[oo]) * sG[oo]; }
            u32x2 w; w.x = cvt_pk_bf16(o[0], o[1]); w.y = cvt_pk_bf16(o[2], o[3]);
            *(u32x2*)(RW + (base + et) * 3328 + h * 64 + j0) = w;
            if (tid < 192) RAW[tid] = RAW[32 * 192 + tid];
        }
        bar();
    }
    {
        float* ws_ = a->out + O_WKVP + ((size_t)(b * 16 + h) * 64 + srow) * 64 + c0;
        *(f32x4*)ws_ = (f32x4){S[0].x, S[0].y, S[1].x, S[1].y}; *(f32x4*)(ws_ + 4) = (f32x4){S[2].x, S[2].y, S[3].x, S[3].y};
        if (tid < 192) a->out[O_SHIFTP + (size_t)b * 3328 + (tid >> 6) * 1024 + h * 64 + (tid & 63)] = RAW[tid];
        if (h == 0 && tid < 256) a->out[O_SHIFTP + (size_t)b * 3328 + 3072 + tid] = bf2f(RW[((size_t)b * 2048 + 2047) * 3328 + 3072 + tid]);
    }
    bar();
}

__device__ __forceinline__ void rwkv_sample_item(KA a, LAS unsigned char* lds, int b, int h) {
    const int tid = threadIdx.x, lane = tid & 63;
    LAS float* li = (LAS float*)lds;
    LAS float* rawl = li + 256;
    LAS float* xsv = rawl + 256;
    LAS float* rawv = xsv + 192;
    LAS float* lo = rawv + 192;
    LAS float* vr = lo + 192;
    LAS float* sy = vr + 7 * 64;
    LAS float* sbon = sy + 64;
    bf16_t* RW = (bf16_t*)(a->ws + W_RW);
    const float* mu = a->in[I_MU]; const float* prevs = a->in[I_SSHIFT] + (size_t)b * 3328;
    const size_t row = (size_t)NPR + b;
    if (tid < 256) { const float cur = bf2f(RW[row * 3328 + 3072 + tid]), prev = prevs[3072 + tid]; const float xs = cur + (prev - cur) * mu[3072 + tid]; rawl[tid] = cur; li[tid] = tid < 64 ? tanhf(xs) : (tid < 128 ? xs : sigm(xs)); }
    else if (tid < 448) { const int idx = tid - 256, c = (idx >> 6) * 1024 + h * 64 + (idx & 63); const float cur = bf2f(RW[row * 3328 + c]), prev = prevs[c]; rawv[idx] = cur; xsv[idx] = cur + (prev - cur) * mu[c]; }
    bar();
    if (tid < 192) {
        float acc = 0.f;
        if (tid < 64) { for (int k = 0; k < 64; ++k) acc += li[k] * a->in[I_W2][k * 1024 + h * 64 + tid]; }
        else if (tid < 128) { for (int k = 0; k < 64; ++k) acc += li[64 + k] * a->in[I_A2][k * 1024 + h * 64 + tid - 64]; }
        else { for (int k = 0; k < 128; ++k) acc += li[128 + k] * a->in[I_G2][k * 1024 + h * 64 + tid - 128]; }
        lo[tid] = acc;
    }
    bar();
    if (tid < 64) {
        const int c = h * 64 + tid; const float r = xsv[tid], k = xsv[64 + tid], v = xsv[128 + tid];
        const float dec = __expf(-0.60653066f * sigm(a->in[I_W0][c] + lo[tid])), al = sigm(a->in[I_A0][c] + lo[64 + tid]);
        const float kkf = k * a->in[I_KK][c], ssk = red64(kkf * kkf), kn = k * (1.0f + (al - 1.0f) * a->in[I_KA][c]), bon = red64(r * kn * a->in[I_RK][c]);
        const float kk = kkf * rsqrtf(ssk + 1e-12f);
        vr[tid] = r; vr[64 + tid] = dec; vr[128 + tid] = kn; vr[192 + tid] = v; vr[256 + tid] = -kk; vr[320 + tid] = kk * al; vr[384 + tid] = lo[128 + tid];
        if (tid == 0) sbon[0] = bon;
    }
    bar();
    {
        const int srow = tid >> 3, c0 = (tid & 7) * 8;
        const size_t so = ((size_t)(b * 16 + h) * 64 + srow) * 64 + c0;
        const f32x4 s0 = *(const f32x4*)(a->in[I_SWKV] + so), s1 = *(const f32x4*)(a->in[I_SWKV] + so + 4);
        float S[8] = {s0[0], s0[1], s0[2], s0[3], s1[0], s1[1], s1[2], s1[3]};
        float sa = 0.f;
#pragma unroll
        for (int i = 0; i < 8; ++i) sa += S[i] * vr[256 + c0 + i];
        sa = red8(sa);
        const float v = vr[192 + srow]; float y = 0.f;
#pragma unroll
        for (int i = 0; i < 8; ++i) { S[i] = S[i] * vr[64 + c0 + i] + v * vr[128 + c0 + i] + sa * vr[320 + c0 + i]; y += S[i] * vr[c0 + i]; }
        y = red8(y);
        *(f32x4*)(a->out + O_WKVS + so) = (f32x4){S[0], S[1], S[2], S[3]}; *(f32x4*)(a->out + O_WKVS + so + 4) = (f32x4){S[4], S[5], S[6], S[7]};
        if ((tid & 7) == 0) sy[srow] = y;
    }
    bar();
    if (tid < 64) {
        const int c = h * 64 + tid; const float y = sy[tid], mean = red64(y) * (1.0f / 64.0f), d = y - mean, var = red64(d * d) * (1.0f / 64.0f);
        const float o = ((d * rsqrtf(var + 64e-5f) * a->in[I_LNG][c] + a->in[I_LNB][c]) + sbon[0] * vr[192 + tid]) * vr[384 + tid];
        RW[row * 3328 + c] = f2bf(o);
    } else if (tid < 256) { const int idx = tid - 64; a->out[O_SHIFTS + (size_t)b * 3328 + (idx >> 6) * 1024 + h * 64 + (idx & 63)] = rawv[idx]; }
    else if (h == 0) { const int i = tid - 256; a->out[O_SHIFTS + (size_t)b * 3328 + 3072 + i] = rawl[i]; }
    bar();
}

__device__ __forceinline__ float softplusf_(float x) { return x > 20.f ? x : log1pf(__expf(x)); }
__device__ __forceinline__ void ssd_prompt_item(KA a, LAS unsigned char* lds, int b, int hd) {
    const int tid = threadIdx.x, lane = tid & 63, wid = tid >> 6, quad = lane >> 4, l16 = lane & 15, g = hd >> 2;
    LAS bf16_t* Cb = (LAS bf16_t*)(lds);
    LAS bf16_t* Bb = (LAS bf16_t*)(lds + 17408);
    LAS bf16_t* BT = (LAS bf16_t*)(lds + 34816);
    LAS bf16_t* XT = (LAS bf16_t*)(lds + 53248);
    LAS bf16_t* XTd = (LAS bf16_t*)(lds + 62464);
    LAS bf16_t* Mb = (LAS bf16_t*)(lds + 71680);
    LAS bf16_t* Hb = (LAS bf16_t*)(lds + 80896);
    LAS float* sdt = (LAS float*)(lds + 98304); LAS float* sac = sdt + 64; LAS float* seac = sac + 64; LAS float* sdd = seac + 64; LAS float* sdec = sdd + 64;
    const bf16_t* XBC = (const bf16_t*)(a->ws + W_XBC); const float* DT = (const float*)(a->ws + W_DT); bf16_t* Z = (bf16_t*)a->out; float* ssq = (float*)(a->ws + W_SSQ);
    const int cg_ = tid % 40, strip = tid / 40;
    int ccol, kind, loc;
    if (cg_ < 8) { kind = 0; loc = cg_ * 8; ccol = hd * 64 + loc; } else if (cg_ < 24) { kind = 1; loc = (cg_ - 8) * 8; ccol = 2048 + g * 128 + loc; } else { kind = 2; loc = (cg_ - 24) * 8; ccol = 3072 + g * 128 + loc; }
    float cw[4][8], cbv[8];
    if (tid < 320) {
#pragma unroll
        for (int q = 0; q < 8; ++q) { cbv[q] = a->in[I_CONVB][ccol + q];
#pragma unroll
            for (int k = 0; k < 4; ++k) cw[k][q] = a->in[I_CONVW][k * 4096 + ccol + q]; }
    }
    const float Ah = -__expf(a->in[I_ALOG][hd]), dtb = a->in[I_DTB][hd], dsk = a->in[I_DSKIP][hd];
    const int pt = wid >> 1, ntb = (wid & 1) * 4;
    f32x4 hacc[4];
#pragma unroll
    for (int i = 0; i < 4; ++i) hacc[i] = (f32x4){0.f, 0.f, 0.f, 0.f};
#pragma unroll 1
    for (int ch = 0; ch < 32; ++ch) {
        const size_t row0 = (size_t)b * 2048 + ch * 64;
        if (tid < 320) {
            float win[3][8];
#pragma unroll
            for (int k = 0; k < 3; ++k) {
                const int tg = ch * 64 + strip * 8 - 3 + k;
                u32x4 w = {0u, 0u, 0u, 0u}; if (tg >= 0) w = *(const u32x4*)(XBC + ((size_t)b * 2048 + tg) * 4096 + ccol);
#pragma unroll
                for (int q = 0; q < 4; ++q) { win[k][2 * q] = bflo(w[q]); win[k][2 * q + 1] = bfhi(w[q]); }
            }
#pragma unroll
            for (int r = 0; r < 8; ++r) {
                const int s = strip * 8 + r;
                const u32x4 w = *(const u32x4*)(XBC + (row0 + s) * 4096 + ccol);
                float cur[8], o[8];
#pragma unroll
                for (int q = 0; q < 4; ++q) { cur[2 * q] = bflo(w[q]); cur[2 * q + 1] = bfhi(w[q]); }
#pragma unroll
                for (int q = 0; q < 8; ++q) { const float v = cbv[q] + cw[0][q] * win[0][q] + cw[1][q] * win[1][q] + cw[2][q] * win[2][q] + cw[3][q] * cur[q]; o[q] = v * sigm(v);
                    win[0][q] = win[1][q]; win[1][q] = win[2][q]; win[2][q] = cur[q]; }
                if (kind == 0) {
#pragma unroll
                    for (int q = 0; q < 8; ++q) XT[(loc + q) * 72 + s] = f2bf(o[q]);
                } else {
                    u32x4 pk; pk.x = cvt_pk_bf16(o[0], o[1]); pk.y = cvt_pk_bf16(o[2], o[3]); pk.z = cvt_pk_bf16(o[4], o[5]); pk.w = cvt_pk_bf16(o[6], o[7]);
                    if (kind == 1) { *(LAS u32x4*)(Bb + s * 136 + loc) = pk;
#pragma unroll
                        for (int q = 0; q < 8; ++q) BT[(loc + q) * 72 + s] = f2bf(o[q]); }
                    else *(LAS u32x4*)(Cb + s * 136 + loc) = pk;
                }
            }
        } else if (wid == 7) {
            const float dtv = softplusf_(DT[(row0 + lane) * 32 + hd] + dtb);
            float x = dtv * Ah;
#pragma unroll
            for (int off = 1; off < 64; off <<= 1) { const float t = __shfl_up(x, off); if (lane >= off) x += t; }
            const float last = __shfl(x, 63);
            sdt[lane] = dtv; sac[lane] = x; seac[lane] = __expf(x); sdd[lane] = __expf(last - x) * dtv; if (lane == 63) sdec[0] = __expf(x);
        }
#pragma unroll
        for (int i = 0; i < 4; ++i)
#pragma unroll
            for (int j = 0; j < 4; ++j) Hb[(pt * 16 + quad * 4 + j) * 136 + (ntb + i) * 16 + l16] = f2bf(hacc[i][j]);
        bar();
        {
            const int p = tid >> 3, s8 = (tid & 7) * 8;
            const u32x4 w = *(const LAS u32x4*)(XT + p * 72 + s8); u32x4 o;
#pragma unroll
            for (int q = 0; q < 4; ++q) o[q] = cvt_pk_bf16(bflo(w[q]) * sdd[s8 + 2 * q], bfhi(w[q]) * sdd[s8 + 2 * q + 1]);
            *(LAS u32x4*)(XTd + p * 72 + s8) = o;
        }
#pragma unroll
        for (int tt = 0; tt < 2; ++tt) {
            const int tile = wid * 2 + tt, lt = tile >> 2, st = tile & 3;
            f32x4 acc = {0.f, 0.f, 0.f, 0.f};
            if (st <= lt) {
#pragma unroll
                for (int kk = 0; kk < 4; ++kk) acc = mfma16(*(const LAS bf16x8*)(Cb + (lt * 16 + l16) * 136 + kk * 32 + quad * 8), *(const LAS bf16x8*)(Bb + (st * 16 + l16) * 136 + kk * 32 + quad * 8), acc);
            }
            const int s = st * 16 + l16; const float as = sac[s], ds = sdt[s];
#pragma unroll
            for (int j = 0; j < 4; ++j) { const int l = lt * 16 + quad * 4 + j; const float v = (s <= l) ? acc[j] * __expf(fminf(sac[l] - as, 0.f)) * ds : 0.f; Mb[l * 72 + s] = f2bf(v); }
        }
        bar();
#pragma unroll
        for (int tt = 0; tt < 2; ++tt) {
            const int tile = wid * 2 + tt, lt = tile >> 2, pc = tile & 3;
            f32x4 acc = {0.f, 0.f, 0.f, 0.f};
#pragma unroll
            for (int kk = 0; kk < 4; ++kk) acc = mfma16(*(const LAS bf16x8*)(Cb + (lt * 16 + l16) * 136 + kk * 32 + quad * 8), *(const LAS bf16x8*)(Hb + (pc * 16 + l16) * 136 + kk * 32 + quad * 8), acc);
#pragma unroll
            for (int j = 0; j < 4; ++j) acc[j] *= seac[lt * 16 + quad * 4 + j];
#pragma unroll
            for (int kk = 0; kk < 2; ++kk) acc = mfma16(*(const LAS bf16x8*)(Mb + (lt * 16 + l16) * 72 + kk * 32 + quad * 8), *(const LAS bf16x8*)(XT + (pc * 16 + l16) * 72 + kk * 32 + quad * 8), acc);
            const int p = pc * 16 + l16;
#pragma unroll
            for (int j = 0; j < 4; ++j) {
                const int l = lt * 16 + quad * 4 + j;
                const float yv = acc[j] + dsk * bf2f(XT[p * 72 + l]);
                bf16_t* zp = Z + (row0 + l) * 2048 + hd * 64 + p;
                const float z = bf2f(*zp), yg = yv * z * sigm(z);
                *zp = f2bf(yg);
                const float sq = red16(yg * yg);
                if (l16 == 0) atomicAdd(ssq + (row0 + l) * 8 + g, sq);
            }
        }
        {
            const float dec = sdec[0];
#pragma unroll
            for (int i = 0; i < 4; ++i) {
                hacc[i] = hacc[i] * dec;
#pragma unroll
                for (int kk = 0; kk < 2; ++kk) hacc[i] = mfma16(*(const LAS bf16x8*)(XTd + (pt * 16 + l16) * 72 + kk * 32 + quad * 8), *(const LAS bf16x8*)(BT + ((ntb + i) * 16 + l16) * 72 + kk * 32 + quad * 8), hacc[i]);
            }
        }
        bar();
    }
#pragma unroll
    for (int i = 0; i < 4; ++i)
#pragma unroll
        for (int j = 0; j < 4; ++j) a->out[O_SSMP + ((size_t)(b * 32 + hd) * 64 + pt * 16 + quad * 4 + j) * 128 + (ntb + i) * 16 + l16] = hacc[i][j];
}

__device__ __forceinline__ void ssd_sample_item(KA a, LAS unsigned char* lds, int b, int hd) {
    const int tid = threadIdx.x, g = hd >> 2;
    LAS float* sx = (LAS float*)lds;
    LAS float* sy = sx + 320;
    const bf16_t* XBC = (const bf16_t*)(a->ws + W_XBC); const float* DT = (const float*)(a->ws + W_DT); bf16_t* Z = (bf16_t*)a->out; float* ssq = (float*)(a->ws + W_SSQ);
    const size_t row = (size_t)NPR + b;
    if (tid < 320) {
        const int col = tid < 64 ? hd * 64 + tid : (tid < 192 ? 2048 + g * 128 + (tid - 64) : 3072 + g * 128 + (tid - 192));
        const float* sc = a->in[I_SCONV] + (size_t)b * 3 * 4096 + col;
        const float v = a->in[I_CONVB][col] + a->in[I_CONVW][col] * sc[0] + a->in[I_CONVW][4096 + col] * sc[4096] + a->in[I_CONVW][8192 + col] * sc[8192] + a->in[I_CONVW][12288 + col] * bf2f(XBC[row * 4096 + col]);
        sx[tid] = v * sigm(v);
    }
    bar();
    const float dtv = softplusf_(DT[row * 32 + hd] + a->in[I_DTB][hd]), dA = __expf(-__expf(a->in[I_ALOG][hd]) * dtv);
    const int p = tid >> 3, n0 = (tid & 7) * 16;
    const size_t so = ((size_t)(b * 32 + hd) * 64 + p) * 128 + n0;
    const float xdt = dtv * sx[p]; float yp = 0.f;
#pragma unroll
    for (int q = 0; q < 4; ++q) {
        f32x4 hv = *(const f32x4*)(a->in[I_SSSM] + so + q * 4);
#pragma unroll
        for (int j = 0; j < 4; ++j) { hv[j] = hv[j] * dA + xdt * sx[64 + n0 + q * 4 + j]; yp += hv[j] * sx[192 + n0 + q * 4 + j]; }
        *(f32x4*)(a->out + O_SSMS + so + q * 4) = hv;
    }
    yp = red8(yp);
    if ((tid & 7) == 0) {
        const float yv = yp + a->in[I_DSKIP][hd] * sx[p];
        bf16_t* zp = Z + row * 2048 + hd * 64 + p; const float z = bf2f(*zp), yg = yv * z * sigm(z);
        *zp = f2bf(yg); sy[p] = yg * yg;
    }
    bar();
    if (tid < 64) { const float s = red64(sy[tid]); if (tid == 0) atomicAdd(ssq + row * 8 + g, s); }
    bar();
}

__device__ __forceinline__ void phase_mix(KA a, LAS unsigned char* lds) {
    const int tid = threadIdx.x, nW = gridDim.x, wg = blockIdx.x;
    const bf16_t* XBC = (const bf16_t*)(a->ws + W_XBC);
    for (size_t i = (size_t)wg * 512 + tid; i < (size_t)8 * 3 * 4096; i += (size_t)nW * 512) { const int c = (int)(i & 4095), j = (int)((i >> 12) % 3), b = (int)(i / 12288); a->out[O_CONVP + i] = bf2f(XBC[((size_t)b * 2048 + 2045 + j) * 4096 + c]); }
    for (size_t i = (size_t)wg * 512 + tid; i < (size_t)128 * 3 * 4096; i += (size_t)nW * 512) { const int c = (int)(i & 4095), j = (int)((i >> 12) % 3), b = (int)(i / 12288);
        a->out[O_CONVS + i] = j < 2 ? a->in[I_SCONV][(size_t)b * 12288 + (j + 1) * 4096 + c] : bf2f(XBC[((size_t)NPR + b) * 4096 + c]); }
    const int half = nW / 2;
    if (wg < half) { for (int it = wg; it < 128; it += half) rwkv_prompt_item(a, lds, it >> 4, it & 15); }
    else {
        const int w = wg - half, ns = nW - half;
        for (int it = w; it < 256; it += ns) ssd_prompt_item(a, lds, it >> 5, it & 31);
        bar();
        for (int it = w; it < 4096; it += ns) ssd_sample_item(a, lds, it >> 5, it & 31);
        for (int it = w; it < 2048; it += ns) rwkv_sample_item(a, lds, it >> 4, it & 15);
    }
}

__device__ __forceinline__ void phase_ssdnorm(KA a) {
    u32x4* Z = (u32x4*)a->out; const float* ssq = (const float*)(a->ws + W_SSQ);
    for (size_t i = (size_t)blockIdx.x * 512 + threadIdx.x; i < (size_t)T * 256; i += (size_t)gridDim.x * 512) {
        const size_t row = i >> 8; const int gi = (int)(i & 255) >> 5;
        const float rs = rsqrtf(ssq[row * 8 + gi] * (1.0f / 256.0f) + EPS);
        u32x4 w = Z[i];
#pragma unroll
        for (int q = 0; q < 4; ++q) w[q] = cvt_pk_bf16(bflo(w[q]) * rs, bfhi(w[q]) * rs);
        Z[i] = w;
    }
}

__device__ __forceinline__ unsigned f2key(float f) { const unsigned u = __float_as_uint(f); return (u & 0x80000000u) ? ~u : (u | 0x80000000u); }
__device__ __forceinline__ float key2f(unsigned k) { return __uint_as_float((k & 0x80000000u) ? (k & 0x7fffffffu) : ~k); }
#define TOPK_INSERT(top, x) do { _Pragma("unroll") for (int _q = 0; _q < 16; ++_q) { const unsigned _hi = max(top[_q], x); x = min(top[_q], x); top[_q] = _hi; } } while (0)

__device__ __forceinline__ void phase_peer(KA a, LAS unsigned char* lds) {
    const int tid = threadIdx.x, lane = tid & 63, wid = tid >> 6, quad = lane >> 4, l16 = lane & 15;
    LAS float* S = (LAS float*)lds;
    LAS unsigned* TK = (LAS unsigned*)(lds + 132096);
    LAS int* EI = (LAS int*)lds;
    LAS float* EG = (LAS float*)(lds + 8192);
    const bf16_t* Q = (const bf16_t*)(a->ws + W_Q); const bf16_t* K12 = (const bf16_t*)(a->ws + W_K12);
    const bf16_t* PU = (const bf16_t*)(a->ws + W_PU); const bf16_t* PV = (const bf16_t*)(a->ws + W_PV);
    const bf16_t* X1B = (const bf16_t*)(a->ws + W_X1B); bf16_t* X2B = (bf16_t*)(a->ws + W_X2B);
    const float* ss1 = (const float*)(a->ws + W_SS) + TP; float* ss2 = (float*)(a->ws + W_SS) + 2 * TP;
    for (int tile = blockIdx.x; tile < T / 16; tile += gridDim.x) {
        const size_t tok0 = (size_t)tile * 16;
#pragma unroll 1
        for (int hq = 0; hq < 2; ++hq) {
            const int hh = wid * 2 + hq;
            bf16x8 af[4];
#pragma unroll
            for (int kk = 0; kk < 4; ++kk) af[kk] = *(const bf16x8*)(Q + (tok0 + l16) * 2048 + hh * 128 + kk * 32 + quad * 8);
#pragma unroll 2
            for (int nt = 0; nt < 8; ++nt) {
                f32x4 acc = {0.f, 0.f, 0.f, 0.f};
#pragma unroll
                for (int kk = 0; kk < 4; ++kk) acc = mfma16(af[kk], *(const bf16x8*)(K12 + ((size_t)hh * 128 + nt * 16 + l16) * 128 + kk * 32 + quad * 8), acc);
#pragma unroll
                for (int j = 0; j < 4; ++j) S[((quad * 4 + j) * 16 + hh) * 129 + nt * 16 + l16] = acc[j];
            }
        }
        bar();
        if (tid < 256) {
            unsigned top[16];
#pragma unroll
            for (int q = 0; q < 16; ++q) top[q] = 0u;
            for (int i = 0; i < 128; ++i) { unsigned x = (f2key(S[tid * 129 + i]) & ~127u) | (unsigned)(127 - i); TOPK_INSERT(top, x); }
#pragma unroll
            for (int q = 0; q < 16; ++q) TK[tid * 16 + q] = top[q];
        }
        bar();
        if (tid < 128) {
            const int t = tid >> 3, head = tid & 7, r1 = (t * 16 + head * 2) * 16, r2 = r1 + 16;
            float f1[16], f2[16];
#pragma unroll
            for (int q = 0; q < 16; ++q) { f1[q] = key2f(TK[r1 + q]); f2[q] = key2f(TK[r2 + q]); }
            unsigned top[16];
#pragma unroll
            for (int q = 0; q < 16; ++q) top[q] = 0u;
#pragma unroll
            for (int i = 0; i < 16; ++i)
#pragma unroll
                for (int j = 0; j < 16; ++j)
                    if ((i + 1) * (j + 1) <= 16) { unsigned x = (f2key(f1[i] + f2[j]) & ~255u) | (unsigned)(255 - (i * 16 + j)); TOPK_INSERT(top, x); }
            float sv[16]; int id[16]; float mx = -3.0e38f;
#pragma unroll
            for (int q = 0; q < 16; ++q) {
                const int pos = 255 - (int)(top[q] & 255u), i = pos >> 4, j = pos & 15;
                const unsigned k1 = TK[r1 + i], k2 = TK[r2 + j];
                sv[q] = key2f(k1) + key2f(k2); id[q] = (127 - (int)(k1 & 127u)) * 128 + (127 - (int)(k2 & 127u)); mx = fmaxf(mx, sv[q]);
            }
            float den = 0.f;
#pragma unroll
            for (int q = 0; q < 16; ++q) { sv[q] = __expf(sv[q] - mx); den += sv[q]; }
            const float rden = 1.0f / den;
#pragma unroll
            for (int q = 0; q < 16; ++q) { EI[t * 128 + head * 16 + q] = id[q]; EG[t * 128 + head * 16 + q] = sv[q] * rden; }
        }
        bar();
#pragma unroll 1
        for (int tq = 0; tq < 2; ++tq) {
            const int tt = wid * 2 + tq; const size_t tok = tok0 + tt;
            const u32x4 xa = *(const u32x4*)(X1B + tok * 1024 + lane * 16), xb = *(const u32x4*)(X1B + tok * 1024 + lane * 16 + 8);
            const float rs = rsqrtf(ss1[tok] * (1.0f / 1024.0f) + EPS);
            float out[16];
#pragma unroll
            for (int q = 0; q < 16; ++q) out[q] = 0.f;
#pragma unroll 1
            for (int hf = 0; hf < 2; ++hf) {
                float dl = 0.f;
#pragma unroll 1
                for (int e0 = 0; e0 < 64; e0 += 4) {
                    u32x4 wa[4], wb[4];
#pragma unroll
                    for (int u = 0; u < 4; ++u) { const int idx = __builtin_amdgcn_readfirstlane(EI[tt * 128 + hf * 64 + e0 + u]); const bf16_t* p = PU + (size_t)idx * 1024 + lane * 16; wa[u] = *(const u32x4*)p; wb[u] = *(const u32x4*)(p + 8); }
#pragma unroll
                    for (int u = 0; u < 4; ++u) {
                        float d = 0.f;
#pragma unroll
                        for (int q = 0; q < 4; ++q) { d += bflo(xa[q]) * bflo(wa[u][q]) + bfhi(xa[q]) * bfhi(wa[u][q]);
                                                      d += bflo(xb[q]) * bflo(wb[u][q]) + bfhi(xb[q]) * bfhi(wb[u][q]); }
                        d = red64(d);
                        dl = (lane == e0 + u) ? d : dl;
                    }
                }
                const float z = dl * rs, act = 0.5f * z * (1.0f + erff(z * 0.70710678f));
                const float cl = EG[tt * 128 + hf * 64 + lane] * act;
#pragma unroll 1
                for (int e0 = 0; e0 < 64; e0 += 4) {
                    u32x4 wa[4], wb[4]; float cc[4];
#pragma unroll
                    for (int u = 0; u < 4; ++u) { const int idx = __builtin_amdgcn_readfirstlane(EI[tt * 128 + hf * 64 + e0 + u]); const bf16_t* p = PV + (size_t)idx * 1024 + lane * 16; wa[u] = *(const u32x4*)p; wb[u] = *(const u32x4*)(p + 8);
                        cc[u] = __int_as_float(__builtin_amdgcn_readlane(__float_as_int(cl), e0 + u)); }
#pragma unroll
                    for (int u = 0; u < 4; ++u)
#pragma unroll
                        for (int q = 0; q < 4; ++q) { out[2 * q] += cc[u] * bflo(wa[u][q]); out[2 * q + 1] += cc[u] * bfhi(wa[u][q]); out[8 + 2 * q] += cc[u] * bflo(wb[u][q]); out[8 + 2 * q + 1] += cc[u] * bfhi(wb[u][q]); }
                }
            }
            float* xr = a->out + tok * 1024 + lane * 16; float sq = 0.f; unsigned pk[8];
#pragma unroll
            for (int q = 0; q < 4; ++q) { f32x4 v = *(const f32x4*)(xr + q * 4);
#pragma unroll
                for (int j = 0; j < 4; ++j) { v[j] += out[q * 4 + j]; sq += v[j] * v[j]; }
                *(f32x4*)(xr + q * 4) = v; pk[2 * q] = cvt_pk_bf16(v[0], v[1]); pk[2 * q + 1] = cvt_pk_bf16(v[2], v[3]); }
            *(u32x4*)(X2B + tok * 1024 + lane * 16) = (u32x4){pk[0], pk[1], pk[2], pk[3]}; *(u32x4*)(X2B + tok * 1024 + lane * 16 + 8) = (u32x4){pk[4], pk[5], pk[6], pk[7]};
            sq = red64(sq);
            if (lane == 0) ss2[tok] = sq;
        }
        bar();
    }
}

__device__ __forceinline__ void phase_final(KA a) {
    f32x4* X = (f32x4*)a->out; const float* ss3 = (const float*)(a->ws + W_SS) + 3 * TP; const f32x4* gn = (const f32x4*)a->in[I_NFIN];
    for (size_t i = (size_t)blockIdx.x * 512 + threadIdx.x; i < (size_t)T * 256; i += (size_t)gridDim.x * 512) {
        const float rs = rsqrtf(ss3[i >> 8] * (1.0f / 1024.0f) + EPS);
        X[i] = X[i] * rs * gn[i & 255];
    }
}

__global__ void __launch_bounds__(512) hybrid_fwd(Args a_unused) {
    extern __shared__ __attribute__((aligned(16))) unsigned char lds_raw[];
    LAS unsigned char* lds = (LAS unsigned char*)lds_raw;
    cg::grid_group grid = cg::this_grid();
    KA a = (KA)__builtin_amdgcn_kernarg_segment_ptr();
    unsigned char* ws = a->ws;
    float* ss = (float*)(ws + W_SS);
    const int ph_lo = a->ph_lo, ph_hi = a->ph_hi;
#define PH_BEGIN(k) if (ph_lo <= (k) && (k) < ph_hi) { if ((k) > ph_lo) grid.sync();
#define PH_END }
    PH_BEGIN(0)  phase_prep(a, lds); PH_END
    PH_BEGIN(1)  { EpiU E; E.Z = (bf16_t*)a->out; E.XBC = (bf16_t*)(ws + W_XBC); E.RW = (bf16_t*)(ws + W_RW); E.G = (bf16_t*)(ws + W_G); E.DT = (float*)(ws + W_DT); E.ss0 = ss;
                  run_gemm(lds, (const bf16_t*)(ws + W_XB), 1024, (const bf16_t*)(ws + W_WIN), 1024, NU, 1024, E); } PH_END
    PH_BEGIN(2)  phase_mix(a, lds); PH_END
    PH_BEGIN(3)  phase_ssdnorm(a); PH_END
    PH_BEGIN(4)  { EpiMix<0> E0; E0.P = (float*)(ws + W_P1); E0.V = nullptr; E0.G = (const bf16_t*)(ws + W_G); E0.goff = 0;
                  run_gemm(lds, (const bf16_t*)a->out, 2048, (const bf16_t*)(ws + W_WOS), 2048, 1024, 2048, E0);
                  __threadfence(); __syncthreads();
                  EpiMix<1> E1; E1.P = (float*)(ws + W_P1); E1.V = (bf16_t*)(ws + W_V); E1.G = (const bf16_t*)(ws + W_G); E1.goff = 1024;
                  run_gemm(lds, (const bf16_t*)(ws + W_RW), 3328, (const bf16_t*)(ws + W_WOR), 1024, 1024, 1024, E1); } PH_END
    PH_BEGIN(5)  { EpiRes<0> E; E.xp = a->in[I_XP]; E.xs = a->in[I_XS]; E.X = a->out; E.XB = (bf16_t*)(ws + W_X1B); E.ss = ss + TP; E.ssin = nullptr; E.P = nullptr;
                  run_gemm(lds, (const bf16_t*)(ws + W_V), 1024, (const bf16_t*)(ws + W_WO), 1024, 1024, 1024, E); } PH_END
    PH_BEGIN(6)  { EpiQ E; E.O = (bf16_t*)(ws + W_Q); E.ld = 2048; E.ss = ss + TP;
                  run_gemm(lds, (const bf16_t*)(ws + W_X1B), 1024, (const bf16_t*)(ws + W_WQ), 1024, 2048, 1024, E); } PH_END
    PH_BEGIN(7)  phase_peer(a, lds); PH_END
    PH_BEGIN(8)  { EpiMix<2> E0; E0.P = (float*)(ws + W_PP); E0.V = nullptr; E0.G = nullptr; E0.goff = 0;
                  run_gemm(lds, (const bf16_t*)(ws + W_PB), 256, (const bf16_t*)(ws + W_WPP), 256, 1024, 256, E0);
                  __threadfence(); __syncthreads();
                  EpiRes<1> E; E.xp = nullptr; E.xs = nullptr; E.X = a->out; E.XB = nullptr; E.ss = ss + 3 * TP; E.ssin = ss + 2 * TP; E.P = (const float*)(ws + W_PP);
                  run_gemm(lds, (const bf16_t*)(ws + W_X2B), 1024, (const bf16_t*)(ws + W_WPG), 1024, 1024, 1024, E); } PH_END
    PH_BEGIN(9) phase_final(a); PH_END
}

extern "C" void kernel_launch(void* const* d_in, const int* in_sizes, int n_in, void* d_out, int out_size, void* d_ws, size_t ws_size, hipStream_t stream) {
    static int grid = 0;
    if (grid == 0) {
        if (n_in != 40 || (size_t)out_size != O_END || ws_size < W_END) { fprintf(stderr, "kernel_launch: unexpected shapes: n_in %d out %d ws %zu (need %zu)\n", n_in, out_size, ws_size, (size_t)W_END); grid = -1; return; }
        int dev = 0, cus = 0, per_cu = 0;
        hipGetDevice(&dev); hipDeviceGetAttribute(&cus, hipDeviceAttributeMultiprocessorCount, dev);
        if (hipFuncSetAttribute((const void*)hybrid_fwd, hipFuncAttributeMaxDynamicSharedMemorySize, LDS_BYTES) != hipSuccess) { fprintf(stderr, "kernel_launch: hipFuncSetAttribute failed\n"); grid = -1; return; }
        if (hipOccupancyMaxActiveBlocksPerMultiprocessor(&per_cu, (const void*)hybrid_fwd, 512, LDS_BYTES) != hipSuccess || per_cu < 1) { fprintf(stderr, "kernel_launch: occupancy query says %d\n", per_cu); per_cu = 1; }
        (void)hipGetLastError();
        grid = cus * 1;
        if (grid > 256) grid = 256;
    }
    if (grid < 0) return;
    Args a{};
    for (int i = 0; i < 40; ++i) a.in[i] = (const float*)d_in[i];
    a.out = (float*)d_out; a.ws = (unsigned char*)d_ws;
#if MULTI_LAUNCH
    for (int ph = 0; ph < NPHASE; ++ph) { a.ph_lo = ph; a.ph_hi = ph + 1; hipLaunchKernelGGL(hybrid_fwd, dim3(grid), dim3(512), LDS_BYTES, stream, a); }
#else
    a.ph_lo = 0; a.ph_hi = NPHASE;
    void* args[] = {&a};
    hipError_t e = hipLaunchCooperativeKernel((const void*)hybrid_fwd, dim3(grid), dim3(512), args, LDS_BYTES, stream);
    if (e != hipSuccess) fprintf(stderr, "kernel_launch: cooperative launch failed: %s (grid %d)\n", hipGetErrorString(e), grid);
#endif
}
```

```cpp
#include <hip/hip_runtime.h>
#include <hip/hip_cooperative_groups.h>
#include <cstdio>
namespace cg = cooperative_groups;
#ifndef MULTI_LAUNCH
#define MULTI_LAUNCH 0
#endif
__device__ __forceinline__ int tidx() { int t = threadIdx.x; asm volatile("" : "+v"(t)); return t; }
namespace pg8 {
#define PG8_LAS __attribute__((address_space(3)))
typedef unsigned short bf16_t;
typedef short bf16x8 __attribute__((ext_vector_type(8)));
typedef float f32x4 __attribute__((ext_vector_type(4)));
typedef unsigned u32x4 __attribute__((ext_vector_type(4)));
constexpr int BM = 256, BK = 64, HALF = 128, HTB = HALF * BK * 2  , STAGE_BYTES = 8 * HTB, NXCD = 8, WGM = 8;

__host__ __device__ __forceinline__ int lds_byte(int r, int c) { const int st = (r >> 4) * 2 + (c >> 5), rr = r & 15, cc = c & 31, ob = rr * 64 + cc * 2; return st * 1024 + (ob ^ (((ob >> 9) & 1) << 5)); }
__host__ __device__ __forceinline__ void stage_rc(int b, int& R, int& C) { const int st = b / 1024, sb = b % 1024, swz = sb ^ (((sb >> 9) & 1) << 5); R = (st >> 1) * 16 + swz / 64; C = (st & 1) * 32 + (swz % 64) / 2; }
__host__ __device__ __forceinline__ int perm32(int rho) { const int n = rho >> 4, i = rho & 15; return 8 * (i >> 2) + 4 * n + (i & 3); }

struct Unit { int pm, pn; };
struct Gemm { const bf16_t* A; const bf16_t* Bt; int M, N, K, lda, ldb; };

struct StaticOrder {
    int nM, nN, nwg, G, c;
    __host__ __device__ void init(int M, int N, int G_, int c_) { nM = M / BM; nN = N / BM; nwg = nM * nN; G = G_; c = c_; }
    __host__ __device__ bool next(int i, Unit& u) const {
        const long L = (long)i * G + c; if (L >= nwg) return false;
        int wgid = (int)L; { const int q = nwg / NXCD, r = nwg % NXCD, xcd = wgid % NXCD, off = wgid / NXCD; wgid = (xcd < r ? xcd * (q + 1) : r * (q + 1) + (xcd - r) * q) + off; }
        const int nig = WGM * nN, gid = wgid / nig, fm = gid * WGM, gsz = (nM - fm) < WGM ? (nM - fm) : WGM;
        u.pm = fm + ((wgid % nig) % gsz); u.pn = (wgid % nig) / gsz; return true;
    }
    __device__ __forceinline__ void a_ready(const Unit&) const {}
    __device__ __forceinline__ void done(const Unit&) const {}
};
__device__ __forceinline__ unsigned cvt_pk_bf16(float lo, float hi) { unsigned r; asm volatile("v_cvt_pk_bf16_f32 %0, %1, %2" : "=v"(r) : "v"(lo), "v"(hi)); return r; }
template <class Epi, class Sched>
__device__ __forceinline__ void gemm_phase(PG8_LAS unsigned char* lds, const Gemm g, const Sched& S, const Epi& E) {
    const int tid = tidx(), wid = __builtin_amdgcn_readfirstlane(tid >> 6), lane = tid & 63, wr = wid >> 2, wc = wid & 3, fr = lane & 15, fq = lane >> 4;
    const int K = g.K, nt = K / BK;
    unsigned voffA[2], voffB[2];
#pragma unroll
    for (int i = 0; i < 2; ++i) { int R, C; stage_rc(tid * 16 + i * 8192, R, C); const int Rb = Epi::PERM ? ((R & ~31) + perm32(R & 31)) : R;
        voffA[i] = (unsigned)(R * g.lda + C) * 2u; voffB[i] = (unsigned)(Rb * g.ldb + C) * 2u; }
    const size_t kstep = (size_t)(BK * 2);
    const size_t hstepA = (size_t)HALF * g.lda * 2, hstepB = (size_t)HALF * g.ldb * 2;
    const size_t tstepA = 2 * hstepA, tstepB = 2 * hstepB;
    const unsigned ldsw = (unsigned)wid * 1024u;
    const int aoff = lds_byte(wr * 64 + fr, fq * 8), boff = lds_byte(wc * 32 + fr, fq * 8);
#define PG8_SA(b, h) (((b) * 2 + (h)) * HTB)
#define PG8_SB(b, h) ((4 + (b) * 2 + (h)) * HTB)
#define PG8_STAGE(bufoff, gbase, voff) do { _Pragma("unroll") for (int _i = 0; _i < 2; ++_i) \
        __builtin_amdgcn_global_load_lds((const unsigned*)((const char*)(gbase) + (voff)[_i]), (PG8_LAS unsigned*)(lds + (bufoff) + ldsw + _i * 8192), 16, 0, 0); } while (0)
#define PG8_LDA(dst, b, h) do { _Pragma("unroll") for (int m = 0; m < 4; ++m) _Pragma("unroll") for (int k = 0; k < 2; ++k) dst[m][k] = *(const PG8_LAS bf16x8*)(lds + PG8_SA(b, h) + aoff + m * 2048 + k * 1024); } while (0)
#define PG8_LDB(dst, b, h) do { _Pragma("unroll") for (int n = 0; n < 2; ++n) _Pragma("unroll") for (int k = 0; k < 2; ++k) dst[n][k] = *(const PG8_LAS bf16x8*)(lds + PG8_SB(b, h) + boff + n * 2048 + k * 1024); } while (0)
#define PG8_MMA(ai, bj, At, Bt) do { __builtin_amdgcn_s_setprio(1); _Pragma("unroll") for (int m = 0; m < 4; ++m) _Pragma("unroll") for (int n = 0; n < 2; ++n) _Pragma("unroll") for (int k = 0; k < 2; ++k) \
        acc[ai][bj][m][n] = __builtin_amdgcn_mfma_f32_16x16x32_bf16(Bt[n][k], At[m][k], acc[ai][bj][m][n], 0, 0, 0); __builtin_amdgcn_s_setprio(0); } while (0)
#define PG8_WAIT_V(n) asm volatile("s_waitcnt vmcnt(" #n ")" ::: "memory")
#define PG8_WAIT_L(n) asm volatile("s_waitcnt lgkmcnt(" #n ")" ::: "memory")
#define PG8_BAR __builtin_amdgcn_s_barrier()
#define PG8_SCHED __builtin_amdgcn_sched_barrier(0)
    Unit cur, nxt; int ui = 0;
    if (!S.next(0, cur)) return;
    f32x4 acc[2][2][4][2];
#pragma unroll
    for (int a = 0; a < 2; ++a)
#pragma unroll
        for (int b = 0; b < 2; ++b)
#pragma unroll
            for (int m = 0; m < 4; ++m)
#pragma unroll
                for (int n = 0; n < 2; ++n) acc[a][b][m][n] = (f32x4){0.f, 0.f, 0.f, 0.f};
    bf16x8 At[4][2], B0[2][2], B1[2][2];
    const char* cA = (const char*)g.A + (size_t)cur.pm * tstepA; const char* cB = (const char*)g.Bt + (size_t)cur.pn * tstepB;
    S.a_ready(cur);
    PG8_STAGE(PG8_SB(0, 0), cB, voffB); PG8_STAGE(PG8_SA(0, 0), cA, voffA); PG8_STAGE(PG8_SB(0, 1), cB + hstepB, voffB); PG8_STAGE(PG8_SA(0, 1), cA + hstepA, voffA);
    if (wr == 1) PG8_BAR;
    PG8_WAIT_V(4); PG8_BAR;
    PG8_STAGE(PG8_SB(1, 0), cB + kstep, voffB); PG8_STAGE(PG8_SA(1, 0), cA + kstep, voffA); PG8_STAGE(PG8_SB(1, 1), cB + hstepB + kstep, voffB);
    PG8_WAIT_V(6); PG8_BAR;
    for (;;) {
        const bool has_next = S.next(ui + 1, nxt);
        const char* nA = has_next ? (const char*)g.A + (size_t)nxt.pm * tstepA : cA; const char* nB = has_next ? (const char*)g.Bt + (size_t)nxt.pn * tstepB : cB;
        for (int t = 0; t < nt; t += 2) {
            const bool last = (t == nt - 2);
            const char* a1 = cA + (size_t)(t + 1) * kstep;
            const char* a2 = last ? nA : cA + (size_t)(t + 2) * kstep; const char* b2 = last ? nB : cB + (size_t)(t + 2) * kstep;
            const char* a3 = a2 + kstep; const char* b3 = b2 + kstep;
            if (last && has_next) S.a_ready(nxt);
            PG8_LDB(B0, 0, 0); PG8_SCHED; PG8_LDA(At, 0, 0); PG8_STAGE(PG8_SA(1, 1), a1 + hstepA, voffA);
            PG8_WAIT_L(8); PG8_BAR; PG8_WAIT_L(0); PG8_MMA(0, 0, At, B0); PG8_BAR; PG8_SCHED;
            PG8_LDB(B1, 0, 1); PG8_STAGE(PG8_SB(0, 0), b2, voffB);
            PG8_BAR; PG8_WAIT_L(0); PG8_MMA(0, 1, At, B1); PG8_BAR;
            PG8_LDA(At, 0, 1); PG8_STAGE(PG8_SA(0, 0), a2, voffA);
            PG8_BAR; PG8_WAIT_L(0); PG8_MMA(1, 0, At, B0); PG8_BAR; PG8_SCHED;
            PG8_STAGE(PG8_SB(0, 1), b2 + hstepB, voffB);
            PG8_WAIT_V(6); PG8_BAR; PG8_MMA(1, 1, At, B1); PG8_BAR;
            PG8_LDB(B0, 1, 0); PG8_SCHED; PG8_LDA(At, 1, 0); PG8_STAGE(PG8_SA(0, 1), a2 + hstepA, voffA);
            PG8_WAIT_L(8); PG8_BAR; PG8_WAIT_L(0); PG8_MMA(0, 0, At, B0); PG8_BAR; PG8_SCHED;
            PG8_LDB(B1, 1, 1); PG8_STAGE(PG8_SB(1, 0), b3, voffB);
            PG8_BAR; PG8_WAIT_L(0); PG8_MMA(0, 1, At, B1); PG8_BAR;
            PG8_LDA(At, 1, 1); PG8_STAGE(PG8_SA(1, 0), a3, voffA);
            PG8_BAR; PG8_WAIT_L(0); PG8_MMA(1, 0, At, B0); PG8_BAR; PG8_SCHED;
            PG8_STAGE(PG8_SB(1, 1), b3 + hstepB, voffB);
            PG8_WAIT_V(6); PG8_BAR; PG8_MMA(1, 1, At, B1); PG8_BAR;
        }
        if constexpr (!Epi::AFTER_DRAIN) { E(acc, cur, wr, wc, fr, fq); S.done(cur); }
        if (!has_next) break;
#pragma unroll
        for (int a = 0; a < 2; ++a)
#pragma unroll
            for (int b = 0; b < 2; ++b)
#pragma unroll
                for (int m = 0; m < 4; ++m)
#pragma unroll
                    for (int n = 0; n < 2; ++n) acc[a][b][m][n] = (f32x4){0.f, 0.f, 0.f, 0.f};
        cur = nxt; cA = nA; cB = nB; ++ui;
    }
    PG8_WAIT_V(0);
    if (wr == 0) PG8_BAR;
    PG8_BAR;
    if constexpr (Epi::AFTER_DRAIN) { E.fused(acc, cur, wr, wc, fr, fq, lds, wid, lane); S.done(cur); }
#undef PG8_SA
#undef PG8_SB
#undef PG8_STAGE
#undef PG8_LDA
#undef PG8_LDB
#undef PG8_MMA
#undef PG8_WAIT_V
#undef PG8_WAIT_L
#undef PG8_BAR
#undef PG8_SCHED
}
}

#define LAS __attribute__((address_space(3)))
using pg8::bf16_t; using pg8::bf16x8; using pg8::f32x4; using pg8::u32x4; using pg8::cvt_pk_bf16;
typedef unsigned u32x2 __attribute__((ext_vector_type(2)));
typedef float f32x2 __attribute__((ext_vector_type(2)));
typedef __bf16 bfp2 __attribute__((ext_vector_type(2)));

constexpr int DM = 1024, NBAT = 8, SEQ = 2048, NPR = NBAT * SEQ, NSM = 128, T = NPR + NSM, TP = 16640;
constexpr int NU = 11776;
constexpr int SHIFT = 3328;
constexpr float EPS = 1e-6f;
constexpr size_t O_SSMP = (size_t)T * 1024, O_CONVP = O_SSMP + 8 * 32 * 64 * 128, O_WKVP = O_CONVP + 8 * 3 * 4096, O_SHIFTP = O_WKVP + 8 * 16 * 64 * 64,
                 O_SSMS = O_SHIFTP + 8 * 3328, O_CONVS = O_SSMS + (size_t)128 * 32 * 64 * 128, O_WKVS = O_CONVS + 128 * 3 * 4096, O_SHIFTS = O_WKVS + (size_t)128 * 16 * 64 * 64,
                 O_END = O_SHIFTS + 128 * 3328;
constexpr size_t W_WIN = 0, W_WOS = W_WIN + (size_t)NU * 1024 * 2, W_WOR = W_WOS + 1024 * 2048 * 2, W_WO = W_WOR + 1024 * 1024 * 2, W_WQ = W_WO + 1024 * 1024 * 2,
                 W_WPG = W_WQ + 2048 * 1024 * 2, W_WPP = W_WPG + 1024 * 1024 * 2, W_K12 = W_WPP + 1024 * 256 * 2, W_PU = W_K12 + 8 * 2 * 128 * 128 * 2,
                 W_PV = W_PU + (size_t)16384 * 1024 * 2, W_XB = W_PV + (size_t)16384 * 1024 * 2, W_XBC = W_XB + (size_t)TP * 1024 * 2, W_RW = W_XBC + (size_t)TP * 4096 * 2,
                 W_G = W_RW + (size_t)TP * 3328 * 2, W_DT = W_G + (size_t)TP * 2048 * 2, W_PB = W_DT + (size_t)TP * 32 * 4, W_SS = W_PB + (size_t)TP * 256 * 2,
                 W_SSQ = W_SS + (size_t)4 * TP * 4, W_END = W_SSQ + (size_t)TP * 8 * 4;
constexpr size_t W_BAR = W_END, W_TOTAL = W_END + 4096;
constexpr size_t W_P1 = W_XBC, W_X1B = W_XBC + (size_t)TP * 1024 * 4, W_V = W_XB, W_X2B = W_XB, W_Q = W_RW, W_PP = W_RW;
constexpr int LDS_BYTES = 155648;
constexpr int NPHASE = 10;

struct Args { const float* in[40]; float* out; unsigned char* ws; int ph_lo, ph_hi; };
typedef const Args __attribute__((address_space(4)))* KA;

enum { I_XP = 0, I_XS, I_PP, I_PS, I_SSSM, I_SCONV, I_SWKV, I_SSHIFT, I_NMIX, I_WIN, I_CONVW, I_CONVB, I_DTB, I_ALOG, I_DSKIP, I_SSMN, I_WOSSM, I_MU, I_W0, I_W2, I_A0, I_A2, I_G2,
       I_KK, I_KA, I_RK, I_LNG, I_LNB, I_WORW, I_WOUT, I_NFFN, I_WQ, I_K1, I_K2, I_PU, I_PV, I_NPLE, I_WPG, I_WPP, I_NFIN };

__device__ __forceinline__ float bf2f(bf16_t b) { return __uint_as_float(((unsigned)b) << 16); }
__device__ __forceinline__ float bflo(unsigned w) { return __uint_as_float(w << 16); }
__device__ __forceinline__ float bfhi(unsigned w) { return __uint_as_float(w & 0xffff0000u); }
__device__ __forceinline__ bf16_t f2bf(float f) { return (bf16_t)(cvt_pk_bf16(f, 0.f) & 0xffffu); }
__device__ __forceinline__ float sigm(float x) { return __builtin_amdgcn_rcpf(1.0f + __expf(-x)); }
__device__ __forceinline__ float tanh_fast(float x) { return 2.0f * sigm(2.0f * x) - 1.0f; }
template <int CTRL> __device__ __forceinline__ float dppm(float x) { return __int_as_float(__builtin_amdgcn_update_dpp(0, __float_as_int(x), CTRL, 0xF, 0xF, true)); }
__device__ __forceinline__ float red8(float x) { x += dppm<0xB1>(x); x += dppm<0x4E>(x); x += dppm<0x141>(x); return x; }
__device__ __forceinline__ float red16(float x) { x = red8(x); x += dppm<0x140>(x); return x; }
__device__ __forceinline__ float red64(float x) { x = red16(x); x += __shfl_xor(x, 16); x += __shfl_xor(x, 32); return x; }
__device__ __forceinline__ f32x4 mfma16(bf16x8 a, bf16x8 b, f32x4 c) { return __builtin_amdgcn_mfma_f32_16x16x32_bf16(a, b, c, 0, 0, 0); }
__device__ __forceinline__ void bar() { __syncthreads(); }
__device__ __forceinline__ void bar_lds() { asm volatile("s_waitcnt lgkmcnt(0)\n\ts_barrier" ::: "memory"); }

__device__ __forceinline__ void peer_quant_row(KA a, int r) {
    const int lane = tidx() & 63; unsigned char* ws = a->ws;
    const bool isv = r >= 16384; const int e = r & 16383;
    const float* src = (isv ? a->in[I_PV] : a->in[I_PU]) + (size_t)e * 1024 + lane * 16;
    f32x4 v[4]; float amax = 0.f;
#pragma unroll
    for (int q = 0; q < 4; ++q) { v[q] = *(const f32x4*)(src + q * 4); if (!isv) v[q] = v[q] * *(const f32x4*)(a->in[I_NFFN] + lane * 16 + q * 4);
        amax = fmaxf(amax, fmaxf(fmaxf(fabsf(v[q][0]), fabsf(v[q][1])), fmaxf(fabsf(v[q][2]), fabsf(v[q][3])))); }
#pragma unroll
    for (int off = 1; off < 64; off <<= 1) amax = fmaxf(amax, __shfl_xor(amax, off));
    const float sc = amax > 0.f ? 224.0f / amax : 1.0f;
    u32x4 w;
#pragma unroll
    for (int q = 0; q < 4; ++q) { int p = __builtin_amdgcn_cvt_pk_fp8_f32(v[q][0] * sc, v[q][1] * sc, 0, false); p = __builtin_amdgcn_cvt_pk_fp8_f32(v[q][2] * sc, v[q][3] * sc, p, true); w[q] = (unsigned)p; }
    unsigned char* dst = ws + (isv ? W_PV : W_PU);
    *(u32x4*)(dst + (size_t)e * 1024 + lane * 16) = w;
    if (lane == 0) ((float*)(dst + 16777216))[e] = amax > 0.f ? amax * (1.0f / 224.0f) : 1.0f;
}

constexpr int N_LATE_JOBS = 14848;
__device__ __forceinline__ void late_transpose_job(KA a, int job) {
    const int lane = tidx() & 63; unsigned char* ws = a->ws;
    const float* src; const float* gain = nullptr; bf16_t* dst; int ld, K, r;
    if (job < 4096) { r = job; src = a->in[I_WOSSM]; gain = a->in[I_SSMN]; dst = (bf16_t*)(ws + W_WOS); ld = 1024; K = 2048; }
    else if (job < 6144) { r = job - 4096; src = a->in[I_WORW]; dst = (bf16_t*)(ws + W_WOR); ld = 1024; K = 1024; }
    else if (job < 8192) { r = job - 6144; src = a->in[I_WOUT]; dst = (bf16_t*)(ws + W_WO); ld = 1024; K = 1024; }
    else if (job < 12288) { r = job - 8192; src = a->in[I_WQ]; gain = a->in[I_NFFN]; dst = (bf16_t*)(ws + W_WQ); ld = 2048; K = 1024; }
    else if (job < 14336) { r = job - 12288; src = a->in[I_WPG]; gain = a->in[I_NPLE]; dst = (bf16_t*)(ws + W_WPG); ld = 1024; K = 1024; }
    else { r = job - 14336; src = a->in[I_WPP]; dst = (bf16_t*)(ws + W_WPP); ld = 1024; K = 256; }
    const int nk = K >> 3, nb = r / nk, kb = r - nb * nk, n = nb * 64 + lane, k0 = kb * 8;
    float v[8];
#pragma unroll
    for (int j = 0; j < 8; ++j) v[j] = src[(size_t)(k0 + j) * ld + n];
    if (gain) {
#pragma unroll
        for (int j = 0; j < 8; ++j) v[j] *= gain[k0 + j]; }
    u32x4 w; w.x = cvt_pk_bf16(v[0], v[1]); w.y = cvt_pk_bf16(v[2], v[3]); w.z = cvt_pk_bf16(v[4], v[5]); w.w = cvt_pk_bf16(v[6], v[7]);
    *(u32x4*)(dst + (size_t)n * K + k0) = w;
}

__device__ __forceinline__ void grid_barrier(unsigned* cnt, unsigned round) {
    __syncthreads();
    if (tidx() < 64) {
        if (tidx() == 0) {
            const unsigned nW = gridDim.x, ng = nW < 8u ? nW : 8u, g = blockIdx.x % ng, gsz = (nW - g + ng - 1) / ng;
            const unsigned old = __hip_atomic_fetch_add(cnt + 64 * (1 + g), 1u, __ATOMIC_ACQ_REL, __HIP_MEMORY_SCOPE_AGENT);
            if (old + 1 == round * gsz) __hip_atomic_fetch_add(cnt, 1u, __ATOMIC_RELEASE, __HIP_MEMORY_SCOPE_AGENT);
            while (__hip_atomic_load(cnt, __ATOMIC_RELAXED, __HIP_MEMORY_SCOPE_AGENT) < round * ng) __builtin_amdgcn_s_sleep(2);
        }
        __builtin_amdgcn_fence(__ATOMIC_ACQUIRE, "agent");
    }
    __syncthreads();
}

__device__ __forceinline__ int win_colmap(int n) { if (n < 6144) return n; if (n < 11520) return n + 32; if (n < 11552) return 6144 + (n - 11520); return -1; }

__device__ __forceinline__ void transpose_tile(LAS float* tl, const float* __restrict__ src, int ld, const float* __restrict__ gain, bf16_t* __restrict__ dst, int K, int k0, int n0, bool remap) {
    const int tid = tidx(), nn = tid & 63, kk0 = tid >> 6;
    const int sc = remap ? win_colmap(n0 + nn) : n0 + nn;
#pragma unroll
    for (int i = 0; i < 8; ++i) { const int k = kk0 + i * 8; float v = 0.f; if (sc >= 0) { v = src[(size_t)(k0 + k) * ld + sc]; if (gain) v *= gain[k0 + k]; } tl[k * 65 + nn] = v; }
    bar();
    const int n = tid >> 3, ks = (tid & 7) * 8;
    u32x4 w; w.x = cvt_pk_bf16(tl[(ks + 0) * 65 + n], tl[(ks + 1) * 65 + n]); w.y = cvt_pk_bf16(tl[(ks + 2) * 65 + n], tl[(ks + 3) * 65 + n]);
    w.z = cvt_pk_bf16(tl[(ks + 4) * 65 + n], tl[(ks + 5) * 65 + n]); w.w = cvt_pk_bf16(tl[(ks + 6) * 65 + n], tl[(ks + 7) * 65 + n]);
    *(u32x4*)(dst + (size_t)(n0 + n) * K + k0 + ks) = w;
    bar();
}

__device__ __forceinline__ void phase_prep(KA a, LAS unsigned char* lds) {
    const int tid = tidx(), nW = gridDim.x, wg = blockIdx.x;
    LAS float* tl = (LAS float*)lds;
    unsigned char* ws = a->ws;
    {
        const float* src = a->in[I_WIN]; const float* gain = a->in[I_NMIX]; bf16_t* dst = (bf16_t*)(ws + W_WIN);
        const int nn = tid & 63, kk0 = tid >> 6;
        float v[8];
#define WIN_LOAD(t_) do { const int k0_ = ((t_) & 15) * 64, n0_ = ((t_) >> 4) * 64; const int sc_ = win_colmap(n0_ + nn); \
            _Pragma("unroll") for (int i = 0; i < 8; ++i) { const int k = kk0 + i * 8; v[i] = 0.f; if (sc_ >= 0) v[i] = src[(size_t)(k0_ + k) * 11552 + sc_] * gain[k0_ + k]; } } while (0)
        if (wg < 2944) WIN_LOAD(wg);
        for (int t = wg; t < 2944; t += nW) {
            const int k0 = (t & 15) * 64, n0 = (t >> 4) * 64;
#pragma unroll
            for (int i = 0; i < 8; ++i) tl[(kk0 + i * 8) * 65 + nn] = v[i];
            if (t + nW < 2944) WIN_LOAD(t + nW);
            bar_lds();
            const int n = tid >> 3, ks = (tid & 7) * 8;
            u32x4 w; w.x = cvt_pk_bf16(tl[(ks + 0) * 65 + n], tl[(ks + 1) * 65 + n]); w.y = cvt_pk_bf16(tl[(ks + 2) * 65 + n], tl[(ks + 3) * 65 + n]);
            w.z = cvt_pk_bf16(tl[(ks + 4) * 65 + n], tl[(ks + 5) * 65 + n]); w.w = cvt_pk_bf16(tl[(ks + 6) * 65 + n], tl[(ks + 7) * 65 + n]);
            *(u32x4*)(dst + (size_t)(n0 + n) * 1024 + k0 + ks) = w;
            bar_lds();
        }
    }
    const size_t gt = (size_t)wg * 512 + tid, gs = (size_t)nW * 512;
    {
        bf16_t* kd = (bf16_t*)(ws + W_K12);
        for (size_t i = gt; i < (size_t)2 * 131072; i += gs) {
            const int half = (int)(i >= 131072), j = (int)(i - (size_t)half * 131072), h = j >> 14, nd = j & 16383;
            kd[((size_t)(h * 2 + half) << 14) + nd] = f2bf(half ? a->in[I_K2][j] : a->in[I_K1][j]);
        }
        u32x2* pb = (u32x2*)(ws + W_PB);
        for (size_t i = gt; i < (size_t)TP * 64; i += gs) {
            const size_t row = i >> 6; f32x4 v = {0.f, 0.f, 0.f, 0.f};
            if (row < (size_t)NPR) v = ((const f32x4*)a->in[I_PP])[i]; else if (row < (size_t)T) v = ((const f32x4*)a->in[I_PS])[i - (size_t)NPR * 64];
            u32x2 o; o.x = cvt_pk_bf16(v[0], v[1]); o.y = cvt_pk_bf16(v[2], v[3]); pb[i] = o;
        }
        float* ss = (float*)(ws + W_SS);
        for (size_t i = gt; i < (size_t)3 * TP; i += gs) ss[TP + i] = 0.f;
        float* ssq = (float*)(ws + W_SSQ);
        for (size_t i = gt; i < (size_t)TP * 8; i += gs) ssq[i] = 0.f;
    }
    {
        const int lane = tid & 63, wv = wg * 8 + (tid >> 6), nwv = nW * 8;
        u32x2* xb = (u32x2*)(ws + W_XB); float* ss0 = (float*)(ws + W_SS);
        for (int row = wv; row < TP; row += nwv) {
            const f32x4* src = row < NPR ? (const f32x4*)(a->in[I_XP] + (size_t)row * 1024) : (const f32x4*)(a->in[I_XS] + (size_t)(row - NPR) * 1024);
            float s = 0.f; f32x4 v[4];
#pragma unroll
            for (int i = 0; i < 4; ++i) {
                v[i] = (f32x4){0.f, 0.f, 0.f, 0.f}; if (row < T) v[i] = src[i * 64 + lane];
                s += v[i][0] * v[i][0] + v[i][1] * v[i][1] + v[i][2] * v[i][2] + v[i][3] * v[i][3];
            }
            s = red64(s);
            const float rs = rsqrtf(s * (1.0f / 1024.0f) + EPS);
#pragma unroll
            for (int i = 0; i < 4; ++i) { u32x2 o; o.x = cvt_pk_bf16(v[i][0] * rs, v[i][1] * rs); o.y = cvt_pk_bf16(v[i][2] * rs, v[i][3] * rs); xb[(size_t)row * 256 + i * 64 + lane] = o; }
            if (lane == 0) ss0[row] = s;
        }
    }
}

typedef const f32x4 (&AccRef)[2][2][4][2];
struct EpiU {
    static constexpr bool PERM = true, AFTER_DRAIN = false;
    bf16_t *Z, *XBC, *RW, *G; float* DT; const float* ss0;
    __device__ __forceinline__ void operator()(AccRef acc, const pg8::Unit& u, int wr, int wc, int fr, int fq) const {
        const int row0 = u.pm * 256 + wr * 64 + fr, pn = u.pn;
        bf16_t* base; int ld, colt, kind;
        if (pn < 8) { base = Z; ld = 2048; colt = pn * 256; kind = 0; }
        else if (pn < 24) { base = XBC; ld = 4096; colt = (pn - 8) * 256; kind = 1; }
        else if (pn < 37) { base = RW; ld = 3328; colt = (pn - 24) * 256; kind = 1; }
        else if (pn < 45) { base = G; ld = 2048; colt = (pn - 37) * 256; kind = 2; }
        else { base = nullptr; ld = 0; colt = 0; kind = 3; }
        const int col0 = colt + wc * 32 + 8 * fq;
#pragma unroll
        for (int ai = 0; ai < 2; ++ai)
#pragma unroll
            for (int m = 0; m < 4; ++m) {
                const int row = row0 + ai * 128 + m * 16;
                const float rs = 1.0f;
                if (kind == 3) {
                    if (wc == 0) { const f32x4 v0 = acc[ai][0][m][0] * rs, v1 = acc[ai][0][m][1] * rs; *(f32x4*)(DT + (size_t)row * 32 + 8 * fq) = v0; *(f32x4*)(DT + (size_t)row * 32 + 8 * fq + 4) = v1; }
                } else if (kind != 0 || row < T) {
#pragma unroll
                    for (int bj = 0; bj < 2; ++bj) {
                        f32x4 v0 = acc[ai][bj][m][0] * rs, v1 = acc[ai][bj][m][1] * rs;
                        if (kind == 2) {
#pragma unroll
                            for (int j = 0; j < 4; ++j) { v0[j] = sigm(v0[j]); v1[j] = sigm(v1[j]); } }
                        u32x4 w; w.x = cvt_pk_bf16(v0[0], v0[1]); w.y = cvt_pk_bf16(v0[2], v0[3]); w.z = cvt_pk_bf16(v1[0], v1[1]); w.w = cvt_pk_bf16(v1[2], v1[3]);
                        *(u32x4*)(base + (size_t)row * ld + col0 + bj * 128) = w;
                    }
                }
            }
    }
};
struct EpiQ {
    static constexpr bool PERM = true, AFTER_DRAIN = false;
    bf16_t* O; int ld; const float* ss;
    static constexpr bool HAS_SS = false;
    __device__ __forceinline__ float* ssp() const { return nullptr; }
    __device__ __forceinline__ float elem(int row, int c, float v) const { O[(size_t)row * ld + c] = f2bf(v * rsqrtf(ss[row] * (1.0f / 1024.0f) + EPS)); return 0.f; }
    __device__ __forceinline__ void operator()(AccRef acc, const pg8::Unit& u, int wr, int wc, int fr, int fq) const {
        const int row0 = u.pm * 256 + wr * 64 + fr, col0 = u.pn * 256 + wc * 32 + 8 * fq;
        float rsv[8];
#pragma unroll
        for (int i = 0; i < 8; ++i) rsv[i] = ss[row0 + (i >> 2) * 128 + (i & 3) * 16];
#pragma unroll
        for (int i = 0; i < 8; ++i) rsv[i] = rsqrtf(rsv[i] * (1.0f / 1024.0f) + EPS);
#pragma unroll
        for (int ai = 0; ai < 2; ++ai)
#pragma unroll
            for (int m = 0; m < 4; ++m) {
                const int row = row0 + ai * 128 + m * 16; const float rs = rsv[ai * 4 + m];
#pragma unroll
                for (int bj = 0; bj < 2; ++bj) {
                    const f32x4 v0 = acc[ai][bj][m][0] * rs, v1 = acc[ai][bj][m][1] * rs;
                    u32x4 w; w.x = cvt_pk_bf16(v0[0], v0[1]); w.y = cvt_pk_bf16(v0[2], v0[3]); w.z = cvt_pk_bf16(v1[0], v1[1]); w.w = cvt_pk_bf16(v1[2], v1[3]);
                    *(u32x4*)(O + (size_t)row * ld + col0 + bj * 128) = w;
                }
            }
    }
};
template <int MODE> struct EpiMix {
    static constexpr bool PERM = false, AFTER_DRAIN = false;
    float* P; bf16_t* V; const bf16_t* G; int goff;
    static constexpr bool HAS_SS = false;
    __device__ __forceinline__ float* ssp() const { return nullptr; }
    __device__ __forceinline__ float elem(int row, int c, float v) const {
        if (MODE != 2) v *= bf2f(G[(size_t)row * 2048 + goff + c]);
        if (MODE == 1) V[(size_t)row * 1024 + c] = f2bf(v + P[(size_t)row * 1024 + c]); else P[(size_t)row * 1024 + c] = v;
        return 0.f; }
    __device__ __forceinline__ void operator()(AccRef acc, const pg8::Unit& u, int wr, int wc, int fr, int fq) const {
        const int row0 = u.pm * 256 + wr * 64 + fr, col0 = u.pn * 256 + wc * 32 + 4 * fq;
#pragma unroll
        for (int ai = 0; ai < 2; ++ai)
#pragma unroll
            for (int mp = 0; mp < 2; ++mp) {
                u32x2 gw[2][4]; f32x4 pv[2][4];
#pragma unroll
                for (int mm = 0; mm < 2; ++mm) { const int row = row0 + ai * 128 + (mp * 2 + mm) * 16;
#pragma unroll
                    for (int f = 0; f < 4; ++f) { const int c = col0 + (f >> 1) * 128 + (f & 1) * 16;
                        if (MODE != 2) gw[mm][f] = *(const u32x2*)(G + (size_t)row * 2048 + goff + c);
                        if (MODE == 1) pv[mm][f] = *(const f32x4*)(P + (size_t)row * 1024 + c); } }
#pragma unroll
                for (int mm = 0; mm < 2; ++mm) { const int m = mp * 2 + mm, row = row0 + ai * 128 + m * 16;
#pragma unroll
                    for (int f = 0; f < 4; ++f) { const int bj = f >> 1, n = f & 1, c = col0 + bj * 128 + n * 16; f32x4 v = acc[ai][bj][m][n];
                        if (MODE != 2) { v[0] *= bflo(gw[mm][f].x); v[1] *= bfhi(gw[mm][f].x); v[2] *= bflo(gw[mm][f].y); v[3] *= bfhi(gw[mm][f].y); }
                        if (MODE == 1) { v = v + pv[mm][f]; u32x2 o; o.x = cvt_pk_bf16(v[0], v[1]); o.y = cvt_pk_bf16(v[2], v[3]); *(u32x2*)(V + (size_t)row * 1024 + c) = o; }
                        else *(f32x4*)(P + (size_t)row * 1024 + c) = v; } }
                asm volatile("" ::: "memory");
            }
    }
};
template <int MODE> struct EpiRes {
    static constexpr bool PERM = false, AFTER_DRAIN = false;
    const float* xp; const float* xs; float* X; bf16_t* XB; float* ss; const float* ssin; const float* P;
    static constexpr bool HAS_SS = true;
    __device__ __forceinline__ float* ssp() const { return ss; }
    __device__ __forceinline__ float elem(int row, int c, float v) const {
        if (MODE == 0) v += xs[(size_t)(row - NPR) * 1024 + c];
        else v = xp[(size_t)row * 1024 + c] + sigm(v * rsqrtf(ssin[row] * (1.0f / 1024.0f) + EPS)) * P[(size_t)row * 1024 + c];
        X[(size_t)row * 1024 + c] = v; if (MODE == 0) XB[(size_t)row * 1024 + c] = f2bf(v);
        return v; }
    __device__ __forceinline__ void operator()(AccRef acc, const pg8::Unit& u, int wr, int wc, int fr, int fq) const {
        const int row0 = u.pm * 256 + wr * 64 + fr, col0 = u.pn * 256 + wc * 32 + 4 * fq;
#pragma unroll
        for (int ai = 0; ai < 2; ++ai)
#pragma unroll
            for (int mp = 0; mp < 2; ++mp) {
                f32x4 xin[2][4], pv[2][4]; float rsr[2];
#pragma unroll
                for (int mm = 0; mm < 2; ++mm) { const int row = row0 + ai * 128 + (mp * 2 + mm) * 16, rowc = row < T ? row : 0;
                    const float* src = MODE == 0 ? (rowc < NPR ? xp + (size_t)rowc * 1024 : xs + (size_t)(rowc - NPR) * 1024) : xp + (size_t)rowc * 1024;
                    rsr[mm] = MODE == 1 ? ssin[rowc] : 0.f;
#pragma unroll
                    for (int f = 0; f < 4; ++f) { const int c = col0 + (f >> 1) * 128 + (f & 1) * 16; xin[mm][f] = *(const f32x4*)(src + c); if (MODE == 1) pv[mm][f] = *(const f32x4*)(P + (size_t)rowc * 1024 + c); } }
#pragma unroll
                for (int mm = 0; mm < 2; ++mm) { const int m = mp * 2 + mm, row = row0 + ai * 128 + m * 16;
                    const float rs = MODE == 1 ? rsqrtf(rsr[mm] * (1.0f / 1024.0f) + EPS) : 0.f; float sq = 0.f;
#pragma unroll
                    for (int f = 0; f < 4; ++f) { const int bj = f >> 1, n = f & 1, c = col0 + bj * 128 + n * 16; f32x4 v = acc[ai][bj][m][n];
                        if (MODE == 1) {
#pragma unroll
                            for (int j = 0; j < 4; ++j) v[j] = sigm(v[j] * rs) * pv[mm][f][j]; }
                        v = v + xin[mm][f];
                        if (row < T) { *(f32x4*)(X + (size_t)row * 1024 + c) = v;
                            if (MODE == 0) { u32x2 o; o.x = cvt_pk_bf16(v[0], v[1]); o.y = cvt_pk_bf16(v[2], v[3]); *(u32x2*)(XB + (size_t)row * 1024 + c) = o; } }
                        sq += v[0] * v[0] + v[1] * v[1] + v[2] * v[2] + v[3] * v[3]; }
                    sq += __shfl_xor(sq, 16); sq += __shfl_xor(sq, 32);
                    if (fq == 0 && row < T) atomicAdd(ss + row, sq); }
                asm volatile("" ::: "memory");
            }
    }
};
template <class Epi> __device__ __forceinline__ void sample_gemm(const bf16_t* A, int lda, const bf16_t* Bt, int ldb, int N, int K, const Epi& E) {
    const int tid = tidx(), lane = tid & 63, wid = tid >> 6, quad = lane >> 4, l16 = lane & 15;
    for (int sl = blockIdx.x; sl < N / 16; sl += gridDim.x) {
        const bf16_t* ap = A + (size_t)(NPR + wid * 16 + l16) * lda + quad * 8; const bf16_t* bp = Bt + (size_t)(sl * 16 + l16) * ldb + quad * 8;
        f32x4 acc = {0.f, 0.f, 0.f, 0.f};
#pragma unroll 8
        for (int kk = 0; kk < K / 32; ++kk) acc = mfma16(*(const bf16x8*)(ap + kk * 32), *(const bf16x8*)(bp + kk * 32), acc);
#pragma unroll
        for (int j = 0; j < 4; ++j) { const int row = NPR + wid * 16 + quad * 4 + j; const float r = E.elem(row, sl * 16 + l16, acc[j]);
            if (Epi::HAS_SS) { const float sq = red16(r * r); if (l16 == 0) atomicAdd(E.ssp() + row, sq); } }
    }
}
template <class Epi, bool split_samples = true> __device__ __forceinline__ void run_gemm(LAS unsigned char* lds, const bf16_t* A, int lda, const bf16_t* Bt, int ldb, int N, int K, const Epi& E) {
    pg8::Gemm g; g.A = A; g.Bt = Bt; g.M = split_samples ? NPR : TP; g.N = N; g.K = K; g.lda = lda; g.ldb = ldb;
    pg8::StaticOrder S; S.init(g.M, N, gridDim.x, blockIdx.x);
    pg8::gemm_phase<Epi, pg8::StaticOrder>(lds, g, S, E);
    if constexpr (split_samples) sample_gemm(A, lda, Bt, ldb, N, K, E);
}

__device__ __forceinline__ float softplusf_(float x);
__device__ __forceinline__ float conv1_(KA a, const bf16_t* XBC, int b, size_t row, int col);
__device__ __forceinline__ void ssd_sample_quarter(KA a, LAS float* wl, int b, int hd, int sub, float& xv, float& xdt, float& dA, float& y) {
    const int lane = tidx() & 63, g = hd >> 2;
    const bf16_t* XBC = (const bf16_t*)(a->ws + W_XBC); const float* DT = (const float*)(a->ws + W_DT); bf16_t* Z = (bf16_t*)a->out; float* ssq = (float*)(a->ws + W_SSQ);
    const size_t row = (size_t)NPR + b;
    if (sub == 0) {
        xv = conv1_(a, XBC, b, row, hd * 64 + lane);
        wl[lane] = conv1_(a, XBC, b, row, 2048 + g * 128 + lane); wl[64 + lane] = conv1_(a, XBC, b, row, 2048 + g * 128 + 64 + lane);
        wl[128 + lane] = conv1_(a, XBC, b, row, 3072 + g * 128 + lane); wl[192 + lane] = conv1_(a, XBC, b, row, 3072 + g * 128 + 64 + lane);
        const float dtv = softplusf_(DT[row * 32 + hd] + a->in[I_DTB][hd]); dA = __expf(-__expf(a->in[I_ALOG][hd]) * dtv); xdt = dtv * xv; y = 0.f;
    }
    const size_t so = ((size_t)(b * 32 + hd) * 64 + lane) * 128 + sub * 32;
#pragma unroll
    for (int q = 0; q < 8; ++q) {
        f32x4 hv = *(const f32x4*)(a->in[I_SSSM] + so + q * 4); const f32x4 Bv = *(const LAS f32x4*)(wl + sub * 32 + q * 4), Cv = *(const LAS f32x4*)(wl + 128 + sub * 32 + q * 4);
        hv = hv * dA + Bv * xdt; y += hv[0] * Cv[0] + hv[1] * Cv[1] + hv[2] * Cv[2] + hv[3] * Cv[3];
        *(f32x4*)(a->out + O_SSMS + so + q * 4) = hv;
    }
    if (sub == 3) {
        const float yv = y + a->in[I_DSKIP][hd] * xv;
        bf16_t* zp = Z + row * 2048 + hd * 64 + lane; const float z = bf2f(*zp), yg = yv * z * sigm(z);
        *zp = f2bf(yg);
        const float sq = red64(yg * yg);
        if (lane == 0) atomicAdd(ssq + row * 8 + g, sq);
    }
}
__device__ __forceinline__ void rwkv_prompt_item(KA a, LAS unsigned char* lds, int b, int h) {
    const int item_ = b * 16 + h;
    const int tid = tidx(), lane = tid & 63, wid = tid >> 6, quad = lane >> 4, l16 = lane & 15;
    LAS bf16_t* WdT = (LAS bf16_t*)(lds);
    LAS bf16_t* WaT = (LAS bf16_t*)(lds + 9216);
    LAS bf16_t* WgT = (LAS bf16_t*)(lds + 18432);
    LAS bf16_t* AL = (LAS bf16_t*)(lds + 35840);
    LAS float* RAW = (LAS float*)(lds + 52736);
    LAS float* sR = (LAS float*)(lds + 78080);
    LAS float* sW = sR + 2048; LAS float* sK = sW + 2048; LAS float* sV = sK + 2048; LAS float* sA = sV + 2048; LAS float* sB = sA + 2048; LAS float* sG = sB + 2048; LAS float* sY = sG + 2048;
    LAS float* sBon = sY + 2048;
    bf16_t* RW = (bf16_t*)(a->ws + W_RW);
    const float* mu = a->in[I_MU];
    for (int i = tid; i < 4096; i += 512) { const int k = i >> 6, n = i & 63; WdT[n * 72 + k] = f2bf(a->in[I_W2][k * 1024 + h * 64 + n]); WaT[n * 72 + k] = f2bf(a->in[I_A2][k * 1024 + h * 64 + n]); }
    for (int i = tid; i < 8192; i += 512) { const int k = i >> 6, n = i & 63; WgT[n * 136 + k] = f2bf(a->in[I_G2][k * 1024 + h * 64 + n]); }
    if (tid < 192) RAW[tid] = 0.f;
    const int et = tid >> 4, j0 = (tid & 15) * 4;
    LAS float* CT = sBon + 32;
    if (tid < 64) { const int c = h * 64 + tid; CT[tid] = mu[c]; CT[64 + tid] = mu[1024 + c]; CT[128 + tid] = mu[2048 + c]; CT[192 + tid] = a->in[I_W0][c]; CT[256 + tid] = a->in[I_A0][c];
        CT[320 + tid] = a->in[I_KK][c]; CT[384 + tid] = a->in[I_KA][c]; CT[448 + tid] = a->in[I_RK][c]; CT[512 + tid] = a->in[I_LNG][c]; CT[576 + tid] = a->in[I_LNB][c]; }
    else if (tid >= 256) CT[640 + tid - 256] = mu[3072 + tid - 256];
    const int li0 = (tid & 15) * 16;
    const int srow = (wid & 3) * 16 + (lane >> 3) * 2, c0 = (lane & 7) * 8;
    float sq_xv = 0.f, sq_xdt = 0.f, sq_dA = 0.f, sq_y = 0.f;
    LAS float* wlq = (LAS float*)(lds + 147456 + (wid & 3) * 1024);
    f32x2 S[4], S1[4];
#pragma unroll
    for (int i = 0; i < 4; ++i) { S[i] = (f32x2){0.f, 0.f}; S1[i] = (f32x2){0.f, 0.f}; }
    bar();
    u32x2 pr[3]; u32x4 cA, cB, pA, pB;
#define RWKV_PREFETCH(chn) do { const size_t nb_ = (size_t)b * 2048 + (chn) * 32; \
        _Pragma("unroll") for (int ii = 0; ii < 3; ++ii) { const int i = tid + ii * 512, t = i / 48, rem = i - t * 48, part = rem >> 4, jj = (rem & 15) * 4; pr[ii] = *(const u32x2*)(RW + (nb_ + t) * 3328 + part * 1024 + h * 64 + jj); } \
        const bf16_t* cp = RW + (nb_ + et) * 3328 + 3072 + li0; cA = *(const u32x4*)cp; cB = *(const u32x4*)(cp + 8); \
        pA = (u32x4){0u, 0u, 0u, 0u}; pB = pA; if ((chn) > 0 || et > 0) { pA = *(const u32x4*)(cp - 3328); pB = *(const u32x4*)(cp - 3328 + 8); } } while (0)
    RWKV_PREFETCH(0);
#pragma unroll 1
    for (int ch = 0; ch < 64; ++ch) {
        const size_t base = (size_t)b * 2048 + ch * 32;
#pragma unroll
        for (int ii = 0; ii < 3; ++ii) {
            const int i = tid + ii * 512, t = i / 48, rem = i - t * 48, part = rem >> 4, jj = (rem & 15) * 4;
            const u32x2 w = pr[ii];
            *(LAS f32x4*)(RAW + (t + 1) * 192 + part * 64 + jj) = (f32x4){bflo(w.x), bfhi(w.x), bflo(w.y), bfhi(w.y)};
        }
        {
            float o[16];
#pragma unroll
            for (int q = 0; q < 8; ++q) {
                const unsigned cw = q < 4 ? cA[q] : cB[q - 4], pw = q < 4 ? pA[q] : pB[q - 4];
                const float m0 = CT[640 + li0 + 2 * q], m1 = CT[640 + li0 + 2 * q + 1];
                const float x0 = bflo(cw), x1 = bfhi(cw);
                o[2 * q] = x0 + (bflo(pw) - x0) * m0; o[2 * q + 1] = x1 + (bfhi(pw) - x1) * m1;
            }
            if (li0 < 64) {
#pragma unroll
                for (int q = 0; q < 16; ++q) o[q] = tanh_fast(o[q]); }
            else if (li0 >= 128) {
#pragma unroll
                for (int q = 0; q < 16; ++q) o[q] = sigm(o[q]); }
            u32x4 w0, w1;
            w0.x = cvt_pk_bf16(o[0], o[1]); w0.y = cvt_pk_bf16(o[2], o[3]); w0.z = cvt_pk_bf16(o[4], o[5]); w0.w = cvt_pk_bf16(o[6], o[7]);
            w1.x = cvt_pk_bf16(o[8], o[9]); w1.y = cvt_pk_bf16(o[10], o[11]); w1.z = cvt_pk_bf16(o[12], o[13]); w1.w = cvt_pk_bf16(o[14], o[15]);
            *(LAS u32x4*)(AL + et * 264 + li0) = w0; *(LAS u32x4*)(AL + et * 264 + li0 + 8) = w1;
        }
        bar_lds();
        {
            const int rb = wid >> 2, cb = wid & 3;
            const LAS bf16_t* ar = AL + (rb * 16 + l16) * 264 + quad * 8;
            f32x4 lw = {0.f, 0.f, 0.f, 0.f}, la = lw, lg = lw;
#pragma unroll
            for (int kk = 0; kk < 2; ++kk) {
                lw = mfma16(*(const LAS bf16x8*)(ar + kk * 32), *(const LAS bf16x8*)(WdT + (cb * 16 + l16) * 72 + kk * 32 + quad * 8), lw);
                la = mfma16(*(const LAS bf16x8*)(ar + 64 + kk * 32), *(const LAS bf16x8*)(WaT + (cb * 16 + l16) * 72 + kk * 32 + quad * 8), la);
            }
#pragma unroll
            for (int kk = 0; kk < 4; ++kk) lg = mfma16(*(const LAS bf16x8*)(ar + 128 + kk * 32), *(const LAS bf16x8*)(WgT + (cb * 16 + l16) * 136 + kk * 32 + quad * 8), lg);
#pragma unroll
            for (int j = 0; j < 4; ++j) { const int o = (rb * 16 + quad * 4 + j) * 64 + cb * 16 + l16; sW[o] = lw[j]; sA[o] = la[j]; sG[o] = lg[j]; }
        }
        bar_lds();
        {
            float kkf[4], al[4]; float ssk = 0.f, bon = 0.f;
            const f32x4 c_mur = *(const LAS f32x4*)(CT + j0), c_muk = *(const LAS f32x4*)(CT + 64 + j0), c_muv = *(const LAS f32x4*)(CT + 128 + j0), c_w0 = *(const LAS f32x4*)(CT + 192 + j0),
                        c_a0 = *(const LAS f32x4*)(CT + 256 + j0), c_kk = *(const LAS f32x4*)(CT + 320 + j0), c_ka = *(const LAS f32x4*)(CT + 384 + j0), c_rk = *(const LAS f32x4*)(CT + 448 + j0);
            const int ob = et * 64 + j0;
            const f32x4 rc4 = *(const LAS f32x4*)(RAW + (et + 1) * 192 + j0), rp4 = *(const LAS f32x4*)(RAW + et * 192 + j0), kc4 = *(const LAS f32x4*)(RAW + (et + 1) * 192 + 64 + j0), kp4 = *(const LAS f32x4*)(RAW + et * 192 + 64 + j0),
                        vc4 = *(const LAS f32x4*)(RAW + (et + 1) * 192 + 128 + j0), vp4 = *(const LAS f32x4*)(RAW + et * 192 + 128 + j0), lw4 = *(const LAS f32x4*)(sW + ob), la4 = *(const LAS f32x4*)(sA + ob);
            f32x4 r4, d4, k4, v4, a4, b4;
#pragma unroll
            for (int q = 0; q < 4; ++q) {
                const float r = rc4[q] + (rp4[q] - rc4[q]) * c_mur[q], k = kc4[q] + (kp4[q] - kc4[q]) * c_muk[q], v = vc4[q] + (vp4[q] - vc4[q]) * c_muv[q];
                const float dec = __expf(-0.60653066f * sigm(c_w0[q] + lw4[q]));
                al[q] = sigm(c_a0[q] + la4[q]);
                kkf[q] = k * c_kk[q]; ssk += kkf[q] * kkf[q];
                const float kn = k * (1.0f + (al[q] - 1.0f) * c_ka[q]); bon += r * kn * c_rk[q];
                r4[q] = r; d4[q] = dec; k4[q] = kn; v4[q] = v;
            }
            ssk = red16(ssk); bon = red16(bon);
            const float inv = rsqrtf(ssk + 1e-12f);
#pragma unroll
            for (int q = 0; q < 4; ++q) { const float kk = kkf[q] * inv; a4[q] = -kk; b4[q] = kk * al[q]; }
            *(LAS f32x4*)(sR + ob) = r4; *(LAS f32x4*)(sW + ob) = d4; *(LAS f32x4*)(sK + ob) = k4; *(LAS f32x4*)(sV + ob) = v4; *(LAS f32x4*)(sA + ob) = a4; *(LAS f32x4*)(sB + ob) = b4;
            if ((tid & 15) == 0) sBon[et] = bon;
        }
        bar_lds();
        if (ch < 63) RWKV_PREFETCH(ch + 1);
        if (wid < 4) {
            const LAS float* sp = sR + c0;
            f32x4 nr0 = *(const LAS f32x4*)(sp), nr1 = *(const LAS f32x4*)(sp + 4), nw0 = *(const LAS f32x4*)(sp + 2048), nw1 = *(const LAS f32x4*)(sp + 2048 + 4);
            f32x4 nk0 = *(const LAS f32x4*)(sp + 4096), nk1 = *(const LAS f32x4*)(sp + 4096 + 4), na0 = *(const LAS f32x4*)(sp + 8192), na1 = *(const LAS f32x4*)(sp + 8192 + 4);
            f32x4 nb0 = *(const LAS f32x4*)(sp + 10240), nb1 = *(const LAS f32x4*)(sp + 10240 + 4); f32x2 nv = *(const LAS f32x2*)(sV + srow);
#pragma unroll 2
            for (int t = 0; t < 32; ++t) {
                const f32x4 r0 = nr0, r1 = nr1, w0 = nw0, w1 = nw1, k0 = nk0, k1 = nk1, a0 = na0, a1 = na1, b0 = nb0, b1 = nb1; const f32x2 v2 = nv;
                {
                    const int tn = t < 31 ? t + 1 : 31; const LAS float* sn = sR + tn * 64 + c0;
                    nr0 = *(const LAS f32x4*)(sn); nr1 = *(const LAS f32x4*)(sn + 4); nw0 = *(const LAS f32x4*)(sn + 2048); nw1 = *(const LAS f32x4*)(sn + 2048 + 4);
                    nk0 = *(const LAS f32x4*)(sn + 4096); nk1 = *(const LAS f32x4*)(sn + 4096 + 4); na0 = *(const LAS f32x4*)(sn + 8192); na1 = *(const LAS f32x4*)(sn + 8192 + 4);
                    nb0 = *(const LAS f32x4*)(sn + 10240); nb1 = *(const LAS f32x4*)(sn + 10240 + 4); nv = *(const LAS f32x2*)(sV + tn * 64 + srow);
                }
                const f32x2 av[4] = {{a0[0], a0[1]}, {a0[2], a0[3]}, {a1[0], a1[1]}, {a1[2], a1[3]}}, bv[4] = {{b0[0], b0[1]}, {b0[2], b0[3]}, {b1[0], b1[1]}, {b1[2], b1[3]}};
                const f32x2 wv[4] = {{w0[0], w0[1]}, {w0[2], w0[3]}, {w1[0], w1[1]}, {w1[2], w1[3]}}, kv[4] = {{k0[0], k0[1]}, {k0[2], k0[3]}, {k1[0], k1[1]}, {k1[2], k1[3]}};
                const f32x2 rv[4] = {{r0[0], r0[1]}, {r0[2], r0[3]}, {r1[0], r1[1]}, {r1[2], r1[3]}};
                f32x2 p = S[0] * av[0]; p = S[1] * av[1] + p; p = S[2] * av[2] + p; p = S[3] * av[3] + p;
                f32x2 p1 = S1[0] * av[0]; p1 = S1[1] * av[1] + p1; p1 = S1[2] * av[2] + p1; p1 = S1[3] * av[3] + p1;
                const float sa = red8(p.x + p.y), sa1 = red8(p1.x + p1.y);
                const f32x2 vv = {v2.x, v2.x}, sav = {sa, sa}, vv1 = {v2.y, v2.y}, sav1 = {sa1, sa1};
#pragma unroll
                for (int i = 0; i < 4; ++i) { const f32x2 u = S[i] * wv[i] + vv * kv[i]; S[i] = sav * bv[i] + u; const f32x2 u1 = S1[i] * wv[i] + vv1 * kv[i]; S1[i] = sav1 * bv[i] + u1; }
                f32x2 y2 = S[0] * rv[0]; y2 = S[1] * rv[1] + y2; y2 = S[2] * rv[2] + y2; y2 = S[3] * rv[3] + y2;
                f32x2 y3 = S1[0] * rv[0]; y3 = S1[1] * rv[1] + y3; y3 = S1[2] * rv[2] + y3; y3 = S1[3] * rv[3] + y3;
                const float y = red8(y2.x + y2.y), y1 = red8(y3.x + y3.y);
                if ((lane & 7) == 0) *(LAS f32x2*)(sY + t * 64 + srow) = (f32x2){y, y1};
            }
        } else {
            const int slot_ = (item_ * 4 + (wid - 4)) * 64 + ch;
            peer_quant_row(a, slot_);
            if (slot_ < N_LATE_JOBS) late_transpose_job(a, slot_);
            if (ch < 32) { const int sidx = (ch >> 2) * 512 + item_ * 4 + (wid - 4); ssd_sample_quarter(a, wlq, sidx >> 5, sidx & 31, ch & 3, sq_xv, sq_xdt, sq_dA, sq_y); }
        }
        bar_lds();
        {
            const int ob = et * 64 + j0;
            const f32x4 y4 = *(const LAS f32x4*)(sY + ob), v4 = *(const LAS f32x4*)(sV + ob), g4 = *(const LAS f32x4*)(sG + ob);
            float y[4]; float s = 0.f;
#pragma unroll
            for (int q = 0; q < 4; ++q) { y[q] = y4[q]; s += y[q]; }
            const float mean = red16(s) * (1.0f / 64.0f); float vs = 0.f;
#pragma unroll
            for (int q = 0; q < 4; ++q) { y[q] -= mean; vs += y[q] * y[q]; }
            const float inv = rsqrtf(red16(vs) * (1.0f / 64.0f) + 64e-5f), bon = sBon[et];
            const f32x4 c_lg = *(const LAS f32x4*)(CT + 512 + j0), c_lb = *(const LAS f32x4*)(CT + 576 + j0);
            float o[4];
#pragma unroll
            for (int q = 0; q < 4; ++q) o[q] = ((y[q] * inv * c_lg[q] + c_lb[q]) + bon * v4[q]) * g4[q];
            u32x2 w; w.x = cvt_pk_bf16(o[0], o[1]); w.y = cvt_pk_bf16(o[2], o[3]);
            *(u32x2*)(RW + (base + et) * 3328 + h * 64 + j0) = w;
            if (tid < 192) RAW[tid] = RAW[32 * 192 + tid];
        }
        bar_lds();
    }
    {
        if (wid < 4) {
            float* ws_ = a->out + O_WKVP + ((size_t)(b * 16 + h) * 64 + srow) * 64 + c0;
            *(f32x4*)ws_ = (f32x4){S[0].x, S[0].y, S[1].x, S[1].y}; *(f32x4*)(ws_ + 4) = (f32x4){S[2].x, S[2].y, S[3].x, S[3].y};
            *(f32x4*)(ws_ + 64) = (f32x4){S1[0].x, S1[0].y, S1[1].x, S1[1].y}; *(f32x4*)(ws_ + 68) = (f32x4){S1[2].x, S1[2].y, S1[3].x, S1[3].y};
        }
        if (tid < 192) a->out[O_SHIFTP + (size_t)b * 3328 + (tid >> 6) * 1024 + h * 64 + (tid & 63)] = RAW[tid];
        if (h == 0 && tid < 256) a->out[O_SHIFTP + (size_t)b * 3328 + 3072 + tid] = bf2f(RW[((size_t)b * 2048 + 2047) * 3328 + 3072 + tid]);
    }
    bar();
}

__device__ __forceinline__ void rwkv_sample_wave(KA a, LAS float* wl, int b, int h) {
    const int lane = tidx() & 63, c = h * 64 + lane;
    bf16_t* RW = (bf16_t*)(a->ws + W_RW);
    const float* mu = a->in[I_MU]; const float* prevs = a->in[I_SSHIFT] + (size_t)b * 3328;
    const size_t row = (size_t)NPR + b;
    {
        const int i0 = lane * 4;
        const u32x2 cw = *(const u32x2*)(RW + row * 3328 + 3072 + i0); const f32x4 pv = *(const f32x4*)(prevs + 3072 + i0), mv = *(const f32x4*)(mu + 3072 + i0);
        f32x4 cur = {bflo(cw.x), bfhi(cw.x), bflo(cw.y), bfhi(cw.y)}, xs = cur + (pv - cur) * mv, o;
#pragma unroll
        for (int q = 0; q < 4; ++q) o[q] = lane < 16 ? tanh_fast(xs[q]) : (lane < 32 ? xs[q] : sigm(xs[q]));
        *(LAS f32x4*)(wl + i0) = o;
        if (h == 0) *(f32x4*)(a->out + O_SHIFTS + (size_t)b * 3328 + 3072 + i0) = cur;
    }
    float rr, kk_, vv;
    {
        const float rc = bf2f(RW[row * 3328 + c]), kc = bf2f(RW[row * 3328 + 1024 + c]), vc = bf2f(RW[row * 3328 + 2048 + c]);
        rr = rc + (prevs[c] - rc) * mu[c]; kk_ = kc + (prevs[1024 + c] - kc) * mu[1024 + c]; vv = vc + (prevs[2048 + c] - vc) * mu[2048 + c];
        float* so = a->out + O_SHIFTS + (size_t)b * 3328; so[c] = rc; so[1024 + c] = kc; so[2048 + c] = vc;
    }
    float lw = 0.f, la = 0.f, lg = 0.f;
    {
        const float* pw = a->in[I_W2] + c; const float* pa = a->in[I_A2] + c; const float* pg = a->in[I_G2] + c;
#pragma unroll 8
        for (int k = 0; k < 64; ++k) { lw += wl[k] * pw[0]; la += wl[64 + k] * pa[0]; pw += 1024; pa += 1024; }
        asm volatile("" ::: "memory");
#pragma unroll 16
        for (int k = 0; k < 128; ++k) { lg += wl[128 + k] * pg[0]; pg += 1024; }
        asm volatile("" ::: "memory");
    }
    const float dec = __expf(-0.60653066f * sigm(a->in[I_W0][c] + lw)), al = sigm(a->in[I_A0][c] + la);
    const float kkf = kk_ * a->in[I_KK][c], ssk = red64(kkf * kkf), kn = kk_ * (1.0f + (al - 1.0f) * a->in[I_KA][c]), bon = red64(rr * kn * a->in[I_RK][c]);
    const float kkn = kkf * rsqrtf(ssk + 1e-12f);
    LAS float* vw = wl + 256;
    vw[lane] = rr; vw[64 + lane] = dec; vw[128 + lane] = kn; vw[192 + lane] = -kkn; vw[256 + lane] = kkn * al;
    const size_t so = ((size_t)(b * 16 + h) * 64 + lane) * 64;
    float sa = 0.f;
#pragma unroll 8
    for (int q = 0; q < 16; ++q) { const f32x4 Sv = *(const f32x4*)(a->in[I_SWKV] + so + q * 4), av = *(const LAS f32x4*)(vw + 192 + q * 4); sa += Sv[0] * av[0] + Sv[1] * av[1] + Sv[2] * av[2] + Sv[3] * av[3]; }
    float y = 0.f;
#pragma unroll 8
    for (int q = 0; q < 16; ++q) {
        const f32x4 wv = *(const LAS f32x4*)(vw + 64 + q * 4), kv = *(const LAS f32x4*)(vw + 128 + q * 4), bv = *(const LAS f32x4*)(vw + 256 + q * 4), rv = *(const LAS f32x4*)(vw + q * 4);
        f32x4 Sv = *(const f32x4*)(a->in[I_SWKV] + so + q * 4);
        Sv = Sv * wv + kv * vv + bv * sa;
        y += Sv[0] * rv[0] + Sv[1] * rv[1] + Sv[2] * rv[2] + Sv[3] * rv[3];
        *(f32x4*)(a->out + O_WKVS + so + q * 4) = Sv;
    }
    const float mean = red64(y) * (1.0f / 64.0f), d = y - mean, var = red64(d * d) * (1.0f / 64.0f);
    const float o = ((d * rsqrtf(var + 64e-5f) * a->in[I_LNG][c] + a->in[I_LNB][c]) + bon * vv) * lg;
    RW[row * 3328 + c] = f2bf(o);
}

__device__ __forceinline__ float softplusf_(float x) { return x > 20.f ? x : log1pf(__expf(x)); }
__device__ __forceinline__ void ssd_prompt_item(KA a, LAS unsigned char* lds, int b, int hd) {
    const int tid = tidx(), lane = tid & 63, wid = tid >> 6, quad = lane >> 4, l16 = lane & 15, g = hd >> 2;
    LAS bf16_t* Cb = (LAS bf16_t*)(lds);
    LAS bf16_t* Bb = (LAS bf16_t*)(lds + 17408);
    LAS bf16_t* BT = (LAS bf16_t*)(lds + 34816);
    LAS bf16_t* XT = (LAS bf16_t*)(lds + 53248);
    LAS bf16_t* XTd = (LAS bf16_t*)(lds + 62464);
    LAS bf16_t* Mb = (LAS bf16_t*)(lds + 71680);
    LAS bf16_t* Hb = (LAS bf16_t*)(lds + 80896);
    LAS float* sdt = (LAS float*)(lds + 98304); LAS float* sac = sdt + 64; LAS float* seac = sac + 64; LAS float* sdd = seac + 64; LAS float* sdec = sdd + 64;
    const bf16_t* XBC = (const bf16_t*)(a->ws + W_XBC); const float* DT = (const float*)(a->ws + W_DT); bf16_t* Z = (bf16_t*)a->out; float* ssq = (float*)(a->ws + W_SSQ);
    const int cg_ = tid % 40, strip = tid / 40;
    int ccol, kind, loc;
    if (cg_ < 8) { kind = 0; loc = cg_ * 8; ccol = hd * 64 + loc; } else if (cg_ < 24) { kind = 1; loc = (cg_ - 8) * 8; ccol = 2048 + g * 128 + loc; } else { kind = 2; loc = (cg_ - 24) * 8; ccol = 3072 + g * 128 + loc; }
    LAS float* CW = sdec + 64;
    if (tid < 40) {
#pragma unroll
        for (int q = 0; q < 8; ++q) { CW[tid * 40 + 32 + q] = a->in[I_CONVB][ccol + q];
#pragma unroll
            for (int k = 0; k < 4; ++k) CW[tid * 40 + k * 8 + q] = a->in[I_CONVW][k * 4096 + ccol + q]; }
    }
    u32x4 rows[11]; float dtn = 0.f;
#define SSD_PREFETCH(chn) do { if (tid < 320) { _Pragma("unroll") for (int k = 0; k < 11; ++k) { const int tg = (chn) * 64 + strip * 8 - 3 + k; rows[k] = (u32x4){0u, 0u, 0u, 0u}; \
            if (tg >= 0) rows[k] = *(const u32x4*)(XBC + ((size_t)b * 2048 + tg) * 4096 + ccol); } } else if (wid == 7) dtn = DT[((size_t)b * 2048 + (chn) * 64 + lane) * 32 + hd]; } while (0)
    SSD_PREFETCH(0);
    bar();
    const float Ah = -__expf(a->in[I_ALOG][hd]), dtb = a->in[I_DTB][hd], dsk = a->in[I_DSKIP][hd];
    const int pt = wid >> 1, ntb = (wid & 1) * 4;
    f32x4 hacc[4];
#pragma unroll
    for (int i = 0; i < 4; ++i) hacc[i] = (f32x4){0.f, 0.f, 0.f, 0.f};
#pragma unroll 1
    for (int ch = 0; ch < 32; ++ch) {
        const size_t row0 = (size_t)b * 2048 + ch * 64;
        bf16_t zq[2][4];
#pragma unroll
        for (int tt = 0; tt < 2; ++tt) { const int tile = wid * 2 + tt, lt = tile >> 2, pc = tile & 3;
#pragma unroll
            for (int j = 0; j < 4; ++j) zq[tt][j] = Z[(row0 + lt * 16 + quad * 4 + j) * 2048 + hd * 64 + pc * 16 + l16]; }
        if (tid < 320) {
#pragma unroll
            for (int hq = 0; hq < 2; ++hq) {
                f32x2 cwp[4][2], cbp[2], xr[11][2];
                { const f32x4 t0 = *(const LAS f32x4*)(CW + cg_ * 40 + hq * 4), t1 = *(const LAS f32x4*)(CW + cg_ * 40 + 8 + hq * 4), t2 = *(const LAS f32x4*)(CW + cg_ * 40 + 16 + hq * 4),
                              t3 = *(const LAS f32x4*)(CW + cg_ * 40 + 24 + hq * 4), tb = *(const LAS f32x4*)(CW + cg_ * 40 + 32 + hq * 4);
                  cwp[0][0] = (f32x2){t0[0], t0[1]}; cwp[0][1] = (f32x2){t0[2], t0[3]}; cwp[1][0] = (f32x2){t1[0], t1[1]}; cwp[1][1] = (f32x2){t1[2], t1[3]};
                  cwp[2][0] = (f32x2){t2[0], t2[1]}; cwp[2][1] = (f32x2){t2[2], t2[3]}; cwp[3][0] = (f32x2){t3[0], t3[1]}; cwp[3][1] = (f32x2){t3[2], t3[3]};
                  cbp[0] = (f32x2){tb[0], tb[1]}; cbp[1] = (f32x2){tb[2], tb[3]}; }
#pragma unroll
                for (int k = 0; k < 11; ++k) { const unsigned wa_ = rows[k][2 * hq], wb_ = rows[k][2 * hq + 1]; xr[k][0] = (f32x2){bflo(wa_), bfhi(wa_)}; xr[k][1] = (f32x2){bflo(wb_), bfhi(wb_)}; }
                const int lc = loc + hq * 4;
                unsigned colpk[4][4];
#pragma unroll
                for (int rp = 0; rp < 4; ++rp) {
                    float o[2][4];
#pragma unroll
                    for (int rr = 0; rr < 2; ++rr) { const int r = rp * 2 + rr;
#pragma unroll
                        for (int pq = 0; pq < 2; ++pq) {
                            f32x2 v = cwp[0][pq] * xr[r][pq] + cbp[pq]; v = cwp[1][pq] * xr[r + 1][pq] + v; v = cwp[2][pq] * xr[r + 2][pq] + v; v = cwp[3][pq] * xr[r + 3][pq] + v;
                            o[rr][2 * pq] = v.x * sigm(v.x); o[rr][2 * pq + 1] = v.y * sigm(v.y); }
                        if (kind != 0) { const int s = strip * 8 + r;
                            u32x2 pk; pk.x = cvt_pk_bf16(o[rr][0], o[rr][1]); pk.y = cvt_pk_bf16(o[rr][2], o[rr][3]);
                            if (kind == 1) *(LAS u32x2*)(Bb + s * 136 + lc) = pk; else *(LAS u32x2*)(Cb + s * 136 + lc) = pk; } }
#pragma unroll
                    for (int q = 0; q < 4; ++q) colpk[q][rp] = cvt_pk_bf16(o[0][q], o[1][q]);
                }
                if (kind != 2) {
                    LAS bf16_t* TT = kind == 0 ? XT : BT;
#pragma unroll
                    for (int q = 0; q < 4; ++q) *(LAS u32x4*)(TT + (lc + q) * 72 + strip * 8) = (u32x4){colpk[q][0], colpk[q][1], colpk[q][2], colpk[q][3]};
                }
                asm volatile("" ::: "memory");
            }
        } else if (wid == 7) {
            const float dtv = softplusf_(dtn + dtb);
            float x = dtv * Ah;
#pragma unroll
            for (int off = 1; off < 64; off <<= 1) { const float t = __shfl_up(x, off); if (lane >= off) x += t; }
            const float last = __shfl(x, 63);
            sdt[lane] = dtv; sac[lane] = x; seac[lane] = __expf(x); sdd[lane] = __expf(last - x) * dtv; if (lane == 63) sdec[0] = __expf(x);
        }
#pragma unroll
        for (int i = 0; i < 4; ++i)
#pragma unroll
            for (int j = 0; j < 4; ++j) Hb[(pt * 16 + quad * 4 + j) * 136 + (ntb + i) * 16 + l16] = f2bf(hacc[i][j]);
        if (ch < 31) SSD_PREFETCH(ch + 1);
        bar_lds();
        {
            const int p = tid >> 3, s8 = (tid & 7) * 8;
            const u32x4 w = *(const LAS u32x4*)(XT + p * 72 + s8); u32x4 o;
#pragma unroll
            for (int q = 0; q < 4; ++q) o[q] = cvt_pk_bf16(bflo(w[q]) * sdd[s8 + 2 * q], bfhi(w[q]) * sdd[s8 + 2 * q + 1]);
            *(LAS u32x4*)(XTd + p * 72 + s8) = o;
        }
#pragma unroll
        for (int tt = 0; tt < 2; ++tt) {
            const int tile = wid * 2 + tt, lt = tile >> 2, st = tile & 3;
            f32x4 acc = {0.f, 0.f, 0.f, 0.f};
            if (st <= lt) {
#pragma unroll
                for (int kk = 0; kk < 4; ++kk) acc = mfma16(*(const LAS bf16x8*)(Cb + (lt * 16 + l16) * 136 + kk * 32 + quad * 8), *(const LAS bf16x8*)(Bb + (st * 16 + l16) * 136 + kk * 32 + quad * 8), acc);
            }
            const int s = st * 16 + l16; const float as = sac[s], ds = sdt[s];
#pragma unroll
            for (int j = 0; j < 4; ++j) { const int l = lt * 16 + quad * 4 + j; const float v = (s <= l) ? acc[j] * __expf(fminf(sac[l] - as, 0.f)) * ds : 0.f; Mb[l * 72 + s] = f2bf(v); }
        }
        bar_lds();
#pragma unroll
        for (int tt = 0; tt < 2; ++tt) {
            const int tile = wid * 2 + tt, lt = tile >> 2, pc = tile & 3;
            f32x4 acc = {0.f, 0.f, 0.f, 0.f};
#pragma unroll
            for (int kk = 0; kk < 4; ++kk) acc = mfma16(*(const LAS bf16x8*)(Cb + (lt * 16 + l16) * 136 + kk * 32 + quad * 8), *(const LAS bf16x8*)(Hb + (pc * 16 + l16) * 136 + kk * 32 + quad * 8), acc);
#pragma unroll
            for (int j = 0; j < 4; ++j) acc[j] *= seac[lt * 16 + quad * 4 + j];
#pragma unroll
            for (int kk = 0; kk < 2; ++kk) acc = mfma16(*(const LAS bf16x8*)(Mb + (lt * 16 + l16) * 72 + kk * 32 + quad * 8), *(const LAS bf16x8*)(XT + (pc * 16 + l16) * 72 + kk * 32 + quad * 8), acc);
            const int p = pc * 16 + l16;
#pragma unroll
            for (int j = 0; j < 4; ++j) {
                const int l = lt * 16 + quad * 4 + j;
                const float yv = acc[j] + dsk * bf2f(XT[p * 72 + l]);
                bf16_t* zp = Z + (row0 + l) * 2048 + hd * 64 + p;
                const float z = bf2f(zq[tt][j]), yg = yv * z * sigm(z);
                *zp = f2bf(yg);
                const float sq = red16(yg * yg);
                if (l16 == 0) atomicAdd(ssq + (row0 + l) * 8 + g, sq);
            }
        }
        {
            const float dec = sdec[0];
#pragma unroll
            for (int i = 0; i < 4; ++i) {
                hacc[i] = hacc[i] * dec;
#pragma unroll
                for (int kk = 0; kk < 2; ++kk) hacc[i] = mfma16(*(const LAS bf16x8*)(XTd + (pt * 16 + l16) * 72 + kk * 32 + quad * 8), *(const LAS bf16x8*)(BT + ((ntb + i) * 16 + l16) * 72 + kk * 32 + quad * 8), hacc[i]);
            }
        }
        bar_lds();
    }
#pragma unroll
    for (int i = 0; i < 4; ++i)
#pragma unroll
        for (int j = 0; j < 4; ++j) a->out[O_SSMP + ((size_t)(b * 32 + hd) * 64 + pt * 16 + quad * 4 + j) * 128 + (ntb + i) * 16 + l16] = hacc[i][j];
}

__device__ __forceinline__ float conv1_(KA a, const bf16_t* XBC, int b, size_t row, int col) {
    const float* sc = a->in[I_SCONV] + (size_t)b * 12288 + col;
    const float v = a->in[I_CONVB][col] + a->in[I_CONVW][col] * sc[0] + a->in[I_CONVW][4096 + col] * sc[4096] + a->in[I_CONVW][8192 + col] * sc[8192] + a->in[I_CONVW][12288 + col] * bf2f(XBC[row * 4096 + col]);
    return v * sigm(v);
}
__device__ __forceinline__ void ssd_sample_wave(KA a, LAS float* wl, int b, int hd) {
    const int lane = tidx() & 63, g = hd >> 2;
    const bf16_t* XBC = (const bf16_t*)(a->ws + W_XBC); const float* DT = (const float*)(a->ws + W_DT); bf16_t* Z = (bf16_t*)a->out; float* ssq = (float*)(a->ws + W_SSQ);
    const size_t row = (size_t)NPR + b;
    const float xv = conv1_(a, XBC, b, row, hd * 64 + lane);
    wl[lane] = conv1_(a, XBC, b, row, 2048 + g * 128 + lane); wl[64 + lane] = conv1_(a, XBC, b, row, 2048 + g * 128 + 64 + lane);
    wl[128 + lane] = conv1_(a, XBC, b, row, 3072 + g * 128 + lane); wl[192 + lane] = conv1_(a, XBC, b, row, 3072 + g * 128 + 64 + lane);
    const float dtv = softplusf_(DT[row * 32 + hd] + a->in[I_DTB][hd]), dA = __expf(-__expf(a->in[I_ALOG][hd]) * dtv), xdt = dtv * xv;
    const size_t so = ((size_t)(b * 32 + hd) * 64 + lane) * 128;
    float y = 0.f;
#pragma unroll 8
    for (int q = 0; q < 32; ++q) {
        f32x4 hv = *(const f32x4*)(a->in[I_SSSM] + so + q * 4); const f32x4 Bv = *(const LAS f32x4*)(wl + q * 4), Cv = *(const LAS f32x4*)(wl + 128 + q * 4);
        hv = hv * dA + Bv * xdt; y += hv[0] * Cv[0] + hv[1] * Cv[1] + hv[2] * Cv[2] + hv[3] * Cv[3];
        *(f32x4*)(a->out + O_SSMS + so + q * 4) = hv;
    }
    const float yv = y + a->in[I_DSKIP][hd] * xv;
    bf16_t* zp = Z + row * 2048 + hd * 64 + lane; const float z = bf2f(*zp), yg = yv * z * sigm(z);
    *zp = f2bf(yg);
    const float sq = red64(yg * yg);
    if (lane == 0) atomicAdd(ssq + row * 8 + g, sq);
}

__device__ __forceinline__ void phase_mix(KA a, LAS unsigned char* lds) {
    const int tid = tidx(), nW = gridDim.x, wg = blockIdx.x;
    const bf16_t* XBC = (const bf16_t*)(a->ws + W_XBC);
    const int half = nW / 2;
    if (wg < half) {
        for (int it = wg; it < 128; it += half) rwkv_prompt_item(a, lds, it >> 4, it & 15);
        bar();
        const int gw = wg * 8 + (tid >> 6), ngw = half * 8; LAS float* wl = (LAS float*)(lds + (tid >> 6) * 4096);
        for (int it = gw; it < 2048; it += ngw) rwkv_sample_wave(a, wl, it >> 4, it & 15);
    }
    else {
        const int w = wg - half, ns = nW - half;
        for (size_t i = (size_t)w * 512 + tid; i < (size_t)8 * 3 * 4096; i += (size_t)ns * 512) { const int c = (int)(i & 4095), j = (int)((i >> 12) % 3), b = (int)(i / 12288); a->out[O_CONVP + i] = bf2f(XBC[((size_t)b * 2048 + 2045 + j) * 4096 + c]); }
        for (size_t i = (size_t)w * 512 + tid; i < (size_t)128 * 3 * 4096; i += (size_t)ns * 512) { const int c = (int)(i & 4095), j = (int)((i >> 12) % 3), b = (int)(i / 12288);
            a->out[O_CONVS + i] = j < 2 ? a->in[I_SCONV][(size_t)b * 12288 + (j + 1) * 4096 + c] : bf2f(XBC[((size_t)NPR + b) * 4096 + c]); }
        {
            const int gw = w * 8 + (tid >> 6), ngw = ns * 8; LAS float* wl = (LAS float*)(lds + (tid >> 6) * 4096);
        }
        bar();
        for (int it = w; it < 256; it += ns) ssd_prompt_item(a, lds, it >> 5, it & 31);
    }
}

__device__ __forceinline__ void phase_ssdnorm(KA a) {
    u32x4* Z = (u32x4*)a->out; const float* ssq = (const float*)(a->ws + W_SSQ);
    for (size_t i = (size_t)blockIdx.x * 512 + tidx(); i < (size_t)T * 256; i += (size_t)gridDim.x * 512) {
        const size_t row = i >> 8; const int gi = (int)(i & 255) >> 5;
        const float rs = rsqrtf(ssq[row * 8 + gi] * (1.0f / 256.0f) + EPS);
        u32x4 w = Z[i];
#pragma unroll
        for (int q = 0; q < 4; ++q) w[q] = cvt_pk_bf16(bflo(w[q]) * rs, bfhi(w[q]) * rs);
        Z[i] = w;
    }
}

__device__ __forceinline__ unsigned f2key(float f) { const unsigned u = __float_as_uint(f); return (u & 0x80000000u) ? ~u : (u | 0x80000000u); }
__device__ __forceinline__ float key2f(unsigned k) { return __uint_as_float((k & 0x80000000u) ? (k & 0x7fffffffu) : ~k); }
#define TOPK_INSERT(top, x) do { _Pragma("unroll") for (int _q = 0; _q < 16; ++_q) { const unsigned _hi = max(top[_q], x); x = min(top[_q], x); top[_q] = _hi; } } while (0)

__device__ __forceinline__ void phase_peer(KA a, LAS unsigned char* lds) {
    const int tid = tidx(), lane = tid & 63, wid = tid >> 6, quad = lane >> 4, l16 = lane & 15;
    LAS float* S = (LAS float*)lds;
    LAS unsigned* TK = (LAS unsigned*)(lds + 132096);
    LAS int* EI = (LAS int*)lds;
    LAS float* EG = (LAS float*)(lds + 8192);
    const bf16_t* Q = (const bf16_t*)(a->ws + W_Q); const bf16_t* K12 = (const bf16_t*)(a->ws + W_K12);
    const unsigned char* PUq = a->ws + W_PU; const unsigned char* PVq = a->ws + W_PV; const float* PUS = (const float*)(a->ws + W_PU + 16777216); const float* PVS = (const float*)(a->ws + W_PV + 16777216);
    const bf16_t* X1B = (const bf16_t*)(a->ws + W_X1B); bf16_t* X2B = (bf16_t*)(a->ws + W_X2B);
    const float* ss1 = (const float*)(a->ws + W_SS) + TP; float* ss2 = (float*)(a->ws + W_SS) + 2 * TP;
    const int t_beg = (int)(((long)blockIdx.x * T) / gridDim.x), t_end = (int)(((long)(blockIdx.x + 1) * T) / gridDim.x);
    for (int tb = t_beg; tb < t_end; tb += 16) {
        const size_t tok0 = (size_t)tb; const int nt = (t_end - tb) < 16 ? (t_end - tb) : 16;
#pragma unroll 1
        for (int hq = 0; hq < 2; ++hq) {
            const int hh = wid * 2 + hq;
            bf16x8 af[4];
#pragma unroll
            for (int kk = 0; kk < 4; ++kk) af[kk] = *(const bf16x8*)(Q + (tok0 + (l16 < nt ? l16 : nt - 1)) * 2048 + hh * 128 + kk * 32 + quad * 8);
#pragma unroll 2
            for (int nt = 0; nt < 8; ++nt) {
                f32x4 acc = {0.f, 0.f, 0.f, 0.f};
#pragma unroll
                for (int kk = 0; kk < 4; ++kk) acc = mfma16(af[kk], *(const bf16x8*)(K12 + ((size_t)hh * 128 + nt * 16 + l16) * 128 + kk * 32 + quad * 8), acc);
#pragma unroll
                for (int j = 0; j < 4; ++j) S[((quad * 4 + j) * 16 + hh) * 129 + nt * 16 + l16] = acc[j];
            }
        }
        bar();
        if (tid < 256) {
            unsigned top[16];
#pragma unroll
            for (int q = 0; q < 16; ++q) top[q] = 0u;
            for (int i = 0; i < 128; ++i) { unsigned x = (f2key(S[tid * 129 + i]) & ~127u) | (unsigned)(127 - i); TOPK_INSERT(top, x); }
#pragma unroll
            for (int q = 0; q < 16; ++q) TK[tid * 16 + q] = top[q];
        }
        bar();
        if (tid < 128) {
            const int t = tid >> 3, head = tid & 7, r1 = (t * 16 + head * 2) * 16, r2 = r1 + 16;
            float f1[16], f2[16];
#pragma unroll
            for (int q = 0; q < 16; ++q) { f1[q] = key2f(TK[r1 + q]); f2[q] = key2f(TK[r2 + q]); }
            unsigned top[16];
#pragma unroll
            for (int q = 0; q < 16; ++q) top[q] = 0u;
#pragma unroll
            for (int i = 0; i < 16; ++i)
#pragma unroll
                for (int j = 0; j < 16; ++j)
                    if ((i + 1) * (j + 1) <= 16) { unsigned x = (f2key(f1[i] + f2[j]) & ~255u) | (unsigned)(255 - (i * 16 + j)); TOPK_INSERT(top, x); }
            float sv[16]; int id[16]; float mx = -3.0e38f;
#pragma unroll
            for (int q = 0; q < 16; ++q) {
                const int pos = 255 - (int)(top[q] & 255u), i = pos >> 4, j = pos & 15;
                const unsigned k1 = TK[r1 + i], k2 = TK[r2 + j];
                sv[q] = key2f(k1) + key2f(k2); id[q] = (127 - (int)(k1 & 127u)) * 128 + (127 - (int)(k2 & 127u)); mx = fmaxf(mx, sv[q]);
            }
            float den = 0.f;
#pragma unroll
            for (int q = 0; q < 16; ++q) { sv[q] = __expf(sv[q] - mx); den += sv[q]; }
            const float rden = 1.0f / den;
#pragma unroll
            for (int q = 0; q < 16; ++q) { EI[t * 128 + head * 16 + q] = id[q]; EG[t * 128 + head * 16 + q] = sv[q] * rden; }
        }
        bar();
#pragma unroll 1
        for (int tq = 0; tq < 2; ++tq) {
            const int tt = wid * 2 + tq; const size_t tok = tok0 + tt;
            if (tt >= nt) continue;
            const u32x4 xa = *(const u32x4*)(X1B + tok * 1024 + lane * 16), xb = *(const u32x4*)(X1B + tok * 1024 + lane * 16 + 8);
            f32x2 xf[8];
#pragma unroll
            for (int q = 0; q < 4; ++q) { xf[q] = (f32x2){bflo(xa[q]), bfhi(xa[q])}; xf[4 + q] = (f32x2){bflo(xb[q]), bfhi(xb[q])}; }
            const float rs = rsqrtf(ss1[tok] * (1.0f / 1024.0f) + EPS);
            f32x2 out2[8];
#pragma unroll
            for (int q = 0; q < 8; ++q) out2[q] = (f32x2){0.f, 0.f};
#pragma unroll 1
            for (int hf = 0; hf < 2; ++hf) {
                float dl = 0.f;
#pragma unroll 1
                for (int e0 = 0; e0 < 64; e0 += 8) {
                    u32x4 w[8]; float rsc[8];
#pragma unroll
                    for (int u = 0; u < 8; ++u) { const int idx = __builtin_amdgcn_readfirstlane(EI[tt * 128 + hf * 64 + e0 + u]); w[u] = *(const u32x4*)(PUq + (size_t)idx * 1024 + lane * 16); rsc[u] = PUS[idx]; }
#pragma unroll
                    for (int u = 0; u < 8; ++u) {
                        f32x2 acc = {0.f, 0.f};
#pragma unroll
                        for (int q = 0; q < 4; ++q) { acc += xf[2 * q] * __builtin_amdgcn_cvt_pk_f32_fp8((int)w[u][q], false); acc += xf[2 * q + 1] * __builtin_amdgcn_cvt_pk_f32_fp8((int)w[u][q], true); }
                        const float d = red64(acc.x + acc.y) * rsc[u];
                        dl = (lane == e0 + u) ? d : dl;
                    }
                }
                const float z = dl * rs, act = 0.5f * z * (1.0f + erff(z * 0.70710678f));
                const float cl = EG[tt * 128 + hf * 64 + lane] * act;
#pragma unroll 1
                for (int e0 = 0; e0 < 64; e0 += 8) {
                    u32x4 w[8]; float cc[8];
#pragma unroll
                    for (int u = 0; u < 8; ++u) { const int idx = __builtin_amdgcn_readfirstlane(EI[tt * 128 + hf * 64 + e0 + u]); w[u] = *(const u32x4*)(PVq + (size_t)idx * 1024 + lane * 16);
                        cc[u] = __int_as_float(__builtin_amdgcn_readlane(__float_as_int(cl), e0 + u)) * PVS[idx]; }
#pragma unroll
                    for (int u = 0; u < 8; ++u) { const f32x2 c2 = {cc[u], cc[u]};
#pragma unroll
                        for (int q = 0; q < 4; ++q) { out2[2 * q] += c2 * __builtin_amdgcn_cvt_pk_f32_fp8((int)w[u][q], false); out2[2 * q + 1] += c2 * __builtin_amdgcn_cvt_pk_f32_fp8((int)w[u][q], true); } }
                }
            }
            float out[16];
#pragma unroll
            for (int q = 0; q < 8; ++q) { out[2 * q] = out2[q].x; out[2 * q + 1] = out2[q].y; }
            const float* xr = a->out + tok * 1024 + lane * 16; float* xw = (float*)(a->ws + W_P1) + tok * 1024 + lane * 16; float sq = 0.f; unsigned pk[8];
#pragma unroll
            for (int q = 0; q < 4; ++q) { f32x4 v = *(const f32x4*)(xr + q * 4);
#pragma unroll
                for (int j = 0; j < 4; ++j) { v[j] += out[q * 4 + j]; sq += v[j] * v[j]; }
                *(f32x4*)(xw + q * 4) = v; pk[2 * q] = cvt_pk_bf16(v[0], v[1]); pk[2 * q + 1] = cvt_pk_bf16(v[2], v[3]); }
            *(u32x4*)(X2B + tok * 1024 + lane * 16) = (u32x4){pk[0], pk[1], pk[2], pk[3]}; *(u32x4*)(X2B + tok * 1024 + lane * 16 + 8) = (u32x4){pk[4], pk[5], pk[6], pk[7]};
            sq = red64(sq);
            if (lane == 0) ss2[tok] = sq;
        }
        bar();
    }
}

__device__ __forceinline__ void phase_final(KA a) {
    f32x4* X = (f32x4*)a->out; const float* ss3 = (const float*)(a->ws + W_SS) + 3 * TP; const f32x4* gn = (const f32x4*)a->in[I_NFIN];
    for (size_t i = (size_t)blockIdx.x * 512 + tidx(); i < (size_t)T * 256; i += (size_t)gridDim.x * 512) {
        const float rs = rsqrtf(ss3[i >> 8] * (1.0f / 1024.0f) + EPS);
        X[i] = X[i] * rs * gn[i & 255];
    }
}

__global__ void __launch_bounds__(512) hybrid_fwd(Args a_unused) {
    extern __shared__ __attribute__((aligned(16))) unsigned char lds_raw[];
    LAS unsigned char* lds = (LAS unsigned char*)lds_raw;
    cg::grid_group grid = cg::this_grid();
    KA a = (KA)__builtin_amdgcn_kernarg_segment_ptr();
    unsigned char* ws = a->ws;
    float* ss = (float*)(ws + W_SS);
    const int ph_lo = a->ph_lo, ph_hi = a->ph_hi;
#ifndef PROBE_REP
#define PROBE_REP 0
#endif
    unsigned* barcnt = (unsigned*)(ws + W_BAR); unsigned nbar = 0;
    if (ph_hi > 1000) grid.sync();
#define GRID_SYNC() do { ++nbar; grid_barrier(barcnt, nbar); } while (0)
#define PH_BEGIN(k) if (ph_lo <= (k) && (k) < ph_hi) { if ((k) > ph_lo) GRID_SYNC(); for (int rep_ = 0; rep_ < 1 + ((PROBE_REP >> (k)) & 1); ++rep_) { if (rep_) GRID_SYNC();
#define PH_END } }
    PH_BEGIN(0)  phase_prep(a, lds); PH_END
    PH_BEGIN(1)  { EpiU E; E.Z = (bf16_t*)a->out; E.XBC = (bf16_t*)(ws + W_XBC); E.RW = (bf16_t*)(ws + W_RW); E.G = (bf16_t*)(ws + W_G); E.DT = (float*)(ws + W_DT); E.ss0 = ss;
                  run_gemm<EpiU, false>(lds, (const bf16_t*)(ws + W_XB), 1024, (const bf16_t*)(ws + W_WIN), 1024, NU, 1024, E); } PH_END
    PH_BEGIN(2)  phase_mix(a, lds); PH_END
    PH_BEGIN(3)  phase_ssdnorm(a); PH_END
    PH_BEGIN(4)  { EpiMix<0> E0; E0.P = (float*)(ws + W_P1); E0.V = nullptr; E0.G = (const bf16_t*)(ws + W_G); E0.goff = 0;
                  run_gemm(lds, (const bf16_t*)a->out, 2048, (const bf16_t*)(ws + W_WOS), 2048, 1024, 2048, E0);
                  __threadfence(); __syncthreads();
                  EpiMix<1> E1; E1.P = (float*)(ws + W_P1); E1.V = (bf16_t*)(ws + W_V); E1.G = (const bf16_t*)(ws + W_G); E1.goff = 1024;
                  run_gemm(lds, (const bf16_t*)(ws + W_RW), 3328, (const bf16_t*)(ws + W_WOR), 1024, 1024, 1024, E1); } PH_END
    PH_BEGIN(5)  { EpiRes<0> E; E.xp = a->in[I_XP]; E.xs = a->in[I_XS]; E.X = a->out; E.XB = (bf16_t*)(ws + W_X1B); E.ss = ss + TP; E.ssin = nullptr; E.P = nullptr;
                  run_gemm(lds, (const bf16_t*)(ws + W_V), 1024, (const bf16_t*)(ws + W_WO), 1024, 1024, 1024, E); } PH_END
    PH_BEGIN(6)  { EpiQ E; E.O = (bf16_t*)(ws + W_Q); E.ld = 2048; E.ss = ss + TP;
                  run_gemm(lds, (const bf16_t*)(ws + W_X1B), 1024, (const bf16_t*)(ws + W_WQ), 1024, 2048, 1024, E); } PH_END
    PH_BEGIN(7)  phase_peer(a, lds); PH_END
    PH_BEGIN(8)  { EpiMix<2> E0; E0.P = (float*)(ws + W_PP); E0.V = nullptr; E0.G = nullptr; E0.goff = 0;
                  run_gemm(lds, (const bf16_t*)(ws + W_PB), 256, (const bf16_t*)(ws + W_WPP), 256, 1024, 256, E0);
                  __threadfence(); __syncthreads();
                  EpiRes<1> E; E.xp = (const float*)(ws + W_P1); E.xs = nullptr; E.X = a->out; E.XB = nullptr; E.ss = ss + 3 * TP; E.ssin = ss + 2 * TP; E.P = (const float*)(ws + W_PP);
                  run_gemm(lds, (const bf16_t*)(ws + W_X2B), 1024, (const bf16_t*)(ws + W_WPG), 1024, 1024, 1024, E); } PH_END
    PH_BEGIN(9) phase_final(a); PH_END
}

extern "C" void kernel_launch(void* const* d_in, const int* in_sizes, int n_in, void* d_out, int out_size, void* d_ws, size_t ws_size, hipStream_t stream) {
    static int grid = 0;
    if (grid == 0) {
        if (n_in != 40 || (size_t)out_size != O_END || ws_size < W_TOTAL) { fprintf(stderr, "kernel_launch: unexpected shapes: n_in %d out %d ws %zu (need %zu)\n", n_in, out_size, ws_size, (size_t)W_TOTAL); grid = -1; return; }
        int dev = 0, cus = 0, per_cu = 0;
        hipGetDevice(&dev); hipDeviceGetAttribute(&cus, hipDeviceAttributeMultiprocessorCount, dev);
        if (hipFuncSetAttribute((const void*)hybrid_fwd, hipFuncAttributeMaxDynamicSharedMemorySize, LDS_BYTES) != hipSuccess) { fprintf(stderr, "kernel_launch: hipFuncSetAttribute failed\n"); grid = -1; return; }
        if (hipOccupancyMaxActiveBlocksPerMultiprocessor(&per_cu, (const void*)hybrid_fwd, 512, LDS_BYTES) != hipSuccess || per_cu < 1) { fprintf(stderr, "kernel_launch: occupancy query says %d\n", per_cu); per_cu = 1; }
        (void)hipGetLastError();
        grid = cus * 1;
        if (grid > 256) grid = 256;
    }
    if (grid < 0) return;
    (void)hipMemsetAsync((unsigned char*)d_ws + W_BAR, 0, 4096, stream);
    Args a{};
    for (int i = 0; i < 40; ++i) a.in[i] = (const float*)d_in[i];
    a.out = (float*)d_out; a.ws = (unsigned char*)d_ws;
#if MULTI_LAUNCH
    for (int ph = 0; ph < NPHASE; ++ph) { a.ph_lo = ph; a.ph_hi = ph + 1; hipLaunchKernelGGL(hybrid_fwd, dim3(grid), dim3(512), LDS_BYTES, stream, a); }
#else
    a.ph_lo = 0; a.ph_hi = NPHASE;
    void* args[] = {&a};
    hipError_t e = hipLaunchCooperativeKernel((const void*)hybrid_fwd, dim3(grid), dim3(512), args, LDS_BYTES, stream);
    if (e != hipSuccess) fprintf(stderr, "kernel_launch: cooperative launch failed: %s (grid %d)\n", hipGetErrorString(e), grid);
#endif
}
```

```cpp
#include <hip/hip_runtime.h>
#include <hip/hip_cooperative_groups.h>
#include <cstdio>
namespace cg = cooperative_groups;
#ifndef MULTI_LAUNCH
#define MULTI_LAUNCH 0
#endif
__device__ __forceinline__ int tidx() { int t = threadIdx.x; asm volatile("" : "+v"(t)); return t; }
namespace pg8 {
#define PG8_LAS __attribute__((address_space(3)))
typedef unsigned short bf16_t;
typedef short bf16x8 __attribute__((ext_vector_type(8)));
typedef float f32x4 __attribute__((ext_vector_type(4)));
typedef unsigned u32x4 __attribute__((ext_vector_type(4)));
constexpr int BM = 256, BK = 64, HALF = 128, HTB = HALF * BK * 2  , STAGE_BYTES = 8 * HTB, NXCD = 8, WGM = 8;

__host__ __device__ __forceinline__ int lds_byte(int r, int c) { const int st = (r >> 4) * 2 + (c >> 5), rr = r & 15, cc = c & 31, ob = rr * 64 + cc * 2; return st * 1024 + (ob ^ (((ob >> 9) & 1) << 5)); }
__host__ __device__ __forceinline__ void stage_rc(int b, int& R, int& C) { const int st = b / 1024, sb = b % 1024, swz = sb ^ (((sb >> 9) & 1) << 5); R = (st >> 1) * 16 + swz / 64; C = (st & 1) * 32 + (swz % 64) / 2; }
__host__ __device__ __forceinline__ int perm32(int rho) { const int n = rho >> 4, i = rho & 15; return 8 * (i >> 2) + 4 * n + (i & 3); }

struct Unit { int pm, pn; };
struct Gemm { const bf16_t* A; const bf16_t* Bt; int M, N, K, lda, ldb; };

struct StaticOrder {
    int nM, nN, nwg, G, c;
    __host__ __device__ void init(int M, int N, int G_, int c_) { nM = M / BM; nN = N / BM; nwg = nM * nN; G = G_; c = c_; }
    __host__ __device__ bool next(int i, Unit& u) const {
        const long L = (long)i * G + c; if (L >= nwg) return false;
        int wgid = (int)L; { const int q = nwg / NXCD, r = nwg % NXCD, xcd = wgid % NXCD, off = wgid / NXCD; wgid = (xcd < r ? xcd * (q + 1) : r * (q + 1) + (xcd - r) * q) + off; }
        const int nig = WGM * nN, gid = wgid / nig, fm = gid * WGM, gsz = (nM - fm) < WGM ? (nM - fm) : WGM;
        u.pm = fm + ((wgid % nig) % gsz); u.pn = (wgid % nig) / gsz; return true;
    }
    __device__ __forceinline__ void a_ready(const Unit&) const {}
    __device__ __forceinline__ void done(const Unit&) const {}
};
__device__ __forceinline__ unsigned cvt_pk_bf16(float lo, float hi) { unsigned r; asm volatile("v_cvt_pk_bf16_f32 %0, %1, %2" : "=v"(r) : "v"(lo), "v"(hi)); return r; }
template <class Epi, class Sched>
__device__ __forceinline__ void gemm_phase(PG8_LAS unsigned char* lds, const Gemm g, const Sched& S, const Epi& E) {
    const int tid = tidx(), wid = __builtin_amdgcn_readfirstlane(tid >> 6), lane = tid & 63, wr = wid >> 2, wc = wid & 3, fr = lane & 15, fq = lane >> 4;
    const int K = g.K, nt = K / BK;
    unsigned voffA[2], voffB[2];
#pragma unroll
    for (int i = 0; i < 2; ++i) { int R, C; stage_rc(tid * 16 + i * 8192, R, C); const int Rb = Epi::PERM ? ((R & ~31) + perm32(R & 31)) : R;
        voffA[i] = (unsigned)(R * g.lda + C) * 2u; voffB[i] = (unsigned)(Rb * g.ldb + C) * 2u; }
    const size_t kstep = (size_t)(BK * 2);
    const size_t hstepA = (size_t)HALF * g.lda * 2, hstepB = (size_t)HALF * g.ldb * 2;
    const size_t tstepA = 2 * hstepA, tstepB = 2 * hstepB;
    const unsigned ldsw = (unsigned)wid * 1024u;
    const int aoff = lds_byte(wr * 64 + fr, fq * 8), boff = lds_byte(wc * 32 + fr, fq * 8);
#define PG8_SA(b, h) (((b) * 2 + (h)) * HTB)
#define PG8_SB(b, h) ((4 + (b) * 2 + (h)) * HTB)
#define PG8_STAGE(bufoff, gbase, voff) do { _Pragma("unroll") for (int _i = 0; _i < 2; ++_i) \
        __builtin_amdgcn_global_load_lds((const unsigned*)((const char*)(gbase) + (voff)[_i]), (PG8_LAS unsigned*)(lds + (bufoff) + ldsw + _i * 8192), 16, 0, 0); } while (0)
#define PG8_LDA(dst, b, h) do { _Pragma("unroll") for (int m = 0; m < 4; ++m) _Pragma("unroll") for (int k = 0; k < 2; ++k) dst[m][k] = *(const PG8_LAS bf16x8*)(lds + PG8_SA(b, h) + aoff + m * 2048 + k * 1024); } while (0)
#define PG8_LDB(dst, b, h) do { _Pragma("unroll") for (int n = 0; n < 2; ++n) _Pragma("unroll") for (int k = 0; k < 2; ++k) dst[n][k] = *(const PG8_LAS bf16x8*)(lds + PG8_SB(b, h) + boff + n * 2048 + k * 1024); } while (0)
#define PG8_MMA(ai, bj, At, Bt) do { __builtin_amdgcn_s_setprio(1); _Pragma("unroll") for (int m = 0; m < 4; ++m) _Pragma("unroll") for (int n = 0; n < 2; ++n) _Pragma("unroll") for (int k = 0; k < 2; ++k) \
        acc[ai][bj][m][n] = __builtin_amdgcn_mfma_f32_16x16x32_bf16(Bt[n][k], At[m][k], acc[ai][bj][m][n], 0, 0, 0); __builtin_amdgcn_s_setprio(0); } while (0)
#define PG8_WAIT_V(n) asm volatile("s_waitcnt vmcnt(" #n ")" ::: "memory")
#define PG8_WAIT_L(n) asm volatile("s_waitcnt lgkmcnt(" #n ")" ::: "memory")
#define PG8_BAR __builtin_amdgcn_s_barrier()
#define PG8_SCHED __builtin_amdgcn_sched_barrier(0)
    Unit cur, nxt; int ui = 0;
    if (!S.next(0, cur)) return;
    f32x4 acc[2][2][4][2];
#pragma unroll
    for (int a = 0; a < 2; ++a)
#pragma unroll
        for (int b = 0; b < 2; ++b)
#pragma unroll
            for (int m = 0; m < 4; ++m)
#pragma unroll
                for (int n = 0; n < 2; ++n) acc[a][b][m][n] = (f32x4){0.f, 0.f, 0.f, 0.f};
    bf16x8 At[4][2], B0[2][2], B1[2][2];
    const char* cA = (const char*)g.A + (size_t)cur.pm * tstepA; const char* cB = (const char*)g.Bt + (size_t)cur.pn * tstepB;
    S.a_ready(cur);
    PG8_STAGE(PG8_SB(0, 0), cB, voffB); PG8_STAGE(PG8_SA(0, 0), cA, voffA); PG8_STAGE(PG8_SB(0, 1), cB + hstepB, voffB); PG8_STAGE(PG8_SA(0, 1), cA + hstepA, voffA);
    if (wr == 1) PG8_BAR;
    PG8_WAIT_V(4); PG8_BAR;
    PG8_STAGE(PG8_SB(1, 0), cB + kstep, voffB); PG8_STAGE(PG8_SA(1, 0), cA + kstep, voffA); PG8_STAGE(PG8_SB(1, 1), cB + hstepB + kstep, voffB);
    PG8_WAIT_V(6); PG8_BAR;
    for (;;) {
        const bool has_next = S.next(ui + 1, nxt);
        const char* nA = has_next ? (const char*)g.A + (size_t)nxt.pm * tstepA : cA; const char* nB = has_next ? (const char*)g.Bt + (size_t)nxt.pn * tstepB : cB;
        for (int t = 0; t < nt; t += 2) {
            const bool last = (t == nt - 2);
            const char* a1 = cA + (size_t)(t + 1) * kstep;
            const char* a2 = last ? nA : cA + (size_t)(t + 2) * kstep; const char* b2 = last ? nB : cB + (size_t)(t + 2) * kstep;
            const char* a3 = a2 + kstep; const char* b3 = b2 + kstep;
            if (last && has_next) S.a_ready(nxt);
            PG8_LDB(B0, 0, 0); PG8_SCHED; PG8_LDA(At, 0, 0); PG8_STAGE(PG8_SA(1, 1), a1 + hstepA, voffA);
            PG8_WAIT_L(8); PG8_BAR; PG8_WAIT_L(0); PG8_MMA(0, 0, At, B0); PG8_BAR; PG8_SCHED;
            PG8_LDB(B1, 0, 1); PG8_STAGE(PG8_SB(0, 0), b2, voffB);
            PG8_BAR; PG8_WAIT_L(0); PG8_MMA(0, 1, At, B1); PG8_BAR;
            PG8_LDA(At, 0, 1); PG8_STAGE(PG8_SA(0, 0), a2, voffA);
            PG8_BAR; PG8_WAIT_L(0); PG8_MMA(1, 0, At, B0); PG8_BAR; PG8_SCHED;
            PG8_STAGE(PG8_SB(0, 1), b2 + hstepB, voffB);
            PG8_WAIT_V(6); PG8_BAR; PG8_MMA(1, 1, At, B1); PG8_BAR;
            PG8_LDB(B0, 1, 0); PG8_SCHED; PG8_LDA(At, 1, 0); PG8_STAGE(PG8_SA(0, 1), a2 + hstepA, voffA);
            PG8_WAIT_L(8); PG8_BAR; PG8_WAIT_L(0); PG8_MMA(0, 0, At, B0); PG8_BAR; PG8_SCHED;
            PG8_LDB(B1, 1, 1); PG8_STAGE(PG8_SB(1, 0), b3, voffB);
            PG8_BAR; PG8_WAIT_L(0); PG8_MMA(0, 1, At, B1); PG8_BAR;
            PG8_LDA(At, 1, 1); PG8_STAGE(PG8_SA(1, 0), a3, voffA);
            PG8_BAR; PG8_WAIT_L(0); PG8_MMA(1, 0, At, B0); PG8_BAR; PG8_SCHED;
            PG8_STAGE(PG8_SB(1, 1), b3 + hstepB, voffB);
            PG8_WAIT_V(6); PG8_BAR; PG8_MMA(1, 1, At, B1); PG8_BAR;
        }
        if constexpr (!Epi::AFTER_DRAIN) { E(acc, cur, wr, wc, fr, fq); S.done(cur); }
        if (!has_next) break;
#pragma unroll
        for (int a = 0; a < 2; ++a)
#pragma unroll
            for (int b = 0; b < 2; ++b)
#pragma unroll
                for (int m = 0; m < 4; ++m)
#pragma unroll
                    for (int n = 0; n < 2; ++n) acc[a][b][m][n] = (f32x4){0.f, 0.f, 0.f, 0.f};
        cur = nxt; cA = nA; cB = nB; ++ui;
    }
    PG8_WAIT_V(0);
    if (wr == 0) PG8_BAR;
    PG8_BAR;
    if constexpr (Epi::AFTER_DRAIN) { E.fused(acc, cur, wr, wc, fr, fq, lds, wid, lane); S.done(cur); }
#undef PG8_SA
#undef PG8_SB
#undef PG8_STAGE
#undef PG8_LDA
#undef PG8_LDB
#undef PG8_MMA
#undef PG8_WAIT_V
#undef PG8_WAIT_L
#undef PG8_BAR
#undef PG8_SCHED
}
}

#define LAS __attribute__((address_space(3)))
using pg8::bf16_t; using pg8::bf16x8; using pg8::f32x4; using pg8::u32x4; using pg8::cvt_pk_bf16;
typedef unsigned u32x2 __attribute__((ext_vector_type(2)));
typedef float f32x2 __attribute__((ext_vector_type(2)));
typedef __bf16 bfp2 __attribute__((ext_vector_type(2)));

constexpr int DM = 1024, NBAT = 8, SEQ = 2048, NPR = NBAT * SEQ, NSM = 128, T = NPR + NSM, TP = 16640;
constexpr int NU = 11776;
constexpr int SHIFT = 3328;
constexpr float EPS = 1e-6f;
constexpr size_t O_SSMP = (size_t)T * 1024, O_CONVP = O_SSMP + 8 * 32 * 64 * 128, O_WKVP = O_CONVP + 8 * 3 * 4096, O_SHIFTP = O_WKVP + 8 * 16 * 64 * 64,
                 O_SSMS = O_SHIFTP + 8 * 3328, O_CONVS = O_SSMS + (size_t)128 * 32 * 64 * 128, O_WKVS = O_CONVS + 128 * 3 * 4096, O_SHIFTS = O_WKVS + (size_t)128 * 16 * 64 * 64,
                 O_END = O_SHIFTS + 128 * 3328;
constexpr size_t W_WIN = 0, W_WOS = W_WIN + (size_t)NU * 1024 * 2, W_WOR = W_WOS + 1024 * 2048 * 2, W_WO = W_WOR + 1024 * 1024 * 2, W_WQ = W_WO + 1024 * 1024 * 2,
                 W_WPG = W_WQ + 2048 * 1024 * 2, W_WPP = W_WPG + 1024 * 1024 * 2, W_K12 = W_WPP + 1024 * 256 * 2, W_PU = W_K12 + 8 * 2 * 128 * 128 * 2,
                 W_PV = W_PU + (size_t)16384 * 1024 * 2, W_XB = W_PV + (size_t)16384 * 1024 * 2, W_XBC = W_XB + (size_t)TP * 1024 * 2, W_RW = W_XBC + (size_t)TP * 4096 * 2,
                 W_G = W_RW + (size_t)TP * 3328 * 2, W_DT = W_G + (size_t)TP * 2048 * 2, W_PB = W_DT + (size_t)TP * 32 * 4, W_SS = W_PB + (size_t)TP * 256 * 2,
                 W_SSQ = W_SS + (size_t)4 * TP * 4, W_END = W_SSQ + (size_t)TP * 8 * 4;
constexpr size_t W_BAR = W_END, W_TOTAL = W_END + 4096;
constexpr size_t W_P1 = W_XBC, W_X1B = W_XBC + (size_t)TP * 1024 * 4, W_V = W_XB, W_X2B = W_XB, W_Q = W_RW, W_PP = W_RW;
constexpr int LDS_BYTES = 155648;
constexpr int NPHASE = 10;

struct Args { const float* in[40]; float* out; unsigned char* ws; int ph_lo, ph_hi; };
typedef const Args __attribute__((address_space(4)))* KA;

enum { I_XP = 0, I_XS, I_PP, I_PS, I_SSSM, I_SCONV, I_SWKV, I_SSHIFT, I_NMIX, I_WIN, I_CONVW, I_CONVB, I_DTB, I_ALOG, I_DSKIP, I_SSMN, I_WOSSM, I_MU, I_W0, I_W2, I_A0, I_A2, I_G2,
       I_KK, I_KA, I_RK, I_LNG, I_LNB, I_WORW, I_WOUT, I_NFFN, I_WQ, I_K1, I_K2, I_PU, I_PV, I_NPLE, I_WPG, I_WPP, I_NFIN };

__device__ __forceinline__ float bf2f(bf16_t b) { return __uint_as_float(((unsigned)b) << 16); }
__device__ __forceinline__ float bflo(unsigned w) { return __uint_as_float(w << 16); }
__device__ __forceinline__ float bfhi(unsigned w) { return __uint_as_float(w & 0xffff0000u); }
__device__ __forceinline__ bf16_t f2bf(float f) { return (bf16_t)(cvt_pk_bf16(f, 0.f) & 0xffffu); }
__device__ __forceinline__ float sigm(float x) { return __builtin_amdgcn_rcpf(1.0f + __expf(-x)); }
__device__ __forceinline__ float tanh_fast(float x) { return 2.0f * sigm(2.0f * x) - 1.0f; }
template <int CTRL> __device__ __forceinline__ float dppm(float x) { return __int_as_float(__builtin_amdgcn_update_dpp(0, __float_as_int(x), CTRL, 0xF, 0xF, true)); }
__device__ __forceinline__ float red8(float x) { x += dppm<0xB1>(x); x += dppm<0x4E>(x); x += dppm<0x141>(x); return x; }
__device__ __forceinline__ float red16(float x) { x = red8(x); x += dppm<0x140>(x); return x; }
__device__ __forceinline__ float red64(float x) { x = red16(x); x += __shfl_xor(x, 16); x += __shfl_xor(x, 32); return x; }
__device__ __forceinline__ f32x4 mfma16(bf16x8 a, bf16x8 b, f32x4 c) { return __builtin_amdgcn_mfma_f32_16x16x32_bf16(a, b, c, 0, 0, 0); }
__device__ __forceinline__ void bar() { __syncthreads(); }
__device__ __forceinline__ void bar_lds() { asm volatile("s_waitcnt lgkmcnt(0)\n\ts_barrier" ::: "memory"); }

__device__ __forceinline__ void peer_quant_row(KA a, int r) {
    const int lane = tidx() & 63; unsigned char* ws = a->ws;
    const bool isv = r >= 16384; const int e = r & 16383;
    const float* src = (isv ? a->in[I_PV] : a->in[I_PU]) + (size_t)e * 1024 + lane * 16;
    f32x4 v[4]; float amax = 0.f;
#pragma unroll
    for (int q = 0; q < 4; ++q) { v[q] = *(const f32x4*)(src + q * 4); if (!isv) v[q] = v[q] * *(const f32x4*)(a->in[I_NFFN] + lane * 16 + q * 4);
        amax = fmaxf(amax, fmaxf(fmaxf(fabsf(v[q][0]), fabsf(v[q][1])), fmaxf(fabsf(v[q][2]), fabsf(v[q][3])))); }
#pragma unroll
    for (int off = 1; off < 64; off <<= 1) amax = fmaxf(amax, __shfl_xor(amax, off));
    const float sc = amax > 0.f ? 224.0f / amax : 1.0f;
    u32x4 w;
#pragma unroll
    for (int q = 0; q < 4; ++q) { int p = __builtin_amdgcn_cvt_pk_fp8_f32(v[q][0] * sc, v[q][1] * sc, 0, false); p = __builtin_amdgcn_cvt_pk_fp8_f32(v[q][2] * sc, v[q][3] * sc, p, true); w[q] = (unsigned)p; }
    unsigned char* dst = ws + (isv ? W_PV : W_PU);
    *(u32x4*)(dst + (size_t)e * 1024 + lane * 16) = w;
    if (lane == 0) ((float*)(dst + 16777216))[e] = amax > 0.f ? amax * (1.0f / 224.0f) : 1.0f;
}

constexpr int N_LATE_JOBS = 14848;
__device__ __forceinline__ void late_transpose_job(KA a, int job) {
    const int lane = tidx() & 63; unsigned char* ws = a->ws;
    const float* src; const float* gain = nullptr; bf16_t* dst; int ld, K, r;
    if (job < 4096) { r = job; src = a->in[I_WOSSM]; gain = a->in[I_SSMN]; dst = (bf16_t*)(ws + W_WOS); ld = 1024; K = 2048; }
    else if (job < 6144) { r = job - 4096; src = a->in[I_WORW]; dst = (bf16_t*)(ws + W_WOR); ld = 1024; K = 1024; }
    else if (job < 8192) { r = job - 6144; src = a->in[I_WOUT]; dst = (bf16_t*)(ws + W_WO); ld = 1024; K = 1024; }
    else if (job < 12288) { r = job - 8192; src = a->in[I_WQ]; gain = a->in[I_NFFN]; dst = (bf16_t*)(ws + W_WQ); ld = 2048; K = 1024; }
    else if (job < 14336) { r = job - 12288; src = a->in[I_WPG]; gain = a->in[I_NPLE]; dst = (bf16_t*)(ws + W_WPG); ld = 1024; K = 1024; }
    else { r = job - 14336; src = a->in[I_WPP]; dst = (bf16_t*)(ws + W_WPP); ld = 1024; K = 256; }
    const int nk = K >> 3, nb = r / nk, kb = r - nb * nk, n = nb * 64 + lane, k0 = kb * 8;
    float v[8];
#pragma unroll
    for (int j = 0; j < 8; ++j) v[j] = src[(size_t)(k0 + j) * ld + n];
    if (gain) {
#pragma unroll
        for (int j = 0; j < 8; ++j) v[j] *= gain[k0 + j]; }
    u32x4 w; w.x = cvt_pk_bf16(v[0], v[1]); w.y = cvt_pk_bf16(v[2], v[3]); w.z = cvt_pk_bf16(v[4], v[5]); w.w = cvt_pk_bf16(v[6], v[7]);
    *(u32x4*)(dst + (size_t)n * K + k0) = w;
}

__device__ __forceinline__ void grid_barrier(unsigned* cnt, unsigned round) {
    __syncthreads();
    if (tidx() < 64) {
        if (tidx() == 0) {
            const unsigned nW = gridDim.x, ng = nW < 8u ? nW : 8u, g = blockIdx.x % ng, gsz = (nW - g + ng - 1) / ng;
            const unsigned old = __hip_atomic_fetch_add(cnt + 64 * (1 + g), 1u, __ATOMIC_ACQ_REL, __HIP_MEMORY_SCOPE_AGENT);
            if (old + 1 == round * gsz) __hip_atomic_fetch_add(cnt, 1u, __ATOMIC_RELEASE, __HIP_MEMORY_SCOPE_AGENT);
            while (__hip_atomic_load(cnt, __ATOMIC_RELAXED, __HIP_MEMORY_SCOPE_AGENT) < round * ng) __builtin_amdgcn_s_sleep(2);
        }
        __builtin_amdgcn_fence(__ATOMIC_ACQUIRE, "agent");
    }
    __syncthreads();
}

__device__ __forceinline__ int win_colmap(int n) { if (n < 6144) return n; if (n < 11520) return n + 32; if (n < 11552) return 6144 + (n - 11520); return -1; }

__device__ __forceinline__ void transpose_tile(LAS float* tl, const float* __restrict__ src, int ld, const float* __restrict__ gain, bf16_t* __restrict__ dst, int K, int k0, int n0, bool remap) {
    const int tid = tidx(), nn = tid & 63, kk0 = tid >> 6;
    const int sc = remap ? win_colmap(n0 + nn) : n0 + nn;
#pragma unroll
    for (int i = 0; i < 8; ++i) { const int k = kk0 + i * 8; float v = 0.f; if (sc >= 0) { v = src[(size_t)(k0 + k) * ld + sc]; if (gain) v *= gain[k0 + k]; } tl[k * 65 + nn] = v; }
    bar();
    const int n = tid >> 3, ks = (tid & 7) * 8;
    u32x4 w; w.x = cvt_pk_bf16(tl[(ks + 0) * 65 + n], tl[(ks + 1) * 65 + n]); w.y = cvt_pk_bf16(tl[(ks + 2) * 65 + n], tl[(ks + 3) * 65 + n]);
    w.z = cvt_pk_bf16(tl[(ks + 4) * 65 + n], tl[(ks + 5) * 65 + n]); w.w = cvt_pk_bf16(tl[(ks + 6) * 65 + n], tl[(ks + 7) * 65 + n]);
    *(u32x4*)(dst + (size_t)(n0 + n) * K + k0 + ks) = w;
    bar();
}

__device__ __forceinline__ void phase_prep(KA a, LAS unsigned char* lds) {
    const int tid = tidx(), nW = gridDim.x, wg = blockIdx.x;
    LAS float* tl = (LAS float*)lds;
    unsigned char* ws = a->ws;
    {
        const float* src = a->in[I_WIN]; const float* gain = a->in[I_NMIX]; bf16_t* dst = (bf16_t*)(ws + W_WIN);
        const int nn = tid & 63, kk0 = tid >> 6;
        float v[8];
#define WIN_LOAD(t_) do { const int k0_ = ((t_) & 15) * 64, n0_ = ((t_) >> 4) * 64; const int sc_ = win_colmap(n0_ + nn); \
            _Pragma("unroll") for (int i = 0; i < 8; ++i) { const int k = kk0 + i * 8; v[i] = 0.f; if (sc_ >= 0) v[i] = src[(size_t)(k0_ + k) * 11552 + sc_] * gain[k0_ + k]; } } while (0)
        if (wg < 2944) WIN_LOAD(wg);
        for (int t = wg; t < 2944; t += nW) {
            const int k0 = (t & 15) * 64, n0 = (t >> 4) * 64;
#pragma unroll
            for (int i = 0; i < 8; ++i) tl[(kk0 + i * 8) * 65 + nn] = v[i];
            if (t + nW < 2944) WIN_LOAD(t + nW);
            bar_lds();
            const int n = tid >> 3, ks = (tid & 7) * 8;
            u32x4 w; w.x = cvt_pk_bf16(tl[(ks + 0) * 65 + n], tl[(ks + 1) * 65 + n]); w.y = cvt_pk_bf16(tl[(ks + 2) * 65 + n], tl[(ks + 3) * 65 + n]);
            w.z = cvt_pk_bf16(tl[(ks + 4) * 65 + n], tl[(ks + 5) * 65 + n]); w.w = cvt_pk_bf16(tl[(ks + 6) * 65 + n], tl[(ks + 7) * 65 + n]);
            *(u32x4*)(dst + (size_t)(n0 + n) * 1024 + k0 + ks) = w;
            bar_lds();
        }
    }
    const size_t gt = (size_t)wg * 512 + tid, gs = (size_t)nW * 512;
    {
        bf16_t* kd = (bf16_t*)(ws + W_K12);
        for (size_t i = gt; i < (size_t)2 * 131072; i += gs) {
            const int half = (int)(i >= 131072), j = (int)(i - (size_t)half * 131072), h = j >> 14, nd = j & 16383;
            kd[((size_t)(h * 2 + half) << 14) + nd] = f2bf(half ? a->in[I_K2][j] : a->in[I_K1][j]);
        }
        u32x2* pb = (u32x2*)(ws + W_PB);
        for (size_t i = gt; i < (size_t)TP * 64; i += gs) {
            const size_t row = i >> 6; f32x4 v = {0.f, 0.f, 0.f, 0.f};
            if (row < (size_t)NPR) v = ((const f32x4*)a->in[I_PP])[i]; else if (row < (size_t)T) v = ((const f32x4*)a->in[I_PS])[i - (size_t)NPR * 64];
            u32x2 o; o.x = cvt_pk_bf16(v[0], v[1]); o.y = cvt_pk_bf16(v[2], v[3]); pb[i] = o;
        }
        float* ss = (float*)(ws + W_SS);
        for (size_t i = gt; i < (size_t)3 * TP; i += gs) ss[TP + i] = 0.f;
        float* ssq = (float*)(ws + W_SSQ);
        for (size_t i = gt; i < (size_t)TP * 8; i += gs) ssq[i] = 0.f;
    }
    {
        const int lane = tid & 63, wv = wg * 8 + (tid >> 6), nwv = nW * 8;
        u32x2* xb = (u32x2*)(ws + W_XB); float* ss0 = (float*)(ws + W_SS);
        for (int row = wv; row < TP; row += nwv) {
            const f32x4* src = row < NPR ? (const f32x4*)(a->in[I_XP] + (size_t)row * 1024) : (const f32x4*)(a->in[I_XS] + (size_t)(row - NPR) * 1024);
            float s = 0.f; f32x4 v[4];
#pragma unroll
            for (int i = 0; i < 4; ++i) {
                v[i] = (f32x4){0.f, 0.f, 0.f, 0.f}; if (row < T) v[i] = src[i * 64 + lane];
                s += v[i][0] * v[i][0] + v[i][1] * v[i][1] + v[i][2] * v[i][2] + v[i][3] * v[i][3];
            }
            s = red64(s);
            const float rs = rsqrtf(s * (1.0f / 1024.0f) + EPS);
#pragma unroll
            for (int i = 0; i < 4; ++i) { u32x2 o; o.x = cvt_pk_bf16(v[i][0] * rs, v[i][1] * rs); o.y = cvt_pk_bf16(v[i][2] * rs, v[i][3] * rs); xb[(size_t)row * 256 + i * 64 + lane] = o; }
            if (lane == 0) ss0[row] = s;
        }
    }
}

typedef const f32x4 (&AccRef)[2][2][4][2];
struct EpiU {
    static constexpr bool PERM = true, AFTER_DRAIN = false;
    bf16_t *Z, *XBC, *RW, *G; float* DT; const float* ss0;
    __device__ __forceinline__ void operator()(AccRef acc, const pg8::Unit& u, int wr, int wc, int fr, int fq) const {
        const int row0 = u.pm * 256 + wr * 64 + fr, pn = u.pn;
        bf16_t* base; int ld, colt, kind;
        if (pn < 8) { base = Z; ld = 2048; colt = pn * 256; kind = 0; }
        else if (pn < 24) { base = XBC; ld = 4096; colt = (pn - 8) * 256; kind = 1; }
        else if (pn < 37) { base = RW; ld = 3328; colt = (pn - 24) * 256; kind = 1; }
        else if (pn < 45) { base = G; ld = 2048; colt = (pn - 37) * 256; kind = 2; }
        else { base = nullptr; ld = 0; colt = 0; kind = 3; }
        const int col0 = colt + wc * 32 + 8 * fq;
#pragma unroll
        for (int ai = 0; ai < 2; ++ai)
#pragma unroll
            for (int m = 0; m < 4; ++m) {
                const int row = row0 + ai * 128 + m * 16;
                const float rs = 1.0f;
                if (kind == 3) {
                    if (wc == 0) { const f32x4 v0 = acc[ai][0][m][0] * rs, v1 = acc[ai][0][m][1] * rs; *(f32x4*)(DT + (size_t)row * 32 + 8 * fq) = v0; *(f32x4*)(DT + (size_t)row * 32 + 8 * fq + 4) = v1; }
                } else if (kind != 0 || row < T) {
#pragma unroll
                    for (int bj = 0; bj < 2; ++bj) {
                        f32x4 v0 = acc[ai][bj][m][0] * rs, v1 = acc[ai][bj][m][1] * rs;
                        if (kind == 2) {
#pragma unroll
                            for (int j = 0; j < 4; ++j) { v0[j] = sigm(v0[j]); v1[j] = sigm(v1[j]); } }
                        u32x4 w; w.x = cvt_pk_bf16(v0[0], v0[1]); w.y = cvt_pk_bf16(v0[2], v0[3]); w.z = cvt_pk_bf16(v1[0], v1[1]); w.w = cvt_pk_bf16(v1[2], v1[3]);
                        *(u32x4*)(base + (size_t)row * ld + col0 + bj * 128) = w;
                    }
                }
            }
    }
};
struct EpiQ {
    static constexpr bool PERM = true, AFTER_DRAIN = false;
    bf16_t* O; int ld; const float* ss;
    static constexpr bool HAS_SS = false;
    __device__ __forceinline__ float* ssp() const { return nullptr; }
    __device__ __forceinline__ float elem(int row, int c, float v) const { O[(size_t)row * ld + c] = f2bf(v * rsqrtf(ss[row] * (1.0f / 1024.0f) + EPS)); return 0.f; }
    __device__ __forceinline__ void operator()(AccRef acc, const pg8::Unit& u, int wr, int wc, int fr, int fq) const {
        const int row0 = u.pm * 256 + wr * 64 + fr, col0 = u.pn * 256 + wc * 32 + 8 * fq;
        float rsv[8];
#pragma unroll
        for (int i = 0; i < 8; ++i) rsv[i] = ss[row0 + (i >> 2) * 128 + (i & 3) * 16];
#pragma unroll
        for (int i = 0; i < 8; ++i) rsv[i] = rsqrtf(rsv[i] * (1.0f / 1024.0f) + EPS);
#pragma unroll
        for (int ai = 0; ai < 2; ++ai)
#pragma unroll
            for (int m = 0; m < 4; ++m) {
                const int row = row0 + ai * 128 + m * 16; const float rs = rsv[ai * 4 + m];
#pragma unroll
                for (int bj = 0; bj < 2; ++bj) {
                    const f32x4 v0 = acc[ai][bj][m][0] * rs, v1 = acc[ai][bj][m][1] * rs;
                    u32x4 w; w.x = cvt_pk_bf16(v0[0], v0[1]); w.y = cvt_pk_bf16(v0[2], v0[3]); w.z = cvt_pk_bf16(v1[0], v1[1]); w.w = cvt_pk_bf16(v1[2], v1[3]);
                    *(u32x4*)(O + (size_t)row * ld + col0 + bj * 128) = w;
                }
            }
    }
};
template <int MODE> struct EpiMix {
    static constexpr bool PERM = false, AFTER_DRAIN = false;
    float* P; bf16_t* V; const bf16_t* G; int goff;
    static constexpr bool HAS_SS = false;
    __device__ __forceinline__ float* ssp() const { return nullptr; }
    __device__ __forceinline__ float elem(int row, int c, float v) const {
        if (MODE != 2) v *= bf2f(G[(size_t)row * 2048 + goff + c]);
        if (MODE == 1) V[(size_t)row * 1024 + c] = f2bf(v + P[(size_t)row * 1024 + c]); else P[(size_t)row * 1024 + c] = v;
        return 0.f; }
    __device__ __forceinline__ void operator()(AccRef acc, const pg8::Unit& u, int wr, int wc, int fr, int fq) const {
        const int row0 = u.pm * 256 + wr * 64 + fr, col0 = u.pn * 256 + wc * 32 + 4 * fq;
#pragma unroll
        for (int ai = 0; ai < 2; ++ai)
#pragma unroll
            for (int mp = 0; mp < 2; ++mp) {
                u32x2 gw[2][4]; f32x4 pv[2][4];
#pragma unroll
                for (int mm = 0; mm < 2; ++mm) { const int row = row0 + ai * 128 + (mp * 2 + mm) * 16;
#pragma unroll
                    for (int f = 0; f < 4; ++f) { const int c = col0 + (f >> 1) * 128 + (f & 1) * 16;
                        if (MODE != 2) gw[mm][f] = *(const u32x2*)(G + (size_t)row * 2048 + goff + c);
                        if (MODE == 1) pv[mm][f] = *(const f32x4*)(P + (size_t)row * 1024 + c); } }
#pragma unroll
                for (int mm = 0; mm < 2; ++mm) { const int m = mp * 2 + mm, row = row0 + ai * 128 + m * 16;
#pragma unroll
                    for (int f = 0; f < 4; ++f) { const int bj = f >> 1, n = f & 1, c = col0 + bj * 128 + n * 16; f32x4 v = acc[ai][bj][m][n];
                        if (MODE != 2) { v[0] *= bflo(gw[mm][f].x); v[1] *= bfhi(gw[mm][f].x); v[2] *= bflo(gw[mm][f].y); v[3] *= bfhi(gw[mm][f].y); }
                        if (MODE == 1) { v = v + pv[mm][f]; u32x2 o; o.x = cvt_pk_bf16(v[0], v[1]); o.y = cvt_pk_bf16(v[2], v[3]); *(u32x2*)(V + (size_t)row * 1024 + c) = o; }
                        else *(f32x4*)(P + (size_t)row * 1024 + c) = v; } }
                asm volatile("" ::: "memory");
            }
    }
};
template <int MODE> struct EpiRes {
    static constexpr bool PERM = false, AFTER_DRAIN = false;
    const float* xp; const float* xs; float* X; bf16_t* XB; float* ss; const float* ssin; const float* P;
    static constexpr bool HAS_SS = true;
    __device__ __forceinline__ float* ssp() const { return ss; }
    __device__ __forceinline__ float elem(int row, int c, float v) const {
        if (MODE == 0) v += xs[(size_t)(row - NPR) * 1024 + c];
        else v = xp[(size_t)row * 1024 + c] + sigm(v * rsqrtf(ssin[row] * (1.0f / 1024.0f) + EPS)) * P[(size_t)row * 1024 + c];
        X[(size_t)row * 1024 + c] = v; if (MODE == 0) XB[(size_t)row * 1024 + c] = f2bf(v);
        return v; }
    __device__ __forceinline__ void operator()(AccRef acc, const pg8::Unit& u, int wr, int wc, int fr, int fq) const {
        const int row0 = u.pm * 256 + wr * 64 + fr, col0 = u.pn * 256 + wc * 32 + 4 * fq;
#pragma unroll
        for (int ai = 0; ai < 2; ++ai)
#pragma unroll
            for (int mp = 0; mp < 2; ++mp) {
                f32x4 xin[2][4], pv[2][4]; float rsr[2];
#pragma unroll
                for (int mm = 0; mm < 2; ++mm) { const int row = row0 + ai * 128 + (mp * 2 + mm) * 16, rowc = row < T ? row : 0;
                    const float* src = MODE == 0 ? (rowc < NPR ? xp + (size_t)rowc * 1024 : xs + (size_t)(rowc - NPR) * 1024) : xp + (size_t)rowc * 1024;
                    rsr[mm] = MODE == 1 ? ssin[rowc] : 0.f;
#pragma unroll
                    for (int f = 0; f < 4; ++f) { const int c = col0 + (f >> 1) * 128 + (f & 1) * 16; xin[mm][f] = *(const f32x4*)(src + c); if (MODE == 1) pv[mm][f] = *(const f32x4*)(P + (size_t)rowc * 1024 + c); } }
#pragma unroll
                for (int mm = 0; mm < 2; ++mm) { const int m = mp * 2 + mm, row = row0 + ai * 128 + m * 16;
                    const float rs = MODE == 1 ? rsqrtf(rsr[mm] * (1.0f / 1024.0f) + EPS) : 0.f; float sq = 0.f;
#pragma unroll
                    for (int f = 0; f < 4; ++f) { const int bj = f >> 1, n = f & 1, c = col0 + bj * 128 + n * 16; f32x4 v = acc[ai][bj][m][n];
                        if (MODE == 1) {
#pragma unroll
                            for (int j = 0; j < 4; ++j) v[j] = sigm(v[j] * rs) * pv[mm][f][j]; }
                        v = v + xin[mm][f];
                        if (row < T) { *(f32x4*)(X + (size_t)row * 1024 + c) = v;
                            if (MODE == 0) { u32x2 o; o.x = cvt_pk_bf16(v[0], v[1]); o.y = cvt_pk_bf16(v[2], v[3]); *(u32x2*)(XB + (size_t)row * 1024 + c) = o; } }
                        sq += v[0] * v[0] + v[1] * v[1] + v[2] * v[2] + v[3] * v[3]; }
                    sq += __shfl_xor(sq, 16); sq += __shfl_xor(sq, 32);
                    if (fq == 0 && row < T) atomicAdd(ss + row, sq); }
                asm volatile("" ::: "memory");
            }
    }
};
template <class Epi> __device__ __forceinline__ void sample_gemm(const bf16_t* A, int lda, const bf16_t* Bt, int ldb, int N, int K, const Epi& E) {
    const int tid = tidx(), lane = tid & 63, wid = tid >> 6, quad = lane >> 4, l16 = lane & 15;
    for (int sl = blockIdx.x; sl < N / 16; sl += gridDim.x) {
        const bf16_t* ap = A + (size_t)(NPR + wid * 16 + l16) * lda + quad * 8; const bf16_t* bp = Bt + (size_t)(sl * 16 + l16) * ldb + quad * 8;
        f32x4 acc = {0.f, 0.f, 0.f, 0.f};
#pragma unroll 8
        for (int kk = 0; kk < K / 32; ++kk) acc = mfma16(*(const bf16x8*)(ap + kk * 32), *(const bf16x8*)(bp + kk * 32), acc);
#pragma unroll
        for (int j = 0; j < 4; ++j) { const int row = NPR + wid * 16 + quad * 4 + j; const float r = E.elem(row, sl * 16 + l16, acc[j]);
            if (Epi::HAS_SS) { const float sq = red16(r * r); if (l16 == 0) atomicAdd(E.ssp() + row, sq); } }
    }
}
template <class Epi, bool split_samples = true> __device__ __forceinline__ void run_gemm(LAS unsigned char* lds, const bf16_t* A, int lda, const bf16_t* Bt, int ldb, int N, int K, const Epi& E) {
    pg8::Gemm g; g.A = A; g.Bt = Bt; g.M = split_samples ? NPR : TP; g.N = N; g.K = K; g.lda = lda; g.ldb = ldb;
    pg8::StaticOrder S; S.init(g.M, N, gridDim.x, blockIdx.x);
    pg8::gemm_phase<Epi, pg8::StaticOrder>(lds, g, S, E);
    if constexpr (split_samples) sample_gemm(A, lda, Bt, ldb, N, K, E);
}

__device__ __forceinline__ void rwkv_prompt_item(KA a, LAS unsigned char* lds, int b, int h) {
    const int item_ = b * 16 + h;
    const int tid = tidx(), lane = tid & 63, wid = tid >> 6, quad = lane >> 4, l16 = lane & 15;
    LAS bf16_t* WdT = (LAS bf16_t*)(lds);
    LAS bf16_t* WaT = (LAS bf16_t*)(lds + 9216);
    LAS bf16_t* WgT = (LAS bf16_t*)(lds + 18432);
    LAS bf16_t* AL = (LAS bf16_t*)(lds + 35840);
    LAS float* RAW = (LAS float*)(lds + 52736);
    LAS float* sR = (LAS float*)(lds + 78080);
    LAS float* sW = sR + 2048; LAS float* sK = sW + 2048; LAS float* sV = sK + 2048; LAS float* sA = sV + 2048; LAS float* sB = sA + 2048; LAS float* sG = sB + 2048; LAS float* sY = sG + 2048;
    LAS float* sBon = sY + 2048;
    bf16_t* RW = (bf16_t*)(a->ws + W_RW);
    const float* mu = a->in[I_MU];
    for (int i = tid; i < 4096; i += 512) { const int k = i >> 6, n = i & 63; WdT[n * 72 + k] = f2bf(a->in[I_W2][k * 1024 + h * 64 + n]); WaT[n * 72 + k] = f2bf(a->in[I_A2][k * 1024 + h * 64 + n]); }
    for (int i = tid; i < 8192; i += 512) { const int k = i >> 6, n = i & 63; WgT[n * 136 + k] = f2bf(a->in[I_G2][k * 1024 + h * 64 + n]); }
    if (tid < 192) RAW[tid] = 0.f;
    const int et = tid >> 4, j0 = (tid & 15) * 4;
    LAS float* CT = sBon + 32;
    if (tid < 64) { const int c = h * 64 + tid; CT[tid] = mu[c]; CT[64 + tid] = mu[1024 + c]; CT[128 + tid] = mu[2048 + c]; CT[192 + tid] = a->in[I_W0][c]; CT[256 + tid] = a->in[I_A0][c];
        CT[320 + tid] = a->in[I_KK][c]; CT[384 + tid] = a->in[I_KA][c]; CT[448 + tid] = a->in[I_RK][c]; CT[512 + tid] = a->in[I_LNG][c]; CT[576 + tid] = a->in[I_LNB][c]; }
    else if (tid >= 256) CT[640 + tid - 256] = mu[3072 + tid - 256];
    const int li0 = (tid & 15) * 16;
    const int srow = (wid & 3) * 16 + (lane >> 3) * 2, c0 = (lane & 7) * 8;
    f32x2 S[4], S1[4];
#pragma unroll
    for (int i = 0; i < 4; ++i) { S[i] = (f32x2){0.f, 0.f}; S1[i] = (f32x2){0.f, 0.f}; }
    bar();
    u32x2 pr[3]; u32x4 cA, cB, pA, pB;
#define RWKV_PREFETCH(chn) do { const size_t nb_ = (size_t)b * 2048 + (chn) * 32; \
        _Pragma("unroll") for (int ii = 0; ii < 3; ++ii) { const int i = tid + ii * 512, t = i / 48, rem = i - t * 48, part = rem >> 4, jj = (rem & 15) * 4; pr[ii] = *(const u32x2*)(RW + (nb_ + t) * 3328 + part * 1024 + h * 64 + jj); } \
        const bf16_t* cp = RW + (nb_ + et) * 3328 + 3072 + li0; cA = *(const u32x4*)cp; cB = *(const u32x4*)(cp + 8); \
        pA = (u32x4){0u, 0u, 0u, 0u}; pB = pA; if ((chn) > 0 || et > 0) { pA = *(const u32x4*)(cp - 3328); pB = *(const u32x4*)(cp - 3328 + 8); } } while (0)
    RWKV_PREFETCH(0);
#pragma unroll 1
    for (int ch = 0; ch < 64; ++ch) {
        const size_t base = (size_t)b * 2048 + ch * 32;
#pragma unroll
        for (int ii = 0; ii < 3; ++ii) {
            const int i = tid + ii * 512, t = i / 48, rem = i - t * 48, part = rem >> 4, jj = (rem & 15) * 4;
            const u32x2 w = pr[ii];
            *(LAS f32x4*)(RAW + (t + 1) * 192 + part * 64 + jj) = (f32x4){bflo(w.x), bfhi(w.x), bflo(w.y), bfhi(w.y)};
        }
        {
            float o[16];
#pragma unroll
            for (int q = 0; q < 8; ++q) {
                const unsigned cw = q < 4 ? cA[q] : cB[q - 4], pw = q < 4 ? pA[q] : pB[q - 4];
                const float m0 = CT[640 + li0 + 2 * q], m1 = CT[640 + li0 + 2 * q + 1];
                const float x0 = bflo(cw), x1 = bfhi(cw);
                o[2 * q] = x0 + (bflo(pw) - x0) * m0; o[2 * q + 1] = x1 + (bfhi(pw) - x1) * m1;
            }
            if (li0 < 64) {
#pragma unroll
                for (int q = 0; q < 16; ++q) o[q] = tanh_fast(o[q]); }
            else if (li0 >= 128) {
#pragma unroll
                for (int q = 0; q < 16; ++q) o[q] = sigm(o[q]); }
            u32x4 w0, w1;
            w0.x = cvt_pk_bf16(o[0], o[1]); w0.y = cvt_pk_bf16(o[2], o[3]); w0.z = cvt_pk_bf16(o[4], o[5]); w0.w = cvt_pk_bf16(o[6], o[7]);
            w1.x = cvt_pk_bf16(o[8], o[9]); w1.y = cvt_pk_bf16(o[10], o[11]); w1.z = cvt_pk_bf16(o[12], o[13]); w1.w = cvt_pk_bf16(o[14], o[15]);
            *(LAS u32x4*)(AL + et * 264 + li0) = w0; *(LAS u32x4*)(AL + et * 264 + li0 + 8) = w1;
        }
        bar_lds();
        {
            const int rb = wid >> 2, cb = wid & 3;
            const LAS bf16_t* ar = AL + (rb * 16 + l16) * 264 + quad * 8;
            f32x4 lw = {0.f, 0.f, 0.f, 0.f}, la = lw, lg = lw;
#pragma unroll
            for (int kk = 0; kk < 2; ++kk) {
                lw = mfma16(*(const LAS bf16x8*)(ar + kk * 32), *(const LAS bf16x8*)(WdT + (cb * 16 + l16) * 72 + kk * 32 + quad * 8), lw);
                la = mfma16(*(const LAS bf16x8*)(ar + 64 + kk * 32), *(const LAS bf16x8*)(WaT + (cb * 16 + l16) * 72 + kk * 32 + quad * 8), la);
            }
#pragma unroll
            for (int kk = 0; kk < 4; ++kk) lg = mfma16(*(const LAS bf16x8*)(ar + 128 + kk * 32), *(const LAS bf16x8*)(WgT + (cb * 16 + l16) * 136 + kk * 32 + quad * 8), lg);
#pragma unroll
            for (int j = 0; j < 4; ++j) { const int o = (rb * 16 + quad * 4 + j) * 64 + cb * 16 + l16; sW[o] = lw[j]; sA[o] = la[j]; sG[o] = lg[j]; }
        }
        bar_lds();
        {
            float kkf[4], al[4]; float ssk = 0.f, bon = 0.f;
            const f32x4 c_mur = *(const LAS f32x4*)(CT + j0), c_muk = *(const LAS f32x4*)(CT + 64 + j0), c_muv = *(const LAS f32x4*)(CT + 128 + j0), c_w0 = *(const LAS f32x4*)(CT + 192 + j0),
                        c_a0 = *(const LAS f32x4*)(CT + 256 + j0), c_kk = *(const LAS f32x4*)(CT + 320 + j0), c_ka = *(const LAS f32x4*)(CT + 384 + j0), c_rk = *(const LAS f32x4*)(CT + 448 + j0);
            const int ob = et * 64 + j0;
            const f32x4 rc4 = *(const LAS f32x4*)(RAW + (et + 1) * 192 + j0), rp4 = *(const LAS f32x4*)(RAW + et * 192 + j0), kc4 = *(const LAS f32x4*)(RAW + (et + 1) * 192 + 64 + j0), kp4 = *(const LAS f32x4*)(RAW + et * 192 + 64 + j0),
                        vc4 = *(const LAS f32x4*)(RAW + (et + 1) * 192 + 128 + j0), vp4 = *(const LAS f32x4*)(RAW + et * 192 + 128 + j0), lw4 = *(const LAS f32x4*)(sW + ob), la4 = *(const LAS f32x4*)(sA + ob);
            f32x4 r4, d4, k4, v4, a4, b4;
#pragma unroll
            for (int q = 0; q < 4; ++q) {
                const float r = rc4[q] + (rp4[q] - rc4[q]) * c_mur[q], k = kc4[q] + (kp4[q] - kc4[q]) * c_muk[q], v = vc4[q] + (vp4[q] - vc4[q]) * c_muv[q];
                const float dec = __expf(-0.60653066f * sigm(c_w0[q] + lw4[q]));
                al[q] = sigm(c_a0[q] + la4[q]);
                kkf[q] = k * c_kk[q]; ssk += kkf[q] * kkf[q];
                const float kn = k * (1.0f + (al[q] - 1.0f) * c_ka[q]); bon += r * kn * c_rk[q];
                r4[q] = r; d4[q] = dec; k4[q] = kn; v4[q] = v;
            }
            ssk = red16(ssk); bon = red16(bon);
            const float inv = rsqrtf(ssk + 1e-12f);
#pragma unroll
            for (int q = 0; q < 4; ++q) { const float kk = kkf[q] * inv; a4[q] = -kk; b4[q] = kk * al[q]; }
            *(LAS f32x4*)(sR + ob) = r4; *(LAS f32x4*)(sW + ob) = d4; *(LAS f32x4*)(sK + ob) = k4; *(LAS f32x4*)(sV + ob) = v4; *(LAS f32x4*)(sA + ob) = a4; *(LAS f32x4*)(sB + ob) = b4;
            if ((tid & 15) == 0) sBon[et] = bon;
        }
        bar_lds();
        if (ch < 63) RWKV_PREFETCH(ch + 1);
        if (wid < 4) {
            const LAS float* sp = sR + c0;
            f32x4 nr0 = *(const LAS f32x4*)(sp), nr1 = *(const LAS f32x4*)(sp + 4), nw0 = *(const LAS f32x4*)(sp + 2048), nw1 = *(const LAS f32x4*)(sp + 2048 + 4);
            f32x4 nk0 = *(const LAS f32x4*)(sp + 4096), nk1 = *(const LAS f32x4*)(sp + 4096 + 4), na0 = *(const LAS f32x4*)(sp + 8192), na1 = *(const LAS f32x4*)(sp + 8192 + 4);
            f32x4 nb0 = *(const LAS f32x4*)(sp + 10240), nb1 = *(const LAS f32x4*)(sp + 10240 + 4); f32x2 nv = *(const LAS f32x2*)(sV + srow);
#pragma unroll 2
            for (int t = 0; t < 32; ++t) {
                const f32x4 r0 = nr0, r1 = nr1, w0 = nw0, w1 = nw1, k0 = nk0, k1 = nk1, a0 = na0, a1 = na1, b0 = nb0, b1 = nb1; const f32x2 v2 = nv;
                {
                    const int tn = t < 31 ? t + 1 : 31; const LAS float* sn = sR + tn * 64 + c0;
                    nr0 = *(const LAS f32x4*)(sn); nr1 = *(const LAS f32x4*)(sn + 4); nw0 = *(const LAS f32x4*)(sn + 2048); nw1 = *(const LAS f32x4*)(sn + 2048 + 4);
                    nk0 = *(const LAS f32x4*)(sn + 4096); nk1 = *(const LAS f32x4*)(sn + 4096 + 4); na0 = *(const LAS f32x4*)(sn + 8192); na1 = *(const LAS f32x4*)(sn + 8192 + 4);
                    nb0 = *(const LAS f32x4*)(sn + 10240); nb1 = *(const LAS f32x4*)(sn + 10240 + 4); nv = *(const LAS f32x2*)(sV + tn * 64 + srow);
                }
                const f32x2 av[4] = {{a0[0], a0[1]}, {a0[2], a0[3]}, {a1[0], a1[1]}, {a1[2], a1[3]}}, bv[4] = {{b0[0], b0[1]}, {b0[2], b0[3]}, {b1[0], b1[1]}, {b1[2], b1[3]}};
                const f32x2 wv[4] = {{w0[0], w0[1]}, {w0[2], w0[3]}, {w1[0], w1[1]}, {w1[2], w1[3]}}, kv[4] = {{k0[0], k0[1]}, {k0[2], k0[3]}, {k1[0], k1[1]}, {k1[2], k1[3]}};
                const f32x2 rv[4] = {{r0[0], r0[1]}, {r0[2], r0[3]}, {r1[0], r1[1]}, {r1[2], r1[3]}};
                f32x2 p = S[0] * av[0]; p = S[1] * av[1] + p; p = S[2] * av[2] + p; p = S[3] * av[3] + p;
                f32x2 p1 = S1[0] * av[0]; p1 = S1[1] * av[1] + p1; p1 = S1[2] * av[2] + p1; p1 = S1[3] * av[3] + p1;
                const float sa = red8(p.x + p.y), sa1 = red8(p1.x + p1.y);
                const f32x2 vv = {v2.x, v2.x}, sav = {sa, sa}, vv1 = {v2.y, v2.y}, sav1 = {sa1, sa1};
#pragma unroll
                for (int i = 0; i < 4; ++i) { const f32x2 u = S[i] * wv[i] + vv * kv[i]; S[i] = sav * bv[i] + u; const f32x2 u1 = S1[i] * wv[i] + vv1 * kv[i]; S1[i] = sav1 * bv[i] + u1; }
                f32x2 y2 = S[0] * rv[0]; y2 = S[1] * rv[1] + y2; y2 = S[2] * rv[2] + y2; y2 = S[3] * rv[3] + y2;
                f32x2 y3 = S1[0] * rv[0]; y3 = S1[1] * rv[1] + y3; y3 = S1[2] * rv[2] + y3; y3 = S1[3] * rv[3] + y3;
                const float y = red8(y2.x + y2.y), y1 = red8(y3.x + y3.y);
                if ((lane & 7) == 0) *(LAS f32x2*)(sY + t * 64 + srow) = (f32x2){y, y1};
            }
        } else {
            const int slot_ = (item_ * 4 + (wid - 4)) * 64 + ch;
            peer_quant_row(a, slot_);
            if (slot_ < N_LATE_JOBS) late_transpose_job(a, slot_);
        }
        bar_lds();
        {
            const int ob = et * 64 + j0;
            const f32x4 y4 = *(const LAS f32x4*)(sY + ob), v4 = *(const LAS f32x4*)(sV + ob), g4 = *(const LAS f32x4*)(sG + ob);
            float y[4]; float s = 0.f;
#pragma unroll
            for (int q = 0; q < 4; ++q) { y[q] = y4[q]; s += y[q]; }
            const float mean = red16(s) * (1.0f / 64.0f); float vs = 0.f;
#pragma unroll
            for (int q = 0; q < 4; ++q) { y[q] -= mean; vs += y[q] * y[q]; }
            const float inv = rsqrtf(red16(vs) * (1.0f / 64.0f) + 64e-5f), bon = sBon[et];
            const f32x4 c_lg = *(const LAS f32x4*)(CT + 512 + j0), c_lb = *(const LAS f32x4*)(CT + 576 + j0);
            float o[4];
#pragma unroll
            for (int q = 0; q < 4; ++q) o[q] = ((y[q] * inv * c_lg[q] + c_lb[q]) + bon * v4[q]) * g4[q];
            u32x2 w; w.x = cvt_pk_bf16(o[0], o[1]); w.y = cvt_pk_bf16(o[2], o[3]);
            *(u32x2*)(RW + (base + et) * 3328 + h * 64 + j0) = w;
            if (tid < 192) RAW[tid] = RAW[32 * 192 + tid];
        }
        bar_lds();
    }
    {
        if (wid < 4) {
            float* ws_ = a->out + O_WKVP + ((size_t)(b * 16 + h) * 64 + srow) * 64 + c0;
            *(f32x4*)ws_ = (f32x4){S[0].x, S[0].y, S[1].x, S[1].y}; *(f32x4*)(ws_ + 4) = (f32x4){S[2].x, S[2].y, S[3].x, S[3].y};
            *(f32x4*)(ws_ + 64) = (f32x4){S1[0].x, S1[0].y, S1[1].x, S1[1].y}; *(f32x4*)(ws_ + 68) = (f32x4){S1[2].x, S1[2].y, S1[3].x, S1[3].y};
        }
        if (tid < 192) a->out[O_SHIFTP + (size_t)b * 3328 + (tid >> 6) * 1024 + h * 64 + (tid & 63)] = RAW[tid];
        if (h == 0 && tid < 256) a->out[O_SHIFTP + (size_t)b * 3328 + 3072 + tid] = bf2f(RW[((size_t)b * 2048 + 2047) * 3328 + 3072 + tid]);
    }
    bar();
}

__device__ __forceinline__ void rwkv_sample_wave(KA a, LAS float* wl, int b, int h) {
    const int lane = tidx() & 63, c = h * 64 + lane;
    bf16_t* RW = (bf16_t*)(a->ws + W_RW);
    const float* mu = a->in[I_MU]; const float* prevs = a->in[I_SSHIFT] + (size_t)b * 3328;
    const size_t row = (size_t)NPR + b;
    {
        const int i0 = lane * 4;
        const u32x2 cw = *(const u32x2*)(RW + row * 3328 + 3072 + i0); const f32x4 pv = *(const f32x4*)(prevs + 3072 + i0), mv = *(const f32x4*)(mu + 3072 + i0);
        f32x4 cur = {bflo(cw.x), bfhi(cw.x), bflo(cw.y), bfhi(cw.y)}, xs = cur + (pv - cur) * mv, o;
#pragma unroll
        for (int q = 0; q < 4; ++q) o[q] = lane < 16 ? tanh_fast(xs[q]) : (lane < 32 ? xs[q] : sigm(xs[q]));
        *(LAS f32x4*)(wl + i0) = o;
        if (h == 0) *(f32x4*)(a->out + O_SHIFTS + (size_t)b * 3328 + 3072 + i0) = cur;
    }
    float rr, kk_, vv;
    {
        const float rc = bf2f(RW[row * 3328 + c]), kc = bf2f(RW[row * 3328 + 1024 + c]), vc = bf2f(RW[row * 3328 + 2048 + c]);
        rr = rc + (prevs[c] - rc) * mu[c]; kk_ = kc + (prevs[1024 + c] - kc) * mu[1024 + c]; vv = vc + (prevs[2048 + c] - vc) * mu[2048 + c];
        float* so = a->out + O_SHIFTS + (size_t)b * 3328; so[c] = rc; so[1024 + c] = kc; so[2048 + c] = vc;
    }
    float lw = 0.f, la = 0.f, lg = 0.f;
    {
        const float* pw = a->in[I_W2] + c; const float* pa = a->in[I_A2] + c; const float* pg = a->in[I_G2] + c;
#pragma unroll 8
        for (int k = 0; k < 64; ++k) { lw += wl[k] * pw[0]; la += wl[64 + k] * pa[0]; pw += 1024; pa += 1024; }
        asm volatile("" ::: "memory");
#pragma unroll 16
        for (int k = 0; k < 128; ++k) { lg += wl[128 + k] * pg[0]; pg += 1024; }
        asm volatile("" ::: "memory");
    }
    const float dec = __expf(-0.60653066f * sigm(a->in[I_W0][c] + lw)), al = sigm(a->in[I_A0][c] + la);
    const float kkf = kk_ * a->in[I_KK][c], ssk = red64(kkf * kkf), kn = kk_ * (1.0f + (al - 1.0f) * a->in[I_KA][c]), bon = red64(rr * kn * a->in[I_RK][c]);
    const float kkn = kkf * rsqrtf(ssk + 1e-12f);
    LAS float* vw = wl + 256;
    vw[lane] = rr; vw[64 + lane] = dec; vw[128 + lane] = kn; vw[192 + lane] = -kkn; vw[256 + lane] = kkn * al;
    const size_t so = ((size_t)(b * 16 + h) * 64 + lane) * 64;
    float sa = 0.f;
#pragma unroll 8
    for (int q = 0; q < 16; ++q) { const f32x4 Sv = *(const f32x4*)(a->in[I_SWKV] + so + q * 4), av = *(const LAS f32x4*)(vw + 192 + q * 4); sa += Sv[0] * av[0] + Sv[1] * av[1] + Sv[2] * av[2] + Sv[3] * av[3]; }
    float y = 0.f;
#pragma unroll 8
    for (int q = 0; q < 16; ++q) {
        const f32x4 wv = *(const LAS f32x4*)(vw + 64 + q * 4), kv = *(const LAS f32x4*)(vw + 128 + q * 4), bv = *(const LAS f32x4*)(vw + 256 + q * 4), rv = *(const LAS f32x4*)(vw + q * 4);
        f32x4 Sv = *(const f32x4*)(a->in[I_SWKV] + so + q * 4);
        Sv = Sv * wv + kv * vv + bv * sa;
        y += Sv[0] * rv[0] + Sv[1] * rv[1] + Sv[2] * rv[2] + Sv[3] * rv[3];
        *(f32x4*)(a->out + O_WKVS + so + q * 4) = Sv;
    }
    const float mean = red64(y) * (1.0f / 64.0f), d = y - mean, var = red64(d * d) * (1.0f / 64.0f);
    const float o = ((d * rsqrtf(var + 64e-5f) * a->in[I_LNG][c] + a->in[I_LNB][c]) + bon * vv) * lg;
    RW[row * 3328 + c] = f2bf(o);
}

__device__ __forceinline__ float softplusf_(float x) { return x > 20.f ? x : log1pf(__expf(x)); }
__device__ __forceinline__ void ssd_prompt_item(KA a, LAS unsigned char* lds, int b, int hd) {
    const int tid = tidx(), lane = tid & 63, wid = tid >> 6, quad = lane >> 4, l16 = lane & 15, g = hd >> 2;
    LAS bf16_t* Cb = (LAS bf16_t*)(lds);
    LAS bf16_t* Bb = (LAS bf16_t*)(lds + 17408);
    LAS bf16_t* BT = (LAS bf16_t*)(lds + 34816);
    LAS bf16_t* XT = (LAS bf16_t*)(lds + 53248);
    LAS bf16_t* XTd = (LAS bf16_t*)(lds + 62464);
    LAS bf16_t* Mb = (LAS bf16_t*)(lds + 71680);
    LAS bf16_t* Hb = (LAS bf16_t*)(lds + 80896);
    LAS float* sdt = (LAS float*)(lds + 98304); LAS float* sac = sdt + 64; LAS float* seac = sac + 64; LAS float* sdd = seac + 64; LAS float* sdec = sdd + 64;
    const bf16_t* XBC = (const bf16_t*)(a->ws + W_XBC); const float* DT = (const float*)(a->ws + W_DT); bf16_t* Z = (bf16_t*)a->out; float* ssq = (float*)(a->ws + W_SSQ);
    const int cg_ = tid % 40, strip = tid / 40;
    int ccol, kind, loc;
    if (cg_ < 8) { kind = 0; loc = cg_ * 8; ccol = hd * 64 + loc; } else if (cg_ < 24) { kind = 1; loc = (cg_ - 8) * 8; ccol = 2048 + g * 128 + loc; } else { kind = 2; loc = (cg_ - 24) * 8; ccol = 3072 + g * 128 + loc; }
    LAS float* CW = sdec + 64;
    if (tid < 40) {
#pragma unroll
        for (int q = 0; q < 8; ++q) { CW[tid * 40 + 32 + q] = a->in[I_CONVB][ccol + q];
#pragma unroll
            for (int k = 0; k < 4; ++k) CW[tid * 40 + k * 8 + q] = a->in[I_CONVW][k * 4096 + ccol + q]; }
    }
    u32x4 rows[11]; float dtn = 0.f;
#define SSD_PREFETCH(chn) do { if (tid < 320) { _Pragma("unroll") for (int k = 0; k < 11; ++k) { const int tg = (chn) * 64 + strip * 8 - 3 + k; rows[k] = (u32x4){0u, 0u, 0u, 0u}; \
            if (tg >= 0) rows[k] = *(const u32x4*)(XBC + ((size_t)b * 2048 + tg) * 4096 + ccol); } } else if (wid == 7) dtn = DT[((size_t)b * 2048 + (chn) * 64 + lane) * 32 + hd]; } while (0)
    SSD_PREFETCH(0);
    bar();
    const float Ah = -__expf(a->in[I_ALOG][hd]), dtb = a->in[I_DTB][hd], dsk = a->in[I_DSKIP][hd];
    const int pt = wid >> 1, ntb = (wid & 1) * 4;
    f32x4 hacc[4];
#pragma unroll
    for (int i = 0; i < 4; ++i) hacc[i] = (f32x4){0.f, 0.f, 0.f, 0.f};
#pragma unroll 1
    for (int ch = 0; ch < 32; ++ch) {
        const size_t row0 = (size_t)b * 2048 + ch * 64;
        bf16_t zq[2][4];
#pragma unroll
        for (int tt = 0; tt < 2; ++tt) { const int tile = wid * 2 + tt, lt = tile >> 2, pc = tile & 3;
#pragma unroll
            for (int j = 0; j < 4; ++j) zq[tt][j] = Z[(row0 + lt * 16 + quad * 4 + j) * 2048 + hd * 64 + pc * 16 + l16]; }
        if (tid < 320) {
#pragma unroll
            for (int hq = 0; hq < 2; ++hq) {
                f32x2 cwp[4][2], cbp[2], xr[11][2];
                { const f32x4 t0 = *(const LAS f32x4*)(CW + cg_ * 40 + hq * 4), t1 = *(const LAS f32x4*)(CW + cg_ * 40 + 8 + hq * 4), t2 = *(const LAS f32x4*)(CW + cg_ * 40 + 16 + hq * 4),
                              t3 = *(const LAS f32x4*)(CW + cg_ * 40 + 24 + hq * 4), tb = *(const LAS f32x4*)(CW + cg_ * 40 + 32 + hq * 4);
                  cwp[0][0] = (f32x2){t0[0], t0[1]}; cwp[0][1] = (f32x2){t0[2], t0[3]}; cwp[1][0] = (f32x2){t1[0], t1[1]}; cwp[1][1] = (f32x2){t1[2], t1[3]};
                  cwp[2][0] = (f32x2){t2[0], t2[1]}; cwp[2][1] = (f32x2){t2[2], t2[3]}; cwp[3][0] = (f32x2){t3[0], t3[1]}; cwp[3][1] = (f32x2){t3[2], t3[3]};
                  cbp[0] = (f32x2){tb[0], tb[1]}; cbp[1] = (f32x2){tb[2], tb[3]}; }
#pragma unroll
                for (int k = 0; k < 11; ++k) { const unsigned wa_ = rows[k][2 * hq], wb_ = rows[k][2 * hq + 1]; xr[k][0] = (f32x2){bflo(wa_), bfhi(wa_)}; xr[k][1] = (f32x2){bflo(wb_), bfhi(wb_)}; }
                const int lc = loc + hq * 4;
                unsigned colpk[4][4];
#pragma unroll
                for (int rp = 0; rp < 4; ++rp) {
                    float o[2][4];
#pragma unroll
                    for (int rr = 0; rr < 2; ++rr) { const int r = rp * 2 + rr;
#pragma unroll
                        for (int pq = 0; pq < 2; ++pq) {
                            f32x2 v = cwp[0][pq] * xr[r][pq] + cbp[pq]; v = cwp[1][pq] * xr[r + 1][pq] + v; v = cwp[2][pq] * xr[r + 2][pq] + v; v = cwp[3][pq] * xr[r + 3][pq] + v;
                            o[rr][2 * pq] = v.x * sigm(v.x); o[rr][2 * pq + 1] = v.y * sigm(v.y); }
                        if (kind != 0) { const int s = strip * 8 + r;
                            u32x2 pk; pk.x = cvt_pk_bf16(o[rr][0], o[rr][1]); pk.y = cvt_pk_bf16(o[rr][2], o[rr][3]);
                            if (kind == 1) *(LAS u32x2*)(Bb + s * 136 + lc) = pk; else *(LAS u32x2*)(Cb + s * 136 + lc) = pk; } }
#pragma unroll
                    for (int q = 0; q < 4; ++q) colpk[q][rp] = cvt_pk_bf16(o[0][q], o[1][q]);
                }
                if (kind != 2) {
                    LAS bf16_t* TT = kind == 0 ? XT : BT;
#pragma unroll
                    for (int q = 0; q < 4; ++q) *(LAS u32x4*)(TT + (lc + q) * 72 + strip * 8) = (u32x4){colpk[q][0], colpk[q][1], colpk[q][2], colpk[q][3]};
                }
                asm volatile("" ::: "memory");
            }
        } else if (wid == 7) {
            const float dtv = softplusf_(dtn + dtb);
            float x = dtv * Ah;
#pragma unroll
            for (int off = 1; off < 64; off <<= 1) { const float t = __shfl_up(x, off); if (lane >= off) x += t; }
            const float last = __shfl(x, 63);
            sdt[lane] = dtv; sac[lane] = x; seac[lane] = __expf(x); sdd[lane] = __expf(last - x) * dtv; if (lane == 63) sdec[0] = __expf(x);
        }
#pragma unroll
        for (int i = 0; i < 4; ++i)
#pragma unroll
            for (int j = 0; j < 4; ++j) Hb[(pt * 16 + quad * 4 + j) * 136 + (ntb + i) * 16 + l16] = f2bf(hacc[i][j]);
        if (ch < 31) SSD_PREFETCH(ch + 1);
        bar_lds();
        {
            const int p = tid >> 3, s8 = (tid & 7) * 8;
            const u32x4 w = *(const LAS u32x4*)(XT + p * 72 + s8); u32x4 o;
#pragma unroll
            for (int q = 0; q < 4; ++q) o[q] = cvt_pk_bf16(bflo(w[q]) * sdd[s8 + 2 * q], bfhi(w[q]) * sdd[s8 + 2 * q + 1]);
            *(LAS u32x4*)(XTd + p * 72 + s8) = o;
        }
#pragma unroll
        for (int tt = 0; tt < 2; ++tt) {
            const int tile = wid * 2 + tt, lt = tile >> 2, st = tile & 3;
            f32x4 acc = {0.f, 0.f, 0.f, 0.f};
            if (st <= lt) {
#pragma unroll
                for (int kk = 0; kk < 4; ++kk) acc = mfma16(*(const LAS bf16x8*)(Cb + (lt * 16 + l16) * 136 + kk * 32 + quad * 8), *(const LAS bf16x8*)(Bb + (st * 16 + l16) * 136 + kk * 32 + quad * 8), acc);
            }
            const int s = st * 16 + l16; const float as = sac[s], ds = sdt[s];
#pragma unroll
            for (int j = 0; j < 4; ++j) { const int l = lt * 16 + quad * 4 + j; const float v = (s <= l) ? acc[j] * __expf(fminf(sac[l] - as, 0.f)) * ds : 0.f; Mb[l * 72 + s] = f2bf(v); }
        }
        bar_lds();
#pragma unroll
        for (int tt = 0; tt < 2; ++tt) {
            const int tile = wid * 2 + tt, lt = tile >> 2, pc = tile & 3;
            f32x4 acc = {0.f, 0.f, 0.f, 0.f};
#pragma unroll
            for (int kk = 0; kk < 4; ++kk) acc = mfma16(*(const LAS bf16x8*)(Cb + (lt * 16 + l16) * 136 + kk * 32 + quad * 8), *(const LAS bf16x8*)(Hb + (pc * 16 + l16) * 136 + kk * 32 + quad * 8), acc);
#pragma unroll
            for (int j = 0; j < 4; ++j) acc[j] *= seac[lt * 16 + quad * 4 + j];
#pragma unroll
            for (int kk = 0; kk < 2; ++kk) acc = mfma16(*(const LAS bf16x8*)(Mb + (lt * 16 + l16) * 72 + kk * 32 + quad * 8), *(const LAS bf16x8*)(XT + (pc * 16 + l16) * 72 + kk * 32 + quad * 8), acc);
            const int p = pc * 16 + l16;
#pragma unroll
            for (int j = 0; j < 4; ++j) {
                const int l = lt * 16 + quad * 4 + j;
                const float yv = acc[j] + dsk * bf2f(XT[p * 72 + l]);
                bf16_t* zp = Z + (row0 + l) * 2048 + hd * 64 + p;
                const float z = bf2f(zq[tt][j]), yg = yv * z * sigm(z);
                *zp = f2bf(yg);
                const float sq = red16(yg * yg);
                if (l16 == 0) atomicAdd(ssq + (row0 + l) * 8 + g, sq);
            }
        }
        {
            const float dec = sdec[0];
#pragma unroll
            for (int i = 0; i < 4; ++i) {
                hacc[i] = hacc[i] * dec;
#pragma unroll
                for (int kk = 0; kk < 2; ++kk) hacc[i] = mfma16(*(const LAS bf16x8*)(XTd + (pt * 16 + l16) * 72 + kk * 32 + quad * 8), *(const LAS bf16x8*)(BT + ((ntb + i) * 16 + l16) * 72 + kk * 32 + quad * 8), hacc[i]);
            }
        }
        bar_lds();
    }
#pragma unroll
    for (int i = 0; i < 4; ++i)
#pragma unroll
        for (int j = 0; j < 4; ++j) a->out[O_SSMP + ((size_t)(b * 32 + hd) * 64 + pt * 16 + quad * 4 + j) * 128 + (ntb + i) * 16 + l16] = hacc[i][j];
}

__device__ __forceinline__ float conv1_(KA a, const bf16_t* XBC, int b, size_t row, int col) {
    const float* sc = a->in[I_SCONV] + (size_t)b * 12288 + col;
    const float v = a->in[I_CONVB][col] + a->in[I_CONVW][col] * sc[0] + a->in[I_CONVW][4096 + col] * sc[4096] + a->in[I_CONVW][8192 + col] * sc[8192] + a->in[I_CONVW][12288 + col] * bf2f(XBC[row * 4096 + col]);
    return v * sigm(v);
}
__device__ __forceinline__ void ssd_sample_wave(KA a, LAS float* wl, int b, int hd) {
    const int lane = tidx() & 63, g = hd >> 2;
    const bf16_t* XBC = (const bf16_t*)(a->ws + W_XBC); const float* DT = (const float*)(a->ws + W_DT); bf16_t* Z = (bf16_t*)a->out; float* ssq = (float*)(a->ws + W_SSQ);
    const size_t row = (size_t)NPR + b;
    const float xv = conv1_(a, XBC, b, row, hd * 64 + lane);
    wl[lane] = conv1_(a, XBC, b, row, 2048 + g * 128 + lane); wl[64 + lane] = conv1_(a, XBC, b, row, 2048 + g * 128 + 64 + lane);
    wl[128 + lane] = conv1_(a, XBC, b, row, 3072 + g * 128 + lane); wl[192 + lane] = conv1_(a, XBC, b, row, 3072 + g * 128 + 64 + lane);
    const float dtv = softplusf_(DT[row * 32 + hd] + a->in[I_DTB][hd]), dA = __expf(-__expf(a->in[I_ALOG][hd]) * dtv), xdt = dtv * xv;
    const size_t so = ((size_t)(b * 32 + hd) * 64 + lane) * 128;
    float y = 0.f;
#pragma unroll 8
    for (int q = 0; q < 32; ++q) {
        f32x4 hv = *(const f32x4*)(a->in[I_SSSM] + so + q * 4); const f32x4 Bv = *(const LAS f32x4*)(wl + q * 4), Cv = *(const LAS f32x4*)(wl + 128 + q * 4);
        hv = hv * dA + Bv * xdt; y += hv[0] * Cv[0] + hv[1] * Cv[1] + hv[2] * Cv[2] + hv[3] * Cv[3];
        *(f32x4*)(a->out + O_SSMS + so + q * 4) = hv;
    }
    const float yv = y + a->in[I_DSKIP][hd] * xv;
    bf16_t* zp = Z + row * 2048 + hd * 64 + lane; const float z = bf2f(*zp), yg = yv * z * sigm(z);
    *zp = f2bf(yg);
    const float sq = red64(yg * yg);
    if (lane == 0) atomicAdd(ssq + row * 8 + g, sq);
}

__device__ __forceinline__ void phase_mix(KA a, LAS unsigned char* lds) {
    const int tid = tidx(), nW = gridDim.x, wg = blockIdx.x;
    const bf16_t* XBC = (const bf16_t*)(a->ws + W_XBC);
    const int half = nW / 2;
    constexpr int SSD_SAMPLES_RWKV_SIDE = 1024;
    if (wg < half) {
        { const int gw = wg * 8 + (tid >> 6), ngw = half * 8; LAS float* wl = (LAS float*)(lds + (tid >> 6) * 4096);
          for (int it = gw; it < SSD_SAMPLES_RWKV_SIDE; it += ngw) ssd_sample_wave(a, wl, it >> 5, it & 31); }
        bar();
        for (int it = wg; it < 128; it += half) rwkv_prompt_item(a, lds, it >> 4, it & 15);
        bar();
        const int gw = wg * 8 + (tid >> 6), ngw = half * 8; LAS float* wl = (LAS float*)(lds + (tid >> 6) * 4096);
        for (int it = gw; it < 2048; it += ngw) rwkv_sample_wave(a, wl, it >> 4, it & 15);
    }
    else {
        const int w = wg - half, ns = nW - half;
        for (size_t i = (size_t)w * 512 + tid; i < (size_t)8 * 3 * 4096; i += (size_t)ns * 512) { const int c = (int)(i & 4095), j = (int)((i >> 12) % 3), b = (int)(i / 12288); a->out[O_CONVP + i] = bf2f(XBC[((size_t)b * 2048 + 2045 + j) * 4096 + c]); }
        for (size_t i = (size_t)w * 512 + tid; i < (size_t)128 * 3 * 4096; i += (size_t)ns * 512) { const int c = (int)(i & 4095), j = (int)((i >> 12) % 3), b = (int)(i / 12288);
            a->out[O_CONVS + i] = j < 2 ? a->in[I_SCONV][(size_t)b * 12288 + (j + 1) * 4096 + c] : bf2f(XBC[((size_t)NPR + b) * 4096 + c]); }
        {
            const int gw = w * 8 + (tid >> 6), ngw = ns * 8; LAS float* wl = (LAS float*)(lds + (tid >> 6) * 4096);
            for (int it = SSD_SAMPLES_RWKV_SIDE + gw; it < 4096; it += ngw) ssd_sample_wave(a, wl, it >> 5, it & 31);
        }
        bar();
        for (int it = w; it < 256; it += ns) ssd_prompt_item(a, lds, it >> 5, it & 31);
    }
}

__device__ __forceinline__ void phase_ssdnorm(KA a) {
    u32x4* Z = (u32x4*)a->out; const float* ssq = (const float*)(a->ws + W_SSQ);
    for (size_t i = (size_t)blockIdx.x * 512 + tidx(); i < (size_t)T * 256; i += (size_t)gridDim.x * 512) {
        const size_t row = i >> 8; const int gi = (int)(i & 255) >> 5;
        const float rs = rsqrtf(ssq[row * 8 + gi] * (1.0f / 256.0f) + EPS);
        u32x4 w = Z[i];
#pragma unroll
        for (int q = 0; q < 4; ++q) w[q] = cvt_pk_bf16(bflo(w[q]) * rs, bfhi(w[q]) * rs);
        Z[i] = w;
    }
}

__device__ __forceinline__ unsigned f2key(float f) { const unsigned u = __float_as_uint(f); return (u & 0x80000000u) ? ~u : (u | 0x80000000u); }
__device__ __forceinline__ float key2f(unsigned k) { return __uint_as_float((k & 0x80000000u) ? (k & 0x7fffffffu) : ~k); }
#define TOPK_INSERT(top, x) do { _Pragma("unroll") for (int _q = 0; _q < 16; ++_q) { const unsigned _hi = max(top[_q], x); x = min(top[_q], x); top[_q] = _hi; } } while (0)

__device__ __forceinline__ void phase_peer(KA a, LAS unsigned char* lds) {
    const int tid = tidx(), lane = tid & 63, wid = tid >> 6, quad = lane >> 4, l16 = lane & 15;
    LAS float* S = (LAS float*)lds;
    LAS unsigned* TK = (LAS unsigned*)(lds + 132096);
    LAS int* EI = (LAS int*)lds;
    LAS float* EG = (LAS float*)(lds + 8192);
    const bf16_t* Q = (const bf16_t*)(a->ws + W_Q); const bf16_t* K12 = (const bf16_t*)(a->ws + W_K12);
    const unsigned char* PUq = a->ws + W_PU; const unsigned char* PVq = a->ws + W_PV; const float* PUS = (const float*)(a->ws + W_PU + 16777216); const float* PVS = (const float*)(a->ws + W_PV + 16777216);
    const bf16_t* X1B = (const bf16_t*)(a->ws + W_X1B); bf16_t* X2B = (bf16_t*)(a->ws + W_X2B);
    const float* ss1 = (const float*)(a->ws + W_SS) + TP; float* ss2 = (float*)(a->ws + W_SS) + 2 * TP;
    const int t_beg = (int)(((long)blockIdx.x * T) / gridDim.x), t_end = (int)(((long)(blockIdx.x + 1) * T) / gridDim.x);
    for (int tb = t_beg; tb < t_end; tb += 16) {
        const size_t tok0 = (size_t)tb; const int nt = (t_end - tb) < 16 ? (t_end - tb) : 16;
#pragma unroll 1
        for (int hq = 0; hq < 2; ++hq) {
            const int hh = wid * 2 + hq;
            bf16x8 af[4];
#pragma unroll
            for (int kk = 0; kk < 4; ++kk) af[kk] = *(const bf16x8*)(Q + (tok0 + (l16 < nt ? l16 : nt - 1)) * 2048 + hh * 128 + kk * 32 + quad * 8);
#pragma unroll 2
            for (int nt = 0; nt < 8; ++nt) {
                f32x4 acc = {0.f, 0.f, 0.f, 0.f};
#pragma unroll
                for (int kk = 0; kk < 4; ++kk) acc = mfma16(af[kk], *(const bf16x8*)(K12 + ((size_t)hh * 128 + nt * 16 + l16) * 128 + kk * 32 + quad * 8), acc);
#pragma unroll
                for (int j = 0; j < 4; ++j) S[((quad * 4 + j) * 16 + hh) * 129 + nt * 16 + l16] = acc[j];
            }
        }
        bar();
        if (tid < 256) {
            unsigned top[16];
#pragma unroll
            for (int q = 0; q < 16; ++q) top[q] = 0u;
            for (int i = 0; i < 128; ++i) { unsigned x = (f2key(S[tid * 129 + i]) & ~127u) | (unsigned)(127 - i); TOPK_INSERT(top, x); }
#pragma unroll
            for (int q = 0; q < 16; ++q) TK[tid * 16 + q] = top[q];
        }
        bar();
        if (tid < 128) {
            const int t = tid >> 3, head = tid & 7, r1 = (t * 16 + head * 2) * 16, r2 = r1 + 16;
            float f1[16], f2[16];
#pragma unroll
            for (int q = 0; q < 16; ++q) { f1[q] = key2f(TK[r1 + q]); f2[q] = key2f(TK[r2 + q]); }
            unsigned top[16];
#pragma unroll
            for (int q = 0; q < 16; ++q) top[q] = 0u;
#pragma unroll
            for (int i = 0; i < 16; ++i)
#pragma unroll
                for (int j = 0; j < 16; ++j)
                    if ((i + 1) * (j + 1) <= 16) { unsigned x = (f2key(f1[i] + f2[j]) & ~255u) | (unsigned)(255 - (i * 16 + j)); TOPK_INSERT(top, x); }
            float sv[16]; int id[16]; float mx = -3.0e38f;
#pragma unroll
            for (int q = 0; q < 16; ++q) {
                const int pos = 255 - (int)(top[q] & 255u), i = pos >> 4, j = pos & 15;
                const unsigned k1 = TK[r1 + i], k2 = TK[r2 + j];
                sv[q] = key2f(k1) + key2f(k2); id[q] = (127 - (int)(k1 & 127u)) * 128 + (127 - (int)(k2 & 127u)); mx = fmaxf(mx, sv[q]);
            }
            float den = 0.f;
#pragma unroll
            for (int q = 0; q < 16; ++q) { sv[q] = __expf(sv[q] - mx); den += sv[q]; }
            const float rden = 1.0f / den;
#pragma unroll
            for (int q = 0; q < 16; ++q) { EI[t * 128 + head * 16 + q] = id[q]; EG[t * 128 + head * 16 + q] = sv[q] * rden; }
        }
        bar();
#pragma unroll 1
        for (int tq = 0; tq < 2; ++tq) {
            const int tt = wid * 2 + tq; const size_t tok = tok0 + tt;
            if (tt >= nt) continue;
            const u32x4 xa = *(const u32x4*)(X1B + tok * 1024 + lane * 16), xb = *(const u32x4*)(X1B + tok * 1024 + lane * 16 + 8);
            f32x2 xf[8];
#pragma unroll
            for (int q = 0; q < 4; ++q) { xf[q] = (f32x2){bflo(xa[q]), bfhi(xa[q])}; xf[4 + q] = (f32x2){bflo(xb[q]), bfhi(xb[q])}; }
            const float rs = rsqrtf(ss1[tok] * (1.0f / 1024.0f) + EPS);
            f32x2 out2[8];
#pragma unroll
            for (int q = 0; q < 8; ++q) out2[q] = (f32x2){0.f, 0.f};
#pragma unroll 1
            for (int hf = 0; hf < 2; ++hf) {
                float dl = 0.f;
#pragma unroll 1
                for (int e0 = 0; e0 < 64; e0 += 8) {
                    u32x4 w[8]; float rsc[8];
#pragma unroll
                    for (int u = 0; u < 8; ++u) { const int idx = __builtin_amdgcn_readfirstlane(EI[tt * 128 + hf * 64 + e0 + u]); w[u] = *(const u32x4*)(PUq + (size_t)idx * 1024 + lane * 16); rsc[u] = PUS[idx]; }
#pragma unroll
                    for (int u = 0; u < 8; ++u) {
                        f32x2 acc = {0.f, 0.f};
#pragma unroll
                        for (int q = 0; q < 4; ++q) { acc += xf[2 * q] * __builtin_amdgcn_cvt_pk_f32_fp8((int)w[u][q], false); acc += xf[2 * q + 1] * __builtin_amdgcn_cvt_pk_f32_fp8((int)w[u][q], true); }
                        const float d = red64(acc.x + acc.y) * rsc[u];
                        dl = (lane == e0 + u) ? d : dl;
                    }
                }
                const float z = dl * rs, act = 0.5f * z * (1.0f + erff(z * 0.70710678f));
                const float cl = EG[tt * 128 + hf * 64 + lane] * act;
#pragma unroll 1
                for (int e0 = 0; e0 < 64; e0 += 8) {
                    u32x4 w[8]; float cc[8];
#pragma unroll
                    for (int u = 0; u < 8; ++u) { const int idx = __builtin_amdgcn_readfirstlane(EI[tt * 128 + hf * 64 + e0 + u]); w[u] = *(const u32x4*)(PVq + (size_t)idx * 1024 + lane * 16);
                        cc[u] = __int_as_float(__builtin_amdgcn_readlane(__float_as_int(cl), e0 + u)) * PVS[idx]; }
#pragma unroll
                    for (int u = 0; u < 8; ++u) { const f32x2 c2 = {cc[u], cc[u]};
#pragma unroll
                        for (int q = 0; q < 4; ++q) { out2[2 * q] += c2 * __builtin_amdgcn_cvt_pk_f32_fp8((int)w[u][q], false); out2[2 * q + 1] += c2 * __builtin_amdgcn_cvt_pk_f32_fp8((int)w[u][q], true); } }
                }
            }
            float out[16];
#pragma unroll
            for (int q = 0; q < 8; ++q) { out[2 * q] = out2[q].x; out[2 * q + 1] = out2[q].y; }
            const float* xr = a->out + tok * 1024 + lane * 16; float* xw = (float*)(a->ws + W_P1) + tok * 1024 + lane * 16; float sq = 0.f; unsigned pk[8];
#pragma unroll
            for (int q = 0; q < 4; ++q) { f32x4 v = *(const f32x4*)(xr + q * 4);
#pragma unroll
                for (int j = 0; j < 4; ++j) { v[j] += out[q * 4 + j]; sq += v[j] * v[j]; }
                *(f32x4*)(xw + q * 4) = v; pk[2 * q] = cvt_pk_bf16(v[0], v[1]); pk[2 * q + 1] = cvt_pk_bf16(v[2], v[3]); }
            *(u32x4*)(X2B + tok * 1024 + lane * 16) = (u32x4){pk[0], pk[1], pk[2], pk[3]}; *(u32x4*)(X2B + tok * 1024 + lane * 16 + 8) = (u32x4){pk[4], pk[5], pk[6], pk[7]};
            sq = red64(sq);
            if (lane == 0) ss2[tok] = sq;
        }
        bar();
    }
}

__device__ __forceinline__ void phase_final(KA a) {
    f32x4* X = (f32x4*)a->out; const float* ss3 = (const float*)(a->ws + W_SS) + 3 * TP; const f32x4* gn = (const f32x4*)a->in[I_NFIN];
    for (size_t i = (size_t)blockIdx.x * 512 + tidx(); i < (size_t)T * 256; i += (size_t)gridDim.x * 512) {
        const float rs = rsqrtf(ss3[i >> 8] * (1.0f / 1024.0f) + EPS);
        X[i] = X[i] * rs * gn[i & 255];
    }
}

__global__ void __launch_bounds__(512) hybrid_fwd(Args a_unused) {
    extern __shared__ __attribute__((aligned(16))) unsigned char lds_raw[];
    LAS unsigned char* lds = (LAS unsigned char*)lds_raw;
    cg::grid_group grid = cg::this_grid();
    KA a = (KA)__builtin_amdgcn_kernarg_segment_ptr();
    unsigned char* ws = a->ws;
    float* ss = (float*)(ws + W_SS);
    const int ph_lo = a->ph_lo, ph_hi = a->ph_hi;
#ifndef PROBE_REP
#define PROBE_REP 0
#endif
    unsigned* barcnt = (unsigned*)(ws + W_BAR); unsigned nbar = 0;
    if (ph_hi > 1000) grid.sync();
#define GRID_SYNC() do { ++nbar; grid_barrier(barcnt, nbar); } while (0)
#define PH_BEGIN(k) if (ph_lo <= (k) && (k) < ph_hi) { if ((k) > ph_lo) GRID_SYNC(); for (int rep_ = 0; rep_ < 1 + ((PROBE_REP >> (k)) & 1); ++rep_) { if (rep_) GRID_SYNC();
#define PH_END } }
    PH_BEGIN(0)  phase_prep(a, lds); PH_END
    PH_BEGIN(1)  { EpiU E; E.Z = (bf16_t*)a->out; E.XBC = (bf16_t*)(ws + W_XBC); E.RW = (bf16_t*)(ws + W_RW); E.G = (bf16_t*)(ws + W_G); E.DT = (float*)(ws + W_DT); E.ss0 = ss;
                  run_gemm<EpiU, false>(lds, (const bf16_t*)(ws + W_XB), 1024, (const bf16_t*)(ws + W_WIN), 1024, NU, 1024, E); } PH_END
    PH_BEGIN(2)  phase_mix(a, lds); PH_END
    PH_BEGIN(3)  phase_ssdnorm(a); PH_END
    PH_BEGIN(4)  { EpiMix<0> E0; E0.P = (float*)(ws + W_P1); E0.V = nullptr; E0.G = (const bf16_t*)(ws + W_G); E0.goff = 0;
                  run_gemm(lds, (const bf16_t*)a->out, 2048, (const bf16_t*)(ws + W_WOS), 2048, 1024, 2048, E0);
                  __threadfence(); __syncthreads();
                  EpiMix<1> E1; E1.P = (float*)(ws + W_P1); E1.V = (bf16_t*)(ws + W_V); E1.G = (const bf16_t*)(ws + W_G); E1.goff = 1024;
                  run_gemm(lds, (const bf16_t*)(ws + W_RW), 3328, (const bf16_t*)(ws + W_WOR), 1024, 1024, 1024, E1); } PH_END
    PH_BEGIN(5)  { EpiRes<0> E; E.xp = a->in[I_XP]; E.xs = a->in[I_XS]; E.X = a->out; E.XB = (bf16_t*)(ws + W_X1B); E.ss = ss + TP; E.ssin = nullptr; E.P = nullptr;
                  run_gemm(lds, (const bf16_t*)(ws + W_V), 1024, (const bf16_t*)(ws + W_WO), 1024, 1024, 1024, E); } PH_END
    PH_BEGIN(6)  { EpiQ E; E.O = (bf16_t*)(ws + W_Q); E.ld = 2048; E.ss = ss + TP;
                  run_gemm(lds, (const bf16_t*)(ws + W_X1B), 1024, (const bf16_t*)(ws + W_WQ), 1024, 2048, 1024, E); } PH_END
    PH_BEGIN(7)  phase_peer(a, lds); PH_END
    PH_BEGIN(8)  { EpiMix<2> E0; E0.P = (float*)(ws + W_PP); E0.V = nullptr; E0.G = nullptr; E0.goff = 0;
                  run_gemm(lds, (const bf16_t*)(ws + W_PB), 256, (const bf16_t*)(ws + W_WPP), 256, 1024, 256, E0);
                  __threadfence(); __syncthreads();
                  EpiRes<1> E; E.xp = (const float*)(ws + W_P1); E.xs = nullptr; E.X = a->out; E.XB = nullptr; E.ss = ss + 3 * TP; E.ssin = ss + 2 * TP; E.P = (const float*)(ws + W_PP);
                  run_gemm(lds, (const bf16_t*)(ws + W_X2B), 1024, (const bf16_t*)(ws + W_WPG), 1024, 1024, 1024, E); } PH_END
    PH_BEGIN(9) phase_final(a); PH_END
}

extern "C" void kernel_launch(void* const* d_in, const int* in_sizes, int n_in, void* d_out, int out_size, void* d_ws, size_t ws_size, hipStream_t stream) {
    static int grid = 0;
    if (grid == 0) {
        if (n_in != 40 || (size_t)out_size != O_END || ws_size < W_TOTAL) { fprintf(stderr, "kernel_launch: unexpected shapes: n_in %d out %d ws %zu (need %zu)\n", n_in, out_size, ws_size, (size_t)W_TOTAL); grid = -1; return; }
        int dev = 0, cus = 0, per_cu = 0;
        hipGetDevice(&dev); hipDeviceGetAttribute(&cus, hipDeviceAttributeMultiprocessorCount, dev);
        if (hipFuncSetAttribute((const void*)hybrid_fwd, hipFuncAttributeMaxDynamicSharedMemorySize, LDS_BYTES) != hipSuccess) { fprintf(stderr, "kernel_launch: hipFuncSetAttribute failed\n"); grid = -1; return; }
        if (hipOccupancyMaxActiveBlocksPerMultiprocessor(&per_cu, (const void*)hybrid_fwd, 512, LDS_BYTES) != hipSuccess || per_cu < 1) { fprintf(stderr, "kernel_launch: occupancy query says %d\n", per_cu); per_cu = 1; }
        (void)hipGetLastError();
        grid = cus * 1;
        if (grid > 256) grid = 256;
    }
    if (grid < 0) return;
    (void)hipMemsetAsync((unsigned char*)d_ws + W_BAR, 0, 4096, stream);
    Args a{};
    for (int i = 0; i < 40; ++i) a.in[i] = (const float*)d_in[i];
    a.out = (float*)d_out; a.ws = (unsigned char*)d_ws;
#if MULTI_LAUNCH
    for (int ph = 0; ph < NPHASE; ++ph) { a.ph_lo = ph; a.ph_hi = ph + 1; hipLaunchKernelGGL(hybrid_fwd, dim3(grid), dim3(512), LDS_BYTES, stream, a); }
#else
    a.ph_lo = 0; a.ph_hi = NPHASE;
    void* args[] = {&a};
    hipError_t e = hipLaunchCooperativeKernel((const void*)hybrid_fwd, dim3(grid), dim3(512), args, LDS_BYTES, stream);
    if (e != hipSuccess) fprintf(stderr, "kernel_launch: cooperative launch failed: %s (grid %d)\n", hipGetErrorString(e), grid);
#endif
}
```

```cpp
#include <hip/hip_runtime.h>
#include <hip/hip_cooperative_groups.h>
#include <cstdio>
namespace cg = cooperative_groups;
#ifndef MULTI_LAUNCH
#define MULTI_LAUNCH 0
#endif
__device__ __forceinline__ int tidx() { int t = threadIdx.x; asm volatile("" : "+v"(t)); return t; }
namespace pg8 {
#define PG8_LAS __attribute__((address_space(3)))
typedef unsigned short bf16_t;
typedef short bf16x8 __attribute__((ext_vector_type(8)));
typedef float f32x4 __attribute__((ext_vector_type(4)));
typedef unsigned u32x4 __attribute__((ext_vector_type(4)));
constexpr int BM = 256, BK = 64, HALF = 128, HTB = HALF * BK * 2  , STAGE_BYTES = 8 * HTB, NXCD = 8, WGM = 8;

__host__ __device__ __forceinline__ int lds_byte(int r, int c) { const int st = (r >> 4) * 2 + (c >> 5), rr = r & 15, cc = c & 31, ob = rr * 64 + cc * 2; return st * 1024 + (ob ^ (((ob >> 9) & 1) << 5)); }
__host__ __device__ __forceinline__ void stage_rc(int b, int& R, int& C) { const int st = b / 1024, sb = b % 1024, swz = sb ^ (((sb >> 9) & 1) << 5); R = (st >> 1) * 16 + swz / 64; C = (st & 1) * 32 + (swz % 64) / 2; }
__host__ __device__ __forceinline__ int perm32(int rho) { const int n = rho >> 4, i = rho & 15; return 8 * (i >> 2) + 4 * n + (i & 3); }

struct Unit { int pm, pn; };
struct Gemm { const bf16_t* A; const bf16_t* Bt; int M, N, K, lda, ldb; };

struct StaticOrder {
    int nM, nN, nwg, G, c;
    __host__ __device__ void init(int M, int N, int G_, int c_) { nM = M / BM; nN = N / BM; nwg = nM * nN; G = G_; c = c_; }
    __host__ __device__ bool next(int i, Unit& u) const {
        const long L = (long)i * G + c; if (L >= nwg) return false;
        int wgid = (int)L; { const int q = nwg / NXCD, r = nwg % NXCD, xcd = wgid % NXCD, off = wgid / NXCD; wgid = (xcd < r ? xcd * (q + 1) : r * (q + 1) + (xcd - r) * q) + off; }
        const int nig = WGM * nN, gid = wgid / nig, fm = gid * WGM, gsz = (nM - fm) < WGM ? (nM - fm) : WGM;
        u.pm = fm + ((wgid % nig) % gsz); u.pn = (wgid % nig) / gsz; return true;
    }
    __device__ __forceinline__ void a_ready(const Unit&) const {}
    __device__ __forceinline__ void done(const Unit&) const {}
};
__device__ __forceinline__ unsigned cvt_pk_bf16(float lo, float hi) { unsigned r; asm volatile("v_cvt_pk_bf16_f32 %0, %1, %2" : "=v"(r) : "v"(lo), "v"(hi)); return r; }
template <class Epi, class Sched>
__device__ __forceinline__ void gemm_phase(PG8_LAS unsigned char* lds, const Gemm g, const Sched& S, const Epi& E) {
    const int tid = tidx(), wid = __builtin_amdgcn_readfirstlane(tid >> 6), lane = tid & 63, wr = wid >> 2, wc = wid & 3, fr = lane & 15, fq = lane >> 4;
    const int K = g.K, nt = K / BK;
    unsigned voffA[2], voffB[2];
#pragma unroll
    for (int i = 0; i < 2; ++i) { int R, C; stage_rc(tid * 16 + i * 8192, R, C); const int Rb = Epi::PERM ? ((R & ~31) + perm32(R & 31)) : R;
        voffA[i] = (unsigned)(R * g.lda + C) * 2u; voffB[i] = (unsigned)(Rb * g.ldb + C) * 2u; }
    const size_t kstep = (size_t)(BK * 2);
    const size_t hstepA = (size_t)HALF * g.lda * 2, hstepB = (size_t)HALF * g.ldb * 2;
    const size_t tstepA = 2 * hstepA, tstepB = 2 * hstepB;
    const unsigned ldsw = (unsigned)wid * 1024u;
    const int aoff = lds_byte(wr * 64 + fr, fq * 8), boff = lds_byte(wc * 32 + fr, fq * 8);
#define PG8_SA(b, h) (((b) * 2 + (h)) * HTB)
#define PG8_SB(b, h) ((4 + (b) * 2 + (h)) * HTB)
#define PG8_STAGE(bufoff, gbase, voff) do { _Pragma("unroll") for (int _i = 0; _i < 2; ++_i) \
        __builtin_amdgcn_global_load_lds((const unsigned*)((const char*)(gbase) + (voff)[_i]), (PG8_LAS unsigned*)(lds + (bufoff) + ldsw + _i * 8192), 16, 0, 0); } while (0)
#define PG8_LDA(dst, b, h) do { _Pragma("unroll") for (int m = 0; m < 4; ++m) _Pragma("unroll") for (int k = 0; k < 2; ++k) dst[m][k] = *(const PG8_LAS bf16x8*)(lds + PG8_SA(b, h) + aoff + m * 2048 + k * 1024); } while (0)
#define PG8_LDB(dst, b, h) do { _Pragma("unroll") for (int n = 0; n < 2; ++n) _Pragma("unroll") for (int k = 0; k < 2; ++k) dst[n][k] = *(const PG8_LAS bf16x8*)(lds + PG8_SB(b, h) + boff + n * 2048 + k * 1024); } while (0)
#define PG8_MMA(ai, bj, At, Bt) do { __builtin_amdgcn_s_setprio(1); _Pragma("unroll") for (int m = 0; m < 4; ++m) _Pragma("unroll") for (int n = 0; n < 2; ++n) _Pragma("unroll") for (int k = 0; k < 2; ++k) \
        acc[ai][bj][m][n] = __builtin_amdgcn_mfma_f32_16x16x32_bf16(Bt[n][k], At[m][k], acc[ai][bj][m][n], 0, 0, 0); __builtin_amdgcn_s_setprio(0); } while (0)
#define PG8_WAIT_V(n) asm volatile("s_waitcnt vmcnt(" #n ")" ::: "memory")
#define PG8_WAIT_L(n) asm volatile("s_waitcnt lgkmcnt(" #n ")" ::: "memory")
#define PG8_BAR __builtin_amdgcn_s_barrier()
#define PG8_SCHED __builtin_amdgcn_sched_barrier(0)
    Unit cur, nxt; int ui = 0;
    if (!S.next(0, cur)) return;
    f32x4 acc[2][2][4][2];
#pragma unroll
    for (int a = 0; a < 2; ++a)
#pragma unroll
        for (int b = 0; b < 2; ++b)
#pragma unroll
            for (int m = 0; m < 4; ++m)
#pragma unroll
                for (int n = 0; n < 2; ++n) acc[a][b][m][n] = (f32x4){0.f, 0.f, 0.f, 0.f};
    bf16x8 At[4][2], B0[2][2], B1[2][2];
    const char* cA = (const char*)g.A + (size_t)cur.pm * tstepA; const char* cB = (const char*)g.Bt + (size_t)cur.pn * tstepB;
    S.a_ready(cur);
    PG8_STAGE(PG8_SB(0, 0), cB, voffB); PG8_STAGE(PG8_SA(0, 0), cA, voffA); PG8_STAGE(PG8_SB(0, 1), cB + hstepB, voffB); PG8_STAGE(PG8_SA(0, 1), cA + hstepA, voffA);
    if (wr == 1) PG8_BAR;
    PG8_WAIT_V(4); PG8_BAR;
    PG8_STAGE(PG8_SB(1, 0), cB + kstep, voffB); PG8_STAGE(PG8_SA(1, 0), cA + kstep, voffA); PG8_STAGE(PG8_SB(1, 1), cB + hstepB + kstep, voffB);
    PG8_WAIT_V(6); PG8_BAR;
    for (;;) {
        const bool has_next = S.next(ui + 1, nxt);
        const char* nA = has_next ? (const char*)g.A + (size_t)nxt.pm * tstepA : cA; const char* nB = has_next ? (const char*)g.Bt + (size_t)nxt.pn * tstepB : cB;
        for (int t = 0; t < nt; t += 2) {
            const bool last = (t == nt - 2);
            const char* a1 = cA + (size_t)(t + 1) * kstep;
            const char* a2 = last ? nA : cA + (size_t)(t + 2) * kstep; const char* b2 = last ? nB : cB + (size_t)(t + 2) * kstep;
            const char* a3 = a2 + kstep; const char* b3 = b2 + kstep;
            if (last && has_next) S.a_ready(nxt);
            PG8_LDB(B0, 0, 0); PG8_SCHED; PG8_LDA(At, 0, 0); PG8_STAGE(PG8_SA(1, 1), a1 + hstepA, voffA);
            PG8_WAIT_L(8); PG8_BAR; PG8_WAIT_L(0); PG8_MMA(0, 0, At, B0); PG8_BAR; PG8_SCHED;
            PG8_LDB(B1, 0, 1); PG8_STAGE(PG8_SB(0, 0), b2, voffB);
            PG8_BAR; PG8_WAIT_L(0); PG8_MMA(0, 1, At, B1); PG8_BAR;
            PG8_LDA(At, 0, 1); PG8_STAGE(PG8_SA(0, 0), a2, voffA);
            PG8_BAR; PG8_WAIT_L(0); PG8_MMA(1, 0, At, B0); PG8_BAR; PG8_SCHED;
            PG8_STAGE(PG8_SB(0, 1), b2 + hstepB, voffB);
            PG8_WAIT_V(6); PG8_BAR; PG8_MMA(1, 1, At, B1); PG8_BAR;
            PG8_LDB(B0, 1, 0); PG8_SCHED; PG8_LDA(At, 1, 0); PG8_STAGE(PG8_SA(0, 1), a2 + hstepA, voffA);
            PG8_WAIT_L(8); PG8_BAR; PG8_WAIT_L(0); PG8_MMA(0, 0, At, B0); PG8_BAR; PG8_SCHED;
            PG8_LDB(B1, 1, 1); PG8_STAGE(PG8_SB(1, 0), b3, voffB);
            PG8_BAR; PG8_WAIT_L(0); PG8_MMA(0, 1, At, B1); PG8_BAR;
            PG8_LDA(At, 1, 1); PG8_STAGE(PG8_SA(1, 0), a3, voffA);
            PG8_BAR; PG8_WAIT_L(0); PG8_MMA(1, 0, At, B0); PG8_BAR; PG8_SCHED;
            PG8_STAGE(PG8_SB(1, 1), b3 + hstepB, voffB);
            PG8_WAIT_V(6); PG8_BAR; PG8_MMA(1, 1, At, B1); PG8_BAR;
        }
        if constexpr (!Epi::AFTER_DRAIN) { E(acc, cur, wr, wc, fr, fq); S.done(cur); }
        if (!has_next) break;
#pragma unroll
        for (int a = 0; a < 2; ++a)
#pragma unroll
            for (int b = 0; b < 2; ++b)
#pragma unroll
                for (int m = 0; m < 4; ++m)
#pragma unroll
                    for (int n = 0; n < 2; ++n) acc[a][b][m][n] = (f32x4){0.f, 0.f, 0.f, 0.f};
        cur = nxt; cA = nA; cB = nB; ++ui;
    }
    PG8_WAIT_V(0);
    if (wr == 0) PG8_BAR;
    PG8_BAR;
    if constexpr (Epi::AFTER_DRAIN) { E.fused(acc, cur, wr, wc, fr, fq, lds, wid, lane); S.done(cur); }
#undef PG8_SA
#undef PG8_SB
#undef PG8_STAGE
#undef PG8_LDA
#undef PG8_LDB
#undef PG8_MMA
#undef PG8_WAIT_V
#undef PG8_WAIT_L
#undef PG8_BAR
#undef PG8_SCHED
}
}

#define LAS __attribute__((address_space(3)))
using pg8::bf16_t; using pg8::bf16x8; using pg8::f32x4; using pg8::u32x4; using pg8::cvt_pk_bf16;
typedef unsigned u32x2 __attribute__((ext_vector_type(2)));
typedef float f32x2 __attribute__((ext_vector_type(2)));
typedef __bf16 bfp2 __attribute__((ext_vector_type(2)));

constexpr int DM = 1024, NBAT = 8, SEQ = 2048, NPR = NBAT * SEQ, NSM = 128, T = NPR + NSM, TP = 16640;
constexpr int NU = 11776;
constexpr int SHIFT = 3328;
constexpr float EPS = 1e-6f;
constexpr size_t O_SSMP = (size_t)T * 1024, O_CONVP = O_SSMP + 8 * 32 * 64 * 128, O_WKVP = O_CONVP + 8 * 3 * 4096, O_SHIFTP = O_WKVP + 8 * 16 * 64 * 64,
                 O_SSMS = O_SHIFTP + 8 * 3328, O_CONVS = O_SSMS + (size_t)128 * 32 * 64 * 128, O_WKVS = O_CONVS + 128 * 3 * 4096, O_SHIFTS = O_WKVS + (size_t)128 * 16 * 64 * 64,
                 O_END = O_SHIFTS + 128 * 3328;
constexpr size_t W_WIN = 0, W_WOS = W_WIN + (size_t)NU * 1024 * 2, W_WOR = W_WOS + 1024 * 2048 * 2, W_WO = W_WOR + 1024 * 1024 * 2, W_WQ = W_WO + 1024 * 1024 * 2,
                 W_WPG = W_WQ + 2048 * 1024 * 2, W_WPP = W_WPG + 1024 * 1024 * 2, W_K12 = W_WPP + 1024 * 256 * 2, W_PU = W_K12 + 8 * 2 * 128 * 128 * 2,
                 W_PV = W_PU + (size_t)16384 * 1024 * 2, W_XB = W_PV + (size_t)16384 * 1024 * 2, W_XBC = W_XB + (size_t)TP * 1024 * 2, W_RW = W_XBC + (size_t)TP * 4096 * 2,
                 W_G = W_RW + (size_t)TP * 3328 * 2, W_DT = W_G + (size_t)TP * 2048 * 2, W_PB = W_DT + (size_t)TP * 32 * 4, W_SS = W_PB + (size_t)TP * 256 * 2,
                 W_SSQ = W_SS + (size_t)4 * TP * 4, W_END = W_SSQ + (size_t)TP * 8 * 4;
constexpr size_t W_BAR = W_END, W_TOTAL = W_END + 4096;
constexpr size_t W_P1 = W_XBC, W_X1B = W_XBC + (size_t)TP * 1024 * 4, W_V = W_XB, W_X2B = W_XB, W_Q = W_RW, W_PP = W_RW;
constexpr int LDS_BYTES = 155648;
constexpr int NPHASE = 10;

struct Args { const float* in[40]; float* out; unsigned char* ws; int ph_lo, ph_hi; };
typedef const Args __attribute__((address_space(4)))* KA;

enum { I_XP = 0, I_XS, I_PP, I_PS, I_SSSM, I_SCONV, I_SWKV, I_SSHIFT, I_NMIX, I_WIN, I_CONVW, I_CONVB, I_DTB, I_ALOG, I_DSKIP, I_SSMN, I_WOSSM, I_MU, I_W0, I_W2, I_A0, I_A2, I_G2,
       I_KK, I_KA, I_RK, I_LNG, I_LNB, I_WORW, I_WOUT, I_NFFN, I_WQ, I_K1, I_K2, I_PU, I_PV, I_NPLE, I_WPG, I_WPP, I_NFIN };

__device__ __forceinline__ float bf2f(bf16_t b) { return __uint_as_float(((unsigned)b) << 16); }
__device__ __forceinline__ float bflo(unsigned w) { return __uint_as_float(w << 16); }
__device__ __forceinline__ float bfhi(unsigned w) { return __uint_as_float(w & 0xffff0000u); }
__device__ __forceinline__ bf16_t f2bf(float f) { return (bf16_t)(cvt_pk_bf16(f, 0.f) & 0xffffu); }
__device__ __forceinline__ float sigm(float x) { return __builtin_amdgcn_rcpf(1.0f + __expf(-x)); }
__device__ __forceinline__ float tanh_fast(float x) { return 2.0f * sigm(2.0f * x) - 1.0f; }
template <int CTRL> __device__ __forceinline__ float dppm(float x) { return __int_as_float(__builtin_amdgcn_update_dpp(0, __float_as_int(x), CTRL, 0xF, 0xF, true)); }
__device__ __forceinline__ float red8(float x) { x += dppm<0xB1>(x); x += dppm<0x4E>(x); x += dppm<0x141>(x); return x; }
__device__ __forceinline__ float red16(float x) { x = red8(x); x += dppm<0x140>(x); return x; }
__device__ __forceinline__ float red64(float x) { x = red16(x); x += __shfl_xor(x, 16); x += __shfl_xor(x, 32); return x; }
__device__ __forceinline__ f32x4 mfma16(bf16x8 a, bf16x8 b, f32x4 c) { return __builtin_amdgcn_mfma_f32_16x16x32_bf16(a, b, c, 0, 0, 0); }
__device__ __forceinline__ void bar() { __syncthreads(); }
__device__ __forceinline__ void bar_lds() { asm volatile("s_waitcnt lgkmcnt(0)\n\ts_barrier" ::: "memory"); }

__device__ __forceinline__ void peer_quant_row(KA a, int r) {
    const int lane = tidx() & 63; unsigned char* ws = a->ws;
    const bool isv = r >= 16384; const int e = r & 16383;
    const float* src = (isv ? a->in[I_PV] : a->in[I_PU]) + (size_t)e * 1024 + lane * 16;
    f32x4 v[4]; float amax = 0.f;
#pragma unroll
    for (int q = 0; q < 4; ++q) { v[q] = *(const f32x4*)(src + q * 4); if (!isv) v[q] = v[q] * *(const f32x4*)(a->in[I_NFFN] + lane * 16 + q * 4);
        amax = fmaxf(amax, fmaxf(fmaxf(fabsf(v[q][0]), fabsf(v[q][1])), fmaxf(fabsf(v[q][2]), fabsf(v[q][3])))); }
#pragma unroll
    for (int off = 1; off < 64; off <<= 1) amax = fmaxf(amax, __shfl_xor(amax, off));
    const float sc = amax > 0.f ? 224.0f / amax : 1.0f;
    u32x4 w;
#pragma unroll
    for (int q = 0; q < 4; ++q) { int p = __builtin_amdgcn_cvt_pk_fp8_f32(v[q][0] * sc, v[q][1] * sc, 0, false); p = __builtin_amdgcn_cvt_pk_fp8_f32(v[q][2] * sc, v[q][3] * sc, p, true); w[q] = (unsigned)p; }
    unsigned char* dst = ws + (isv ? W_PV : W_PU);
    *(u32x4*)(dst + (size_t)e * 1024 + lane * 16) = w;
    if (lane == 0) ((float*)(dst + 16777216))[e] = amax > 0.f ? amax * (1.0f / 224.0f) : 1.0f;
}

constexpr int N_LATE_JOBS = 14848;
__device__ __forceinline__ void late_transpose_job(KA a, int job) {
    const int lane = tidx() & 63; unsigned char* ws = a->ws;
    const float* src; const float* gain = nullptr; bf16_t* dst; int ld, K, r;
    if (job < 4096) { r = job; src = a->in[I_WOSSM]; gain = a->in[I_SSMN]; dst = (bf16_t*)(ws + W_WOS); ld = 1024; K = 2048; }
    else if (job < 6144) { r = job - 4096; src = a->in[I_WORW]; dst = (bf16_t*)(ws + W_WOR); ld = 1024; K = 1024; }
    else if (job < 8192) { r = job - 6144; src = a->in[I_WOUT]; dst = (bf16_t*)(ws + W_WO); ld = 1024; K = 1024; }
    else if (job < 12288) { r = job - 8192; src = a->in[I_WQ]; gain = a->in[I_NFFN]; dst = (bf16_t*)(ws + W_WQ); ld = 2048; K = 1024; }
    else if (job < 14336) { r = job - 12288; src = a->in[I_WPG]; gain = a->in[I_NPLE]; dst = (bf16_t*)(ws + W_WPG); ld = 1024; K = 1024; }
    else { r = job - 14336; src = a->in[I_WPP]; dst = (bf16_t*)(ws + W_WPP); ld = 1024; K = 256; }
    const int nk = K >> 3, nb = r / nk, kb = r - nb * nk, n = nb * 64 + lane, k0 = kb * 8;
    float v[8];
#pragma unroll
    for (int j = 0; j < 8; ++j) v[j] = src[(size_t)(k0 + j) * ld + n];
    if (gain) {
#pragma unroll
        for (int j = 0; j < 8; ++j) v[j] *= gain[k0 + j]; }
    u32x4 w; w.x = cvt_pk_bf16(v[0], v[1]); w.y = cvt_pk_bf16(v[2], v[3]); w.z = cvt_pk_bf16(v[4], v[5]); w.w = cvt_pk_bf16(v[6], v[7]);
    *(u32x4*)(dst + (size_t)n * K + k0) = w;
}

__device__ __forceinline__ void grid_barrier(unsigned* cnt, unsigned round) {
    __syncthreads();
    if (tidx() < 64) {
        if (tidx() == 0) {
            const unsigned nW = gridDim.x, ng = nW < 8u ? nW : 8u, g = blockIdx.x % ng, gsz = (nW - g + ng - 1) / ng;
            const unsigned old = __hip_atomic_fetch_add(cnt + 64 * (1 + g), 1u, __ATOMIC_ACQ_REL, __HIP_MEMORY_SCOPE_AGENT);
            if (old + 1 == round * gsz) __hip_atomic_fetch_add(cnt, 1u, __ATOMIC_RELEASE, __HIP_MEMORY_SCOPE_AGENT);
            while (__hip_atomic_load(cnt, __ATOMIC_RELAXED, __HIP_MEMORY_SCOPE_AGENT) < round * ng) __builtin_amdgcn_s_sleep(2);
        }
        __builtin_amdgcn_fence(__ATOMIC_ACQUIRE, "agent");
    }
    __syncthreads();
}

__device__ __forceinline__ int win_colmap(int n) { if (n < 6144) return n; if (n < 11520) return n + 32; if (n < 11552) return 6144 + (n - 11520); return -1; }

__device__ __forceinline__ void transpose_tile(LAS float* tl, const float* __restrict__ src, int ld, const float* __restrict__ gain, bf16_t* __restrict__ dst, int K, int k0, int n0, bool remap) {
    const int tid = tidx(), nn = tid & 63, kk0 = tid >> 6;
    const int sc = remap ? win_colmap(n0 + nn) : n0 + nn;
#pragma unroll
    for (int i = 0; i < 8; ++i) { const int k = kk0 + i * 8; float v = 0.f; if (sc >= 0) { v = src[(size_t)(k0 + k) * ld + sc]; if (gain) v *= gain[k0 + k]; } tl[k * 65 + nn] = v; }
    bar();
    const int n = tid >> 3, ks = (tid & 7) * 8;
    u32x4 w; w.x = cvt_pk_bf16(tl[(ks + 0) * 65 + n], tl[(ks + 1) * 65 + n]); w.y = cvt_pk_bf16(tl[(ks + 2) * 65 + n], tl[(ks + 3) * 65 + n]);
    w.z = cvt_pk_bf16(tl[(ks + 4) * 65 + n], tl[(ks + 5) * 65 + n]); w.w = cvt_pk_bf16(tl[(ks + 6) * 65 + n], tl[(ks + 7) * 65 + n]);
    *(u32x4*)(dst + (size_t)(n0 + n) * K + k0 + ks) = w;
    bar();
}

__device__ __forceinline__ void phase_prep(KA a, LAS unsigned char* lds) {
    const int tid = tidx(), nW = gridDim.x, wg = blockIdx.x;
    LAS float* tl = (LAS float*)lds;
    unsigned char* ws = a->ws;
    {
        const float* src = a->in[I_WIN]; const float* gain = a->in[I_NMIX]; bf16_t* dst = (bf16_t*)(ws + W_WIN);
        const int nn = tid & 63, kk0 = tid >> 6;
        float v[8];
#define WIN_LOAD(t_) do { const int k0_ = ((t_) & 15) * 64, n0_ = ((t_) >> 4) * 64; const int sc_ = win_colmap(n0_ + nn); \
            _Pragma("unroll") for (int i = 0; i < 8; ++i) { const int k = kk0 + i * 8; v[i] = 0.f; if (sc_ >= 0) v[i] = src[(size_t)(k0_ + k) * 11552 + sc_] * gain[k0_ + k]; } } while (0)
        if (wg < 2944) WIN_LOAD(wg);
        for (int t = wg; t < 2944; t += nW) {
            const int k0 = (t & 15) * 64, n0 = (t >> 4) * 64;
#pragma unroll
            for (int i = 0; i < 8; ++i) tl[(kk0 + i * 8) * 65 + nn] = v[i];
            if (t + nW < 2944) WIN_LOAD(t + nW);
            bar_lds();
            const int n = tid >> 3, ks = (tid & 7) * 8;
            u32x4 w; w.x = cvt_pk_bf16(tl[(ks + 0) * 65 + n], tl[(ks + 1) * 65 + n]); w.y = cvt_pk_bf16(tl[(ks + 2) * 65 + n], tl[(ks + 3) * 65 + n]);
            w.z = cvt_pk_bf16(tl[(ks + 4) * 65 + n], tl[(ks + 5) * 65 + n]); w.w = cvt_pk_bf16(tl[(ks + 6) * 65 + n], tl[(ks + 7) * 65 + n]);
            *(u32x4*)(dst + (size_t)(n0 + n) * 1024 + k0 + ks) = w;
            bar_lds();
        }
    }
    const size_t gt = (size_t)wg * 512 + tid, gs = (size_t)nW * 512;
    {
        bf16_t* kd = (bf16_t*)(ws + W_K12);
        for (size_t i = gt; i < (size_t)2 * 131072; i += gs) {
            const int half = (int)(i >= 131072), j = (int)(i - (size_t)half * 131072), h = j >> 14, nd = j & 16383;
            kd[((size_t)(h * 2 + half) << 14) + nd] = f2bf(half ? a->in[I_K2][j] : a->in[I_K1][j]);
        }
        u32x2* pb = (u32x2*)(ws + W_PB);
        for (size_t i = gt; i < (size_t)TP * 64; i += gs) {
            const size_t row = i >> 6; f32x4 v = {0.f, 0.f, 0.f, 0.f};
            if (row < (size_t)NPR) v = ((const f32x4*)a->in[I_PP])[i]; else if (row < (size_t)T) v = ((const f32x4*)a->in[I_PS])[i - (size_t)NPR * 64];
            u32x2 o; o.x = cvt_pk_bf16(v[0], v[1]); o.y = cvt_pk_bf16(v[2], v[3]); pb[i] = o;
        }
        float* ss = (float*)(ws + W_SS);
        for (size_t i = gt; i < (size_t)3 * TP; i += gs) ss[TP + i] = 0.f;
        float* ssq = (float*)(ws + W_SSQ);
        for (size_t i = gt; i < (size_t)TP * 8; i += gs) ssq[i] = 0.f;
    }
    {
        const int lane = tid & 63, wv = wg * 8 + (tid >> 6), nwv = nW * 8;
        u32x2* xb = (u32x2*)(ws + W_XB); float* ss0 = (float*)(ws + W_SS);
        for (int row = wv; row < TP; row += nwv) {
            const f32x4* src = row < NPR ? (const f32x4*)(a->in[I_XP] + (size_t)row * 1024) : (const f32x4*)(a->in[I_XS] + (size_t)(row - NPR) * 1024);
            float s = 0.f; f32x4 v[4];
#pragma unroll
            for (int i = 0; i < 4; ++i) {
                v[i] = (f32x4){0.f, 0.f, 0.f, 0.f}; if (row < T) v[i] = src[i * 64 + lane];
                s += v[i][0] * v[i][0] + v[i][1] * v[i][1] + v[i][2] * v[i][2] + v[i][3] * v[i][3];
            }
            s = red64(s);
            const float rs = rsqrtf(s * (1.0f / 1024.0f) + EPS);
#pragma unroll
            for (int i = 0; i < 4; ++i) { u32x2 o; o.x = cvt_pk_bf16(v[i][0] * rs, v[i][1] * rs); o.y = cvt_pk_bf16(v[i][2] * rs, v[i][3] * rs); xb[(size_t)row * 256 + i * 64 + lane] = o; }
            if (lane == 0) ss0[row] = s;
        }
    }
}

typedef const f32x4 (&AccRef)[2][2][4][2];
struct EpiU {
    static constexpr bool PERM = true, AFTER_DRAIN = false;
    bf16_t *Z, *XBC, *RW, *G; float* DT; const float* ss0;
    __device__ __forceinline__ void operator()(AccRef acc, const pg8::Unit& u, int wr, int wc, int fr, int fq) const {
        const int row0 = u.pm * 256 + wr * 64 + fr, pn = u.pn;
        bf16_t* base; int ld, colt, kind;
        if (pn < 8) { base = Z; ld = 2048; colt = pn * 256; kind = 0; }
        else if (pn < 24) { base = XBC; ld = 4096; colt = (pn - 8) * 256; kind = 1; }
        else if (pn < 37) { base = RW; ld = 3328; colt = (pn - 24) * 256; kind = 1; }
        else if (pn < 45) { base = G; ld = 2048; colt = (pn - 37) * 256; kind = 2; }
        else { base = nullptr; ld = 0; colt = 0; kind = 3; }
        const int col0 = colt + wc * 32 + 8 * fq;
#pragma unroll
        for (int ai = 0; ai < 2; ++ai)
#pragma unroll
            for (int m = 0; m < 4; ++m) {
                const int row = row0 + ai * 128 + m * 16;
                const float rs = 1.0f;
                if (kind == 3) {
                    if (wc == 0) { const f32x4 v0 = acc[ai][0][m][0] * rs, v1 = acc[ai][0][m][1] * rs; *(f32x4*)(DT + (size_t)row * 32 + 8 * fq) = v0; *(f32x4*)(DT + (size_t)row * 32 + 8 * fq + 4) = v1; }
                } else if (kind != 0 || row < T) {
#pragma unroll
                    for (int bj = 0; bj < 2; ++bj) {
                        f32x4 v0 = acc[ai][bj][m][0] * rs, v1 = acc[ai][bj][m][1] * rs;
                        if (kind == 2) {
#pragma unroll
                            for (int j = 0; j < 4; ++j) { v0[j] = sigm(v0[j]); v1[j] = sigm(v1[j]); } }
                        u32x4 w; w.x = cvt_pk_bf16(v0[0], v0[1]); w.y = cvt_pk_bf16(v0[2], v0[3]); w.z = cvt_pk_bf16(v1[0], v1[1]); w.w = cvt_pk_bf16(v1[2], v1[3]);
                        *(u32x4*)(base + (size_t)row * ld + col0 + bj * 128) = w;
                    }
                }
            }
    }
};
struct EpiQ {
    static constexpr bool PERM = true, AFTER_DRAIN = false;
    bf16_t* O; int ld; const float* ss;
    static constexpr bool HAS_SS = false;
    __device__ __forceinline__ float* ssp() const { return nullptr; }
    __device__ __forceinline__ float elem(int row, int c, float v) const { O[(size_t)row * ld + c] = f2bf(v * rsqrtf(ss[row] * (1.0f / 1024.0f) + EPS)); return 0.f; }
    __device__ __forceinline__ void operator()(AccRef acc, const pg8::Unit& u, int wr, int wc, int fr, int fq) const {
        const int row0 = u.pm * 256 + wr * 64 + fr, col0 = u.pn * 256 + wc * 32 + 8 * fq;
        float rsv[8];
#pragma unroll
        for (int i = 0; i < 8; ++i) rsv[i] = ss[row0 + (i >> 2) * 128 + (i & 3) * 16];
#pragma unroll
        for (int i = 0; i < 8; ++i) rsv[i] = rsqrtf(rsv[i] * (1.0f / 1024.0f) + EPS);
#pragma unroll
        for (int ai = 0; ai < 2; ++ai)
#pragma unroll
            for (int m = 0; m < 4; ++m) {
                const int row = row0 + ai * 128 + m * 16; const float rs = rsv[ai * 4 + m];
#pragma unroll
                for (int bj = 0; bj < 2; ++bj) {
                    const f32x4 v0 = acc[ai][bj][m][0] * rs, v1 = acc[ai][bj][m][1] * rs;
                    u32x4 w; w.x = cvt_pk_bf16(v0[0], v0[1]); w.y = cvt_pk_bf16(v0[2], v0[3]); w.z = cvt_pk_bf16(v1[0], v1[1]); w.w = cvt_pk_bf16(v1[2], v1[3]);
                    *(u32x4*)(O + (size_t)row * ld + col0 + bj * 128) = w;
                }
            }
    }
};
template <int MODE> struct EpiMix {
    static constexpr bool PERM = false, AFTER_DRAIN = false;
    float* P; bf16_t* V; const bf16_t* G; int goff;
    static constexpr bool HAS_SS = false;
    __device__ __forceinline__ float* ssp() const { return nullptr; }
    __device__ __forceinline__ float elem(int row, int c, float v) const {
        if (MODE != 2) v *= bf2f(G[(size_t)row * 2048 + goff + c]);
        if (MODE == 1) V[(size_t)row * 1024 + c] = f2bf(v + P[(size_t)row * 1024 + c]); else P[(size_t)row * 1024 + c] = v;
        return 0.f; }
    __device__ __forceinline__ void operator()(AccRef acc, const pg8::Unit& u, int wr, int wc, int fr, int fq) const {
        const int row0 = u.pm * 256 + wr * 64 + fr, col0 = u.pn * 256 + wc * 32 + 4 * fq;
#pragma unroll
        for (int ai = 0; ai < 2; ++ai)
#pragma unroll
            for (int mp = 0; mp < 2; ++mp) {
                u32x2 gw[2][4]; f32x4 pv[2][4];
#pragma unroll
                for (int mm = 0; mm < 2; ++mm) { const int row = row0 + ai * 128 + (mp * 2 + mm) * 16;
#pragma unroll
                    for (int f = 0; f < 4; ++f) { const int c = col0 + (f >> 1) * 128 + (f & 1) * 16;
                        if (MODE != 2) gw[mm][f] = *(const u32x2*)(G + (size_t)row * 2048 + goff + c);
                        if (MODE == 1) pv[mm][f] = *(const f32x4*)(P + (size_t)row * 1024 + c); } }
#pragma unroll
                for (int mm = 0; mm < 2; ++mm) { const int m = mp * 2 + mm, row = row0 + ai * 128 + m * 16;
#pragma unroll
                    for (int f = 0; f < 4; ++f) { const int bj = f >> 1, n = f & 1, c = col0 + bj * 128 + n * 16; f32x4 v = acc[ai][bj][m][n];
                        if (MODE != 2) { v[0] *= bflo(gw[mm][f].x); v[1] *= bfhi(gw[mm][f].x); v[2] *= bflo(gw[mm][f].y); v[3] *= bfhi(gw[mm][f].y); }
                        if (MODE == 1) { v = v + pv[mm][f]; u32x2 o; o.x = cvt_pk_bf16(v[0], v[1]); o.y = cvt_pk_bf16(v[2], v[3]); *(u32x2*)(V + (size_t)row * 1024 + c) = o; }
                        else *(f32x4*)(P + (size_t)row * 1024 + c) = v; } }
                asm volatile("" ::: "memory");
            }
    }
};
template <int MODE> struct EpiRes {
    static constexpr bool PERM = false, AFTER_DRAIN = false;
    const float* xp; const float* xs; float* X; bf16_t* XB; float* ss; const float* ssin; const float* P;
    static constexpr bool HAS_SS = true;
    __device__ __forceinline__ float* ssp() const { return ss; }
    __device__ __forceinline__ float elem(int row, int c, float v) const {
        if (MODE == 0) v += xs[(size_t)(row - NPR) * 1024 + c];
        else v = xp[(size_t)row * 1024 + c] + sigm(v * rsqrtf(ssin[row] * (1.0f / 1024.0f) + EPS)) * P[(size_t)row * 1024 + c];
        X[(size_t)row * 1024 + c] = v; if (MODE == 0) XB[(size_t)row * 1024 + c] = f2bf(v);
        return v; }
    __device__ __forceinline__ void operator()(AccRef acc, const pg8::Unit& u, int wr, int wc, int fr, int fq) const {
        const int row0 = u.pm * 256 + wr * 64 + fr, col0 = u.pn * 256 + wc * 32 + 4 * fq;
#pragma unroll
        for (int ai = 0; ai < 2; ++ai)
#pragma unroll
            for (int mp = 0; mp < 2; ++mp) {
                f32x4 xin[2][4], pv[2][4]; float rsr[2];
#pragma unroll
                for (int mm = 0; mm < 2; ++mm) { const int row = row0 + ai * 128 + (mp * 2 + mm) * 16, rowc = row < T ? row : 0;
                    const float* src = MODE == 0 ? (rowc < NPR ? xp + (size_t)rowc * 1024 : xs + (size_t)(rowc - NPR) * 1024) : xp + (size_t)rowc * 1024;
                    rsr[mm] = MODE == 1 ? ssin[rowc] : 0.f;
#pragma unroll
                    for (int f = 0; f < 4; ++f) { const int c = col0 + (f >> 1) * 128 + (f & 1) * 16; xin[mm][f] = *(const f32x4*)(src + c); if (MODE == 1) pv[mm][f] = *(const f32x4*)(P + (size_t)rowc * 1024 + c); } }
#pragma unroll
                for (int mm = 0; mm < 2; ++mm) { const int m = mp * 2 + mm, row = row0 + ai * 128 + m * 16;
                    const float rs = MODE == 1 ? rsqrtf(rsr[mm] * (1.0f / 1024.0f) + EPS) : 0.f; float sq = 0.f;
#pragma unroll
                    for (int f = 0; f < 4; ++f) { const int bj = f >> 1, n = f & 1, c = col0 + bj * 128 + n * 16; f32x4 v = acc[ai][bj][m][n];
                        if (MODE == 1) {
#pragma unroll
                            for (int j = 0; j < 4; ++j) v[j] = sigm(v[j] * rs) * pv[mm][f][j]; }
                        v = v + xin[mm][f];
                        if (row < T) { *(f32x4*)(X + (size_t)row * 1024 + c) = v;
                            if (MODE == 0) { u32x2 o; o.x = cvt_pk_bf16(v[0], v[1]); o.y = cvt_pk_bf16(v[2], v[3]); *(u32x2*)(XB + (size_t)row * 1024 + c) = o; } }
                        sq += v[0] * v[0] + v[1] * v[1] + v[2] * v[2] + v[3] * v[3]; }
                    sq += __shfl_xor(sq, 16); sq += __shfl_xor(sq, 32);
                    if (fq == 0 && row < T) atomicAdd(ss + row, sq); }
                asm volatile("" ::: "memory");
            }
    }
};
template <class Epi> __device__ __forceinline__ void sample_gemm(const bf16_t* A, int lda, const bf16_t* Bt, int ldb, int N, int K, const Epi& E) {
    const int tid = tidx(), lane = tid & 63, wid = tid >> 6, quad = lane >> 4, l16 = lane & 15;
    for (int sl = blockIdx.x; sl < N / 16; sl += gridDim.x) {
        const bf16_t* ap = A + (size_t)(NPR + wid * 16 + l16) * lda + quad * 8; const bf16_t* bp = Bt + (size_t)(sl * 16 + l16) * ldb + quad * 8;
        f32x4 acc = {0.f, 0.f, 0.f, 0.f};
#pragma unroll 8
        for (int kk = 0; kk < K / 32; ++kk) acc = mfma16(*(const bf16x8*)(ap + kk * 32), *(const bf16x8*)(bp + kk * 32), acc);
#pragma unroll
        for (int j = 0; j < 4; ++j) { const int row = NPR + wid * 16 + quad * 4 + j; const float r = E.elem(row, sl * 16 + l16, acc[j]);
            if (Epi::HAS_SS) { const float sq = red16(r * r); if (l16 == 0) atomicAdd(E.ssp() + row, sq); } }
    }
}
template <class Epi, bool split_samples = true> __device__ __forceinline__ void run_gemm(LAS unsigned char* lds, const bf16_t* A, int lda, const bf16_t* Bt, int ldb, int N, int K, const Epi& E) {
    pg8::Gemm g; g.A = A; g.Bt = Bt; g.M = split_samples ? NPR : TP; g.N = N; g.K = K; g.lda = lda; g.ldb = ldb;
    pg8::StaticOrder S; S.init(g.M, N, gridDim.x, blockIdx.x);
    pg8::gemm_phase<Epi, pg8::StaticOrder>(lds, g, S, E);
    if constexpr (split_samples) sample_gemm(A, lda, Bt, ldb, N, K, E);
}

__device__ __forceinline__ void rwkv_prompt_item(KA a, LAS unsigned char* lds, int b, int h) {
    const int item_ = b * 16 + h;
    const int tid = tidx(), lane = tid & 63, wid = tid >> 6, quad = lane >> 4, l16 = lane & 15;
    LAS bf16_t* WdT = (LAS bf16_t*)(lds);
    LAS bf16_t* WaT = (LAS bf16_t*)(lds + 9216);
    LAS bf16_t* WgT = (LAS bf16_t*)(lds + 18432);
    LAS bf16_t* AL = (LAS bf16_t*)(lds + 35840);
    LAS float* RAW = (LAS float*)(lds + 52736);
    LAS float* sR = (LAS float*)(lds + 78080);
    LAS float* sW = sR + 2048; LAS float* sK = sW + 2048; LAS float* sV = sK + 2048; LAS float* sA = sV + 2048; LAS float* sB = sA + 2048; LAS float* sG = sB + 2048; LAS float* sY = sG + 2048;
    LAS float* sBon = sY + 2048;
    bf16_t* RW = (bf16_t*)(a->ws + W_RW);
    const float* mu = a->in[I_MU];
#pragma unroll 8
    for (int i = tid; i < 4096; i += 512) { const int k = i >> 6, n = i & 63; WdT[n * 72 + k] = f2bf(a->in[I_W2][k * 1024 + h * 64 + n]); WaT[n * 72 + k] = f2bf(a->in[I_A2][k * 1024 + h * 64 + n]); }
#pragma unroll 16
    for (int i = tid; i < 8192; i += 512) { const int k = i >> 6, n = i & 63; WgT[n * 136 + k] = f2bf(a->in[I_G2][k * 1024 + h * 64 + n]); }
    if (tid < 192) RAW[tid] = 0.f;
    const int et = tid >> 4, j0 = (tid & 15) * 4;
    LAS float* CT = sBon + 32;
    if (tid < 64) { const int c = h * 64 + tid; CT[tid] = mu[c]; CT[64 + tid] = mu[1024 + c]; CT[128 + tid] = mu[2048 + c]; CT[192 + tid] = a->in[I_W0][c]; CT[256 + tid] = a->in[I_A0][c];
        CT[320 + tid] = a->in[I_KK][c]; CT[384 + tid] = a->in[I_KA][c]; CT[448 + tid] = a->in[I_RK][c]; CT[512 + tid] = a->in[I_LNG][c]; CT[576 + tid] = a->in[I_LNB][c]; }
    else if (tid >= 256) CT[640 + tid - 256] = mu[3072 + tid - 256];
    const int li0 = (tid & 15) * 16;
    const int srow = (wid & 3) * 16 + (lane >> 3) * 2, c0 = (lane & 7) * 8;
    f32x2 S[4], S1[4];
#pragma unroll
    for (int i = 0; i < 4; ++i) { S[i] = (f32x2){0.f, 0.f}; S1[i] = (f32x2){0.f, 0.f}; }
    bar();
    u32x2 pr[3]; u32x4 cA, cB, pA, pB;
#define RWKV_PREFETCH(chn) do { const size_t nb_ = (size_t)b * 2048 + (chn) * 32; \
        _Pragma("unroll") for (int ii = 0; ii < 3; ++ii) { const int i = tid + ii * 512, t = i / 48, rem = i - t * 48, part = rem >> 4, jj = (rem & 15) * 4; pr[ii] = *(const u32x2*)(RW + (nb_ + t) * 3328 + part * 1024 + h * 64 + jj); } \
        const bf16_t* cp = RW + (nb_ + et) * 3328 + 3072 + li0; cA = *(const u32x4*)cp; cB = *(const u32x4*)(cp + 8); \
        pA = (u32x4){0u, 0u, 0u, 0u}; pB = pA; if ((chn) > 0 || et > 0) { pA = *(const u32x4*)(cp - 3328); pB = *(const u32x4*)(cp - 3328 + 8); } } while (0)
    RWKV_PREFETCH(0);
#pragma unroll 1
    for (int ch = 0; ch < 64; ++ch) {
        const size_t base = (size_t)b * 2048 + ch * 32;
#pragma unroll
        for (int ii = 0; ii < 3; ++ii) {
            const int i = tid + ii * 512, t = i / 48, rem = i - t * 48, part = rem >> 4, jj = (rem & 15) * 4;
            const u32x2 w = pr[ii];
            *(LAS f32x4*)(RAW + (t + 1) * 192 + part * 64 + jj) = (f32x4){bflo(w.x), bfhi(w.x), bflo(w.y), bfhi(w.y)};
        }
        {
            float o[16];
#pragma unroll
            for (int q = 0; q < 8; ++q) {
                const unsigned cw = q < 4 ? cA[q] : cB[q - 4], pw = q < 4 ? pA[q] : pB[q - 4];
                const float m0 = CT[640 + li0 + 2 * q], m1 = CT[640 + li0 + 2 * q + 1];
                const float x0 = bflo(cw), x1 = bfhi(cw);
                o[2 * q] = x0 + (bflo(pw) - x0) * m0; o[2 * q + 1] = x1 + (bfhi(pw) - x1) * m1;
            }
            if (li0 < 64) {
#pragma unroll
                for (int q = 0; q < 16; ++q) o[q] = tanh_fast(o[q]); }
            else if (li0 >= 128) {
#pragma unroll
                for (int q = 0; q < 16; ++q) o[q] = sigm(o[q]); }
            u32x4 w0, w1;
            w0.x = cvt_pk_bf16(o[0], o[1]); w0.y = cvt_pk_bf16(o[2], o[3]); w0.z = cvt_pk_bf16(o[4], o[5]); w0.w = cvt_pk_bf16(o[6], o[7]);
            w1.x = cvt_pk_bf16(o[8], o[9]); w1.y = cvt_pk_bf16(o[10], o[11]); w1.z = cvt_pk_bf16(o[12], o[13]); w1.w = cvt_pk_bf16(o[14], o[15]);
            *(LAS u32x4*)(AL + et * 264 + li0) = w0; *(LAS u32x4*)(AL + et * 264 + li0 + 8) = w1;
        }
        bar_lds();
        {
            const int rb = wid >> 2, cb = wid & 3;
            const LAS bf16_t* ar = AL + (rb * 16 + l16) * 264 + quad * 8;
            f32x4 lw = {0.f, 0.f, 0.f, 0.f}, la = lw, lg = lw;
#pragma unroll
            for (int kk = 0; kk < 2; ++kk) {
                lw = mfma16(*(const LAS bf16x8*)(ar + kk * 32), *(const LAS bf16x8*)(WdT + (cb * 16 + l16) * 72 + kk * 32 + quad * 8), lw);
                la = mfma16(*(const LAS bf16x8*)(ar + 64 + kk * 32), *(const LAS bf16x8*)(WaT + (cb * 16 + l16) * 72 + kk * 32 + quad * 8), la);
            }
#pragma unroll
            for (int kk = 0; kk < 4; ++kk) lg = mfma16(*(const LAS bf16x8*)(ar + 128 + kk * 32), *(const LAS bf16x8*)(WgT + (cb * 16 + l16) * 136 + kk * 32 + quad * 8), lg);
#pragma unroll
            for (int j = 0; j < 4; ++j) { const int o = (rb * 16 + quad * 4 + j) * 64 + cb * 16 + l16; sW[o] = lw[j]; sA[o] = la[j]; sG[o] = lg[j]; }
        }
        bar_lds();
        {
            float kkf[4], al[4]; float ssk = 0.f, bon = 0.f;
            const f32x4 c_mur = *(const LAS f32x4*)(CT + j0), c_muk = *(const LAS f32x4*)(CT + 64 + j0), c_muv = *(const LAS f32x4*)(CT + 128 + j0), c_w0 = *(const LAS f32x4*)(CT + 192 + j0),
                        c_a0 = *(const LAS f32x4*)(CT + 256 + j0), c_kk = *(const LAS f32x4*)(CT + 320 + j0), c_ka = *(const LAS f32x4*)(CT + 384 + j0), c_rk = *(const LAS f32x4*)(CT + 448 + j0);
            const int ob = et * 64 + j0;
            const f32x4 rc4 = *(const LAS f32x4*)(RAW + (et + 1) * 192 + j0), rp4 = *(const LAS f32x4*)(RAW + et * 192 + j0), kc4 = *(const LAS f32x4*)(RAW + (et + 1) * 192 + 64 + j0), kp4 = *(const LAS f32x4*)(RAW + et * 192 + 64 + j0),
                        vc4 = *(const LAS f32x4*)(RAW + (et + 1) * 192 + 128 + j0), vp4 = *(const LAS f32x4*)(RAW + et * 192 + 128 + j0), lw4 = *(const LAS f32x4*)(sW + ob), la4 = *(const LAS f32x4*)(sA + ob);
            f32x4 r4, d4, k4, v4, a4, b4;
#pragma unroll
            for (int q = 0; q < 4; ++q) {
                const float r = rc4[q] + (rp4[q] - rc4[q]) * c_mur[q], k = kc4[q] + (kp4[q] - kc4[q]) * c_muk[q], v = vc4[q] + (vp4[q] - vc4[q]) * c_muv[q];
                const float dec = __expf(-0.60653066f * sigm(c_w0[q] + lw4[q]));
                al[q] = sigm(c_a0[q] + la4[q]);
                kkf[q] = k * c_kk[q]; ssk += kkf[q] * kkf[q];
                const float kn = k * (1.0f + (al[q] - 1.0f) * c_ka[q]); bon += r * kn * c_rk[q];
                r4[q] = r; d4[q] = dec; k4[q] = kn; v4[q] = v;
            }
            ssk = red16(ssk); bon = red16(bon);
            const float inv = rsqrtf(ssk + 1e-12f);
#pragma unroll
            for (int q = 0; q < 4; ++q) { const float kk = kkf[q] * inv; a4[q] = -kk; b4[q] = kk * al[q]; }
            *(LAS f32x4*)(sR + ob) = r4; *(LAS f32x4*)(sW + ob) = d4; *(LAS f32x4*)(sK + ob) = k4; *(LAS f32x4*)(sV + ob) = v4; *(LAS f32x4*)(sA + ob) = a4; *(LAS f32x4*)(sB + ob) = b4;
            if ((tid & 15) == 0) sBon[et] = bon;
        }
        bar_lds();
        if (ch < 63) RWKV_PREFETCH(ch + 1);
        if (wid < 4) {
            const LAS float* sp = sR + c0;
            f32x4 nr0 = *(const LAS f32x4*)(sp), nr1 = *(const LAS f32x4*)(sp + 4), nw0 = *(const LAS f32x4*)(sp + 2048), nw1 = *(const LAS f32x4*)(sp + 2048 + 4);
            f32x4 nk0 = *(const LAS f32x4*)(sp + 4096), nk1 = *(const LAS f32x4*)(sp + 4096 + 4), na0 = *(const LAS f32x4*)(sp + 8192), na1 = *(const LAS f32x4*)(sp + 8192 + 4);
            f32x4 nb0 = *(const LAS f32x4*)(sp + 10240), nb1 = *(const LAS f32x4*)(sp + 10240 + 4); f32x2 nv = *(const LAS f32x2*)(sV + srow);
#pragma unroll 2
            for (int t = 0; t < 32; ++t) {
                const f32x4 r0 = nr0, r1 = nr1, w0 = nw0, w1 = nw1, k0 = nk0, k1 = nk1, a0 = na0, a1 = na1, b0 = nb0, b1 = nb1; const f32x2 v2 = nv;
                {
                    const int tn = t < 31 ? t + 1 : 31; const LAS float* sn = sR + tn * 64 + c0;
                    nr0 = *(const LAS f32x4*)(sn); nr1 = *(const LAS f32x4*)(sn + 4); nw0 = *(const LAS f32x4*)(sn + 2048); nw1 = *(const LAS f32x4*)(sn + 2048 + 4);
                    nk0 = *(const LAS f32x4*)(sn + 4096); nk1 = *(const LAS f32x4*)(sn + 4096 + 4); na0 = *(const LAS f32x4*)(sn + 8192); na1 = *(const LAS f32x4*)(sn + 8192 + 4);
                    nb0 = *(const LAS f32x4*)(sn + 10240); nb1 = *(const LAS f32x4*)(sn + 10240 + 4); nv = *(const LAS f32x2*)(sV + tn * 64 + srow);
                }
                const f32x2 av[4] = {{a0[0], a0[1]}, {a0[2], a0[3]}, {a1[0], a1[1]}, {a1[2], a1[3]}}, bv[4] = {{b0[0], b0[1]}, {b0[2], b0[3]}, {b1[0], b1[1]}, {b1[2], b1[3]}};
                const f32x2 wv[4] = {{w0[0], w0[1]}, {w0[2], w0[3]}, {w1[0], w1[1]}, {w1[2], w1[3]}}, kv[4] = {{k0[0], k0[1]}, {k0[2], k0[3]}, {k1[0], k1[1]}, {k1[2], k1[3]}};
                const f32x2 rv[4] = {{r0[0], r0[1]}, {r0[2], r0[3]}, {r1[0], r1[1]}, {r1[2], r1[3]}};
                f32x2 p = S[0] * av[0]; p = S[1] * av[1] + p; p = S[2] * av[2] + p; p = S[3] * av[3] + p;
                f32x2 p1 = S1[0] * av[0]; p1 = S1[1] * av[1] + p1; p1 = S1[2] * av[2] + p1; p1 = S1[3] * av[3] + p1;
                const float sa = red8(p.x + p.y), sa1 = red8(p1.x + p1.y);
                const f32x2 vv = {v2.x, v2.x}, sav = {sa, sa}, vv1 = {v2.y, v2.y}, sav1 = {sa1, sa1};
#pragma unroll
                for (int i = 0; i < 4; ++i) { const f32x2 u = S[i] * wv[i] + vv * kv[i]; S[i] = sav * bv[i] + u; const f32x2 u1 = S1[i] * wv[i] + vv1 * kv[i]; S1[i] = sav1 * bv[i] + u1; }
                f32x2 y2 = S[0] * rv[0]; y2 = S[1] * rv[1] + y2; y2 = S[2] * rv[2] + y2; y2 = S[3] * rv[3] + y2;
                f32x2 y3 = S1[0] * rv[0]; y3 = S1[1] * rv[1] + y3; y3 = S1[2] * rv[2] + y3; y3 = S1[3] * rv[3] + y3;
                const float y = red8(y2.x + y2.y), y1 = red8(y3.x + y3.y);
                if ((lane & 7) == 0) *(LAS f32x2*)(sY + t * 64 + srow) = (f32x2){y, y1};
            }
        } else {
            const int slot_ = (item_ * 4 + (wid - 4)) * 64 + ch;
            peer_quant_row(a, slot_);
            if (slot_ < N_LATE_JOBS) late_transpose_job(a, slot_);
        }
        bar_lds();
        {
            const int ob = et * 64 + j0;
            const f32x4 y4 = *(const LAS f32x4*)(sY + ob), v4 = *(const LAS f32x4*)(sV + ob), g4 = *(const LAS f32x4*)(sG + ob);
            float y[4]; float s = 0.f;
#pragma unroll
            for (int q = 0; q < 4; ++q) { y[q] = y4[q]; s += y[q]; }
            const float mean = red16(s) * (1.0f / 64.0f); float vs = 0.f;
#pragma unroll
            for (int q = 0; q < 4; ++q) { y[q] -= mean; vs += y[q] * y[q]; }
            const float inv = rsqrtf(red16(vs) * (1.0f / 64.0f) + 64e-5f), bon = sBon[et];
            const f32x4 c_lg = *(const LAS f32x4*)(CT + 512 + j0), c_lb = *(const LAS f32x4*)(CT + 576 + j0);
            float o[4];
#pragma unroll
            for (int q = 0; q < 4; ++q) o[q] = ((y[q] * inv * c_lg[q] + c_lb[q]) + bon * v4[q]) * g4[q];
            u32x2 w; w.x = cvt_pk_bf16(o[0], o[1]); w.y = cvt_pk_bf16(o[2], o[3]);
            *(u32x2*)(RW + (base + et) * 3328 + h * 64 + j0) = w;
            if (tid < 192) RAW[tid] = RAW[32 * 192 + tid];
        }
        bar_lds();
    }
    {
        if (wid < 4) {
            float* ws_ = a->out + O_WKVP + ((size_t)(b * 16 + h) * 64 + srow) * 64 + c0;
            *(f32x4*)ws_ = (f32x4){S[0].x, S[0].y, S[1].x, S[1].y}; *(f32x4*)(ws_ + 4) = (f32x4){S[2].x, S[2].y, S[3].x, S[3].y};
            *(f32x4*)(ws_ + 64) = (f32x4){S1[0].x, S1[0].y, S1[1].x, S1[1].y}; *(f32x4*)(ws_ + 68) = (f32x4){S1[2].x, S1[2].y, S1[3].x, S1[3].y};
        }
        if (tid < 192) a->out[O_SHIFTP + (size_t)b * 3328 + (tid >> 6) * 1024 + h * 64 + (tid & 63)] = RAW[tid];
        if (h == 0 && tid < 256) a->out[O_SHIFTP + (size_t)b * 3328 + 3072 + tid] = bf2f(RW[((size_t)b * 2048 + 2047) * 3328 + 3072 + tid]);
    }
    bar();
}

__device__ __forceinline__ void rwkv_sample_wave(KA a, LAS float* wl, int b, int h) {
    const int lane = tidx() & 63, c = h * 64 + lane;
    bf16_t* RW = (bf16_t*)(a->ws + W_RW);
    const float* mu = a->in[I_MU]; const float* prevs = a->in[I_SSHIFT] + (size_t)b * 3328;
    const size_t row = (size_t)NPR + b;
    {
        const int i0 = lane * 4;
        const u32x2 cw = *(const u32x2*)(RW + row * 3328 + 3072 + i0); const f32x4 pv = *(const f32x4*)(prevs + 3072 + i0), mv = *(const f32x4*)(mu + 3072 + i0);
        f32x4 cur = {bflo(cw.x), bfhi(cw.x), bflo(cw.y), bfhi(cw.y)}, xs = cur + (pv - cur) * mv, o;
#pragma unroll
        for (int q = 0; q < 4; ++q) o[q] = lane < 16 ? tanh_fast(xs[q]) : (lane < 32 ? xs[q] : sigm(xs[q]));
        *(LAS f32x4*)(wl + i0) = o;
        if (h == 0) *(f32x4*)(a->out + O_SHIFTS + (size_t)b * 3328 + 3072 + i0) = cur;
    }
    float rr, kk_, vv;
    {
        const float rc = bf2f(RW[row * 3328 + c]), kc = bf2f(RW[row * 3328 + 1024 + c]), vc = bf2f(RW[row * 3328 + 2048 + c]);
        rr = rc + (prevs[c] - rc) * mu[c]; kk_ = kc + (prevs[1024 + c] - kc) * mu[1024 + c]; vv = vc + (prevs[2048 + c] - vc) * mu[2048 + c];
        float* so = a->out + O_SHIFTS + (size_t)b * 3328; so[c] = rc; so[1024 + c] = kc; so[2048 + c] = vc;
    }
    float lw = 0.f, la = 0.f, lg = 0.f;
    {
        const float* pw = a->in[I_W2] + c; const float* pa = a->in[I_A2] + c; const float* pg = a->in[I_G2] + c;
#pragma unroll 8
        for (int k = 0; k < 64; ++k) { lw += wl[k] * pw[0]; la += wl[64 + k] * pa[0]; pw += 1024; pa += 1024; }
        asm volatile("" ::: "memory");
#pragma unroll 16
        for (int k = 0; k < 128; ++k) { lg += wl[128 + k] * pg[0]; pg += 1024; }
        asm volatile("" ::: "memory");
    }
    const float dec = __expf(-0.60653066f * sigm(a->in[I_W0][c] + lw)), al = sigm(a->in[I_A0][c] + la);
    const float kkf = kk_ * a->in[I_KK][c], ssk = red64(kkf * kkf), kn = kk_ * (1.0f + (al - 1.0f) * a->in[I_KA][c]), bon = red64(rr * kn * a->in[I_RK][c]);
    const float kkn = kkf * rsqrtf(ssk + 1e-12f);
    LAS float* vw = wl + 256;
    vw[lane] = rr; vw[64 + lane] = dec; vw[128 + lane] = kn; vw[192 + lane] = -kkn; vw[256 + lane] = kkn * al;
    const size_t so = ((size_t)(b * 16 + h) * 64 + lane) * 64;
    float sa = 0.f;
#pragma unroll 8
    for (int q = 0; q < 16; ++q) { const f32x4 Sv = *(const f32x4*)(a->in[I_SWKV] + so + q * 4), av = *(const LAS f32x4*)(vw + 192 + q * 4); sa += Sv[0] * av[0] + Sv[1] * av[1] + Sv[2] * av[2] + Sv[3] * av[3]; }
    float y = 0.f;
#pragma unroll 8
    for (int q = 0; q < 16; ++q) {
        const f32x4 wv = *(const LAS f32x4*)(vw + 64 + q * 4), kv = *(const LAS f32x4*)(vw + 128 + q * 4), bv = *(const LAS f32x4*)(vw + 256 + q * 4), rv = *(const LAS f32x4*)(vw + q * 4);
        f32x4 Sv = *(const f32x4*)(a->in[I_SWKV] + so + q * 4);
        Sv = Sv * wv + kv * vv + bv * sa;
        y += Sv[0] * rv[0] + Sv[1] * rv[1] + Sv[2] * rv[2] + Sv[3] * rv[3];
        *(f32x4*)(a->out + O_WKVS + so + q * 4) = Sv;
    }
    const float mean = red64(y) * (1.0f / 64.0f), d = y - mean, var = red64(d * d) * (1.0f / 64.0f);
    const float o = ((d * rsqrtf(var + 64e-5f) * a->in[I_LNG][c] + a->in[I_LNB][c]) + bon * vv) * lg;
    RW[row * 3328 + c] = f2bf(o);
}

__device__ __forceinline__ float softplusf_(float x) { return x > 20.f ? x : log1pf(__expf(x)); }
__device__ __forceinline__ void ssd_prompt_item(KA a, LAS unsigned char* lds, int b, int hd) {
    const int tid = tidx(), lane = tid & 63, wid = tid >> 6, quad = lane >> 4, l16 = lane & 15, g = hd >> 2;
    LAS bf16_t* Cb = (LAS bf16_t*)(lds);
    LAS bf16_t* Bb = (LAS bf16_t*)(lds + 17408);
    LAS bf16_t* BT = (LAS bf16_t*)(lds + 34816);
    LAS bf16_t* XT = (LAS bf16_t*)(lds + 53248);
    LAS bf16_t* XTd = (LAS bf16_t*)(lds + 62464);
    LAS bf16_t* Mb = (LAS bf16_t*)(lds + 71680);
    LAS bf16_t* Hb = (LAS bf16_t*)(lds + 80896);
    LAS float* sdt = (LAS float*)(lds + 98304); LAS float* sac = sdt + 64; LAS float* seac = sac + 64; LAS float* sdd = seac + 64; LAS float* sdec = sdd + 64;
    const bf16_t* XBC = (const bf16_t*)(a->ws + W_XBC); const float* DT = (const float*)(a->ws + W_DT); bf16_t* Z = (bf16_t*)a->out; float* ssq = (float*)(a->ws + W_SSQ);
    const int cg_ = tid % 40, strip = tid / 40;
    int ccol, kind, loc;
    if (cg_ < 8) { kind = 0; loc = cg_ * 8; ccol = hd * 64 + loc; } else if (cg_ < 24) { kind = 1; loc = (cg_ - 8) * 8; ccol = 2048 + g * 128 + loc; } else { kind = 2; loc = (cg_ - 24) * 8; ccol = 3072 + g * 128 + loc; }
    LAS float* CW = sdec + 64;
    if (tid < 40) {
#pragma unroll
        for (int q = 0; q < 8; ++q) { CW[tid * 40 + 32 + q] = a->in[I_CONVB][ccol + q];
#pragma unroll
            for (int k = 0; k < 4; ++k) CW[tid * 40 + k * 8 + q] = a->in[I_CONVW][k * 4096 + ccol + q]; }
    }
    u32x4 rows[11]; float dtn = 0.f;
#define SSD_PREFETCH(chn) do { if (tid < 320) { _Pragma("unroll") for (int k = 0; k < 11; ++k) { const int tg = (chn) * 64 + strip * 8 - 3 + k; rows[k] = (u32x4){0u, 0u, 0u, 0u}; \
            if (tg >= 0) rows[k] = *(const u32x4*)(XBC + ((size_t)b * 2048 + tg) * 4096 + ccol); } } else if (wid == 7) dtn = DT[((size_t)b * 2048 + (chn) * 64 + lane) * 32 + hd]; } while (0)
    SSD_PREFETCH(0);
    bar();
    const float Ah = -__expf(a->in[I_ALOG][hd]), dtb = a->in[I_DTB][hd], dsk = a->in[I_DSKIP][hd];
    const int pt = wid >> 1, ntb = (wid & 1) * 4;
    f32x4 hacc[4];
#pragma unroll
    for (int i = 0; i < 4; ++i) hacc[i] = (f32x4){0.f, 0.f, 0.f, 0.f};
#pragma unroll 1
    for (int ch = 0; ch < 32; ++ch) {
        const size_t row0 = (size_t)b * 2048 + ch * 64;
        bf16_t zq[2][4];
#pragma unroll
        for (int tt = 0; tt < 2; ++tt) { const int tile = wid * 2 + tt, lt = tile >> 2, pc = tile & 3;
#pragma unroll
            for (int j = 0; j < 4; ++j) zq[tt][j] = Z[(row0 + lt * 16 + quad * 4 + j) * 2048 + hd * 64 + pc * 16 + l16]; }
        if (tid < 320) {
#pragma unroll
            for (int hq = 0; hq < 2; ++hq) {
                f32x2 cwp[4][2], cbp[2], xr[11][2];
                { const f32x4 t0 = *(const LAS f32x4*)(CW + cg_ * 40 + hq * 4), t1 = *(const LAS f32x4*)(CW + cg_ * 40 + 8 + hq * 4), t2 = *(const LAS f32x4*)(CW + cg_ * 40 + 16 + hq * 4),
                              t3 = *(const LAS f32x4*)(CW + cg_ * 40 + 24 + hq * 4), tb = *(const LAS f32x4*)(CW + cg_ * 40 + 32 + hq * 4);
                  cwp[0][0] = (f32x2){t0[0], t0[1]}; cwp[0][1] = (f32x2){t0[2], t0[3]}; cwp[1][0] = (f32x2){t1[0], t1[1]}; cwp[1][1] = (f32x2){t1[2], t1[3]};
                  cwp[2][0] = (f32x2){t2[0], t2[1]}; cwp[2][1] = (f32x2){t2[2], t2[3]}; cwp[3][0] = (f32x2){t3[0], t3[1]}; cwp[3][1] = (f32x2){t3[2], t3[3]};
                  cbp[0] = (f32x2){tb[0], tb[1]}; cbp[1] = (f32x2){tb[2], tb[3]}; }
#pragma unroll
                for (int k = 0; k < 11; ++k) { const unsigned wa_ = rows[k][2 * hq], wb_ = rows[k][2 * hq + 1]; xr[k][0] = (f32x2){bflo(wa_), bfhi(wa_)}; xr[k][1] = (f32x2){bflo(wb_), bfhi(wb_)}; }
                const int lc = loc + hq * 4;
                unsigned colpk[4][4];
#pragma unroll
                for (int rp = 0; rp < 4; ++rp) {
                    float o[2][4];
#pragma unroll
                    for (int rr = 0; rr < 2; ++rr) { const int r = rp * 2 + rr;
#pragma unroll
                        for (int pq = 0; pq < 2; ++pq) {
                            f32x2 v = cwp[0][pq] * xr[r][pq] + cbp[pq]; v = cwp[1][pq] * xr[r + 1][pq] + v; v = cwp[2][pq] * xr[r + 2][pq] + v; v = cwp[3][pq] * xr[r + 3][pq] + v;
                            o[rr][2 * pq] = v.x * sigm(v.x); o[rr][2 * pq + 1] = v.y * sigm(v.y); }
                        if (kind != 0) { const int s = strip * 8 + r;
                            u32x2 pk; pk.x = cvt_pk_bf16(o[rr][0], o[rr][1]); pk.y = cvt_pk_bf16(o[rr][2], o[rr][3]);
                            if (kind == 1) *(LAS u32x2*)(Bb + s * 136 + lc) = pk; else *(LAS u32x2*)(Cb + s * 136 + lc) = pk; } }
#pragma unroll
                    for (int q = 0; q < 4; ++q) colpk[q][rp] = cvt_pk_bf16(o[0][q], o[1][q]);
                }
                if (kind != 2) {
                    LAS bf16_t* TT = kind == 0 ? XT : BT;
#pragma unroll
                    for (int q = 0; q < 4; ++q) *(LAS u32x4*)(TT + (lc + q) * 72 + strip * 8) = (u32x4){colpk[q][0], colpk[q][1], colpk[q][2], colpk[q][3]};
                }
                asm volatile("" ::: "memory");
            }
        } else if (wid == 7) {
            const float dtv = softplusf_(dtn + dtb);
            float x = dtv * Ah;
#pragma unroll
            for (int off = 1; off < 64; off <<= 1) { const float t = __shfl_up(x, off); if (lane >= off) x += t; }
            const float last = __shfl(x, 63);
            sdt[lane] = dtv; sac[lane] = x; seac[lane] = __expf(x); sdd[lane] = __expf(last - x) * dtv; if (lane == 63) sdec[0] = __expf(x);
        }
#pragma unroll
        for (int i = 0; i < 4; ++i)
#pragma unroll
            for (int j = 0; j < 4; ++j) Hb[(pt * 16 + quad * 4 + j) * 136 + (ntb + i) * 16 + l16] = f2bf(hacc[i][j]);
        if (ch < 31) SSD_PREFETCH(ch + 1);
        bar_lds();
        {
            const int p = tid >> 3, s8 = (tid & 7) * 8;
            const u32x4 w = *(const LAS u32x4*)(XT + p * 72 + s8); u32x4 o;
#pragma unroll
            for (int q = 0; q < 4; ++q) o[q] = cvt_pk_bf16(bflo(w[q]) * sdd[s8 + 2 * q], bfhi(w[q]) * sdd[s8 + 2 * q + 1]);
            *(LAS u32x4*)(XTd + p * 72 + s8) = o;
        }
#pragma unroll
        for (int tt = 0; tt < 2; ++tt) {
            const int tile = wid * 2 + tt, lt = tile >> 2, st = tile & 3;
            f32x4 acc = {0.f, 0.f, 0.f, 0.f};
            if (st <= lt) {
#pragma unroll
                for (int kk = 0; kk < 4; ++kk) acc = mfma16(*(const LAS bf16x8*)(Cb + (lt * 16 + l16) * 136 + kk * 32 + quad * 8), *(const LAS bf16x8*)(Bb + (st * 16 + l16) * 136 + kk * 32 + quad * 8), acc);
            }
            const int s = st * 16 + l16; const float as = sac[s], ds = sdt[s];
#pragma unroll
            for (int j = 0; j < 4; ++j) { const int l = lt * 16 + quad * 4 + j; const float v = (s <= l) ? acc[j] * __expf(fminf(sac[l] - as, 0.f)) * ds : 0.f; Mb[l * 72 + s] = f2bf(v); }
        }
        bar_lds();
#pragma unroll
        for (int tt = 0; tt < 2; ++tt) {
            const int tile = wid * 2 + tt, lt = tile >> 2, pc = tile & 3;
            f32x4 acc = {0.f, 0.f, 0.f, 0.f};
#pragma unroll
            for (int kk = 0; kk < 4; ++kk) acc = mfma16(*(const LAS bf16x8*)(Cb + (lt * 16 + l16) * 136 + kk * 32 + quad * 8), *(const LAS bf16x8*)(Hb + (pc * 16 + l16) * 136 + kk * 32 + quad * 8), acc);
#pragma unroll
            for (int j = 0; j < 4; ++j) acc[j] *= seac[lt * 16 + quad * 4 + j];
#pragma unroll
            for (int kk = 0; kk < 2; ++kk) acc = mfma16(*(const LAS bf16x8*)(Mb + (lt * 16 + l16) * 72 + kk * 32 + quad * 8), *(const LAS bf16x8*)(XT + (pc * 16 + l16) * 72 + kk * 32 + quad * 8), acc);
            const int p = pc * 16 + l16;
#pragma unroll
            for (int j = 0; j < 4; ++j) {
                const int l = lt * 16 + quad * 4 + j;
                const float yv = acc[j] + dsk * bf2f(XT[p * 72 + l]);
                bf16_t* zp = Z + (row0 + l) * 2048 + hd * 64 + p;
                const float z = bf2f(zq[tt][j]), yg = yv * z * sigm(z);
                *zp = f2bf(yg);
                const float sq = red16(yg * yg);
                if (l16 == 0) atomicAdd(ssq + (row0 + l) * 8 + g, sq);
            }
        }
        {
            const float dec = sdec[0];
#pragma unroll
            for (int i = 0; i < 4; ++i) {
                hacc[i] = hacc[i] * dec;
#pragma unroll
                for (int kk = 0; kk < 2; ++kk) hacc[i] = mfma16(*(const LAS bf16x8*)(XTd + (pt * 16 + l16) * 72 + kk * 32 + quad * 8), *(const LAS bf16x8*)(BT + ((ntb + i) * 16 + l16) * 72 + kk * 32 + quad * 8), hacc[i]);
            }
        }
        bar_lds();
    }
#pragma unroll
    for (int i = 0; i < 4; ++i)
#pragma unroll
        for (int j = 0; j < 4; ++j) a->out[O_SSMP + ((size_t)(b * 32 + hd) * 64 + pt * 16 + quad * 4 + j) * 128 + (ntb + i) * 16 + l16] = hacc[i][j];
}

__device__ __forceinline__ float conv1_(KA a, const bf16_t* XBC, int b, size_t row, int col) {
    const float* sc = a->in[I_SCONV] + (size_t)b * 12288 + col;
    const float v = a->in[I_CONVB][col] + a->in[I_CONVW][col] * sc[0] + a->in[I_CONVW][4096 + col] * sc[4096] + a->in[I_CONVW][8192 + col] * sc[8192] + a->in[I_CONVW][12288 + col] * bf2f(XBC[row * 4096 + col]);
    return v * sigm(v);
}
__device__ __forceinline__ void ssd_sample_wave(KA a, LAS float* wl, int b, int hd) {
    const int lane = tidx() & 63, g = hd >> 2;
    const bf16_t* XBC = (const bf16_t*)(a->ws + W_XBC); const float* DT = (const float*)(a->ws + W_DT); bf16_t* Z = (bf16_t*)a->out; float* ssq = (float*)(a->ws + W_SSQ);
    const size_t row = (size_t)NPR + b;
    const float xv = conv1_(a, XBC, b, row, hd * 64 + lane);
    wl[lane] = conv1_(a, XBC, b, row, 2048 + g * 128 + lane); wl[64 + lane] = conv1_(a, XBC, b, row, 2048 + g * 128 + 64 + lane);
    wl[128 + lane] = conv1_(a, XBC, b, row, 3072 + g * 128 + lane); wl[192 + lane] = conv1_(a, XBC, b, row, 3072 + g * 128 + 64 + lane);
    const float dtv = softplusf_(DT[row * 32 + hd] + a->in[I_DTB][hd]), dA = __expf(-__expf(a->in[I_ALOG][hd]) * dtv), xdt = dtv * xv;
    const size_t so = ((size_t)(b * 32 + hd) * 64 + lane) * 128;
    float y = 0.f;
#pragma unroll 8
    for (int q = 0; q < 32; ++q) {
        f32x4 hv = *(const f32x4*)(a->in[I_SSSM] + so + q * 4); const f32x4 Bv = *(const LAS f32x4*)(wl + q * 4), Cv = *(const LAS f32x4*)(wl + 128 + q * 4);
        hv = hv * dA + Bv * xdt; y += hv[0] * Cv[0] + hv[1] * Cv[1] + hv[2] * Cv[2] + hv[3] * Cv[3];
        *(f32x4*)(a->out + O_SSMS + so + q * 4) = hv;
    }
    const float yv = y + a->in[I_DSKIP][hd] * xv;
    bf16_t* zp = Z + row * 2048 + hd * 64 + lane; const float z = bf2f(*zp), yg = yv * z * sigm(z);
    *zp = f2bf(yg);
    const float sq = red64(yg * yg);
    if (lane == 0) atomicAdd(ssq + row * 8 + g, sq);
}

__device__ __forceinline__ void phase_mix(KA a, LAS unsigned char* lds) {
    const int tid = tidx(), nW = gridDim.x, wg = blockIdx.x;
    const bf16_t* XBC = (const bf16_t*)(a->ws + W_XBC);
    const int half = nW / 2;
    if (wg < half) {
        for (int it = wg; it < 128; it += half) rwkv_prompt_item(a, lds, it >> 4, it & 15);
        bar();
        const int gw = wg * 8 + (tid >> 6), ngw = half * 8; LAS float* wl = (LAS float*)(lds + (tid >> 6) * 4096);
        for (int it = gw; it < 2048; it += ngw) rwkv_sample_wave(a, wl, it >> 4, it & 15);
    }
    else {
        const int w = wg - half, ns = nW - half;
        {
            const int gw = w * 8 + (tid >> 6), ngw = ns * 8; LAS float* wl = (LAS float*)(lds + (tid >> 6) * 4096);
            for (int it = gw; it < 4096; it += ngw) ssd_sample_wave(a, wl, it >> 5, it & 31);
        }
        bar();
        for (int it = w; it < 256; it += ns) ssd_prompt_item(a, lds, it >> 5, it & 31);
    }
}

__device__ __forceinline__ void phase_ssdnorm(KA a) {
    u32x4* Z = (u32x4*)a->out; const float* ssq = (const float*)(a->ws + W_SSQ);
    {
        const bf16_t* XBC = (const bf16_t*)(a->ws + W_XBC); const int tid = tidx(), w = blockIdx.x, ns = gridDim.x;
        for (size_t i = (size_t)w * 512 + tid; i < (size_t)8 * 3 * 4096; i += (size_t)ns * 512) { const int c = (int)(i & 4095), j = (int)((i >> 12) % 3), b = (int)(i / 12288); a->out[O_CONVP + i] = bf2f(XBC[((size_t)b * 2048 + 2045 + j) * 4096 + c]); }
        for (size_t i = (size_t)w * 512 + tid; i < (size_t)128 * 3 * 4096; i += (size_t)ns * 512) { const int c = (int)(i & 4095), j = (int)((i >> 12) % 3), b = (int)(i / 12288);
            a->out[O_CONVS + i] = j < 2 ? a->in[I_SCONV][(size_t)b * 12288 + (j + 1) * 4096 + c] : bf2f(XBC[((size_t)NPR + b) * 4096 + c]); }
    }
    for (size_t i = (size_t)blockIdx.x * 512 + tidx(); i < (size_t)T * 256; i += (size_t)gridDim.x * 512) {
        const size_t row = i >> 8; const int gi = (int)(i & 255) >> 5;
        const float rs = rsqrtf(ssq[row * 8 + gi] * (1.0f / 256.0f) + EPS);
        u32x4 w = Z[i];
#pragma unroll
        for (int q = 0; q < 4; ++q) w[q] = cvt_pk_bf16(bflo(w[q]) * rs, bfhi(w[q]) * rs);
        Z[i] = w;
    }
}

__device__ __forceinline__ unsigned f2key(float f) { const unsigned u = __float_as_uint(f); return (u & 0x80000000u) ? ~u : (u | 0x80000000u); }
__device__ __forceinline__ float key2f(unsigned k) { return __uint_as_float((k & 0x80000000u) ? (k & 0x7fffffffu) : ~k); }
#define TOPK_INSERT(top, x) do { _Pragma("unroll") for (int _q = 0; _q < 16; ++_q) { const unsigned _hi = max(top[_q], x); x = min(top[_q], x); top[_q] = _hi; } } while (0)

__device__ __forceinline__ void phase_peer(KA a, LAS unsigned char* lds) {
    const int tid = tidx(), lane = tid & 63, wid = tid >> 6, quad = lane >> 4, l16 = lane & 15;
    LAS float* S = (LAS float*)lds;
    LAS unsigned* TK = (LAS unsigned*)(lds + 132096);
    LAS int* EI = (LAS int*)lds;
    LAS float* EG = (LAS float*)(lds + 8192);
    const bf16_t* Q = (const bf16_t*)(a->ws + W_Q); const bf16_t* K12 = (const bf16_t*)(a->ws + W_K12);
    const unsigned char* PUq = a->ws + W_PU; const unsigned char* PVq = a->ws + W_PV; const float* PUS = (const float*)(a->ws + W_PU + 16777216); const float* PVS = (const float*)(a->ws + W_PV + 16777216);
    const bf16_t* X1B = (const bf16_t*)(a->ws + W_X1B); bf16_t* X2B = (bf16_t*)(a->ws + W_X2B);
    const float* ss1 = (const float*)(a->ws + W_SS) + TP; float* ss2 = (float*)(a->ws + W_SS) + 2 * TP;
    const int t_beg = (int)(((long)blockIdx.x * T) / gridDim.x), t_end = (int)(((long)(blockIdx.x + 1) * T) / gridDim.x);
    for (int tb = t_beg; tb < t_end; tb += 16) {
        const size_t tok0 = (size_t)tb; const int nt = (t_end - tb) < 16 ? (t_end - tb) : 16;
#pragma unroll 1
        for (int hq = 0; hq < 2; ++hq) {
            const int hh = wid * 2 + hq;
            bf16x8 af[4];
#pragma unroll
            for (int kk = 0; kk < 4; ++kk) af[kk] = *(const bf16x8*)(Q + (tok0 + (l16 < nt ? l16 : nt - 1)) * 2048 + hh * 128 + kk * 32 + quad * 8);
#pragma unroll 2
            for (int nt = 0; nt < 8; ++nt) {
                f32x4 acc = {0.f, 0.f, 0.f, 0.f};
#pragma unroll
                for (int kk = 0; kk < 4; ++kk) acc = mfma16(af[kk], *(const bf16x8*)(K12 + ((size_t)hh * 128 + nt * 16 + l16) * 128 + kk * 32 + quad * 8), acc);
#pragma unroll
                for (int j = 0; j < 4; ++j) S[((quad * 4 + j) * 16 + hh) * 129 + nt * 16 + l16] = acc[j];
            }
        }
        bar();
        if (tid < 256) {
            unsigned top[16];
#pragma unroll
            for (int q = 0; q < 16; ++q) top[q] = 0u;
            for (int i = 0; i < 128; ++i) { unsigned x = (f2key(S[tid * 129 + i]) & ~127u) | (unsigned)(127 - i); TOPK_INSERT(top, x); }
#pragma unroll
            for (int q = 0; q < 16; ++q) TK[tid * 16 + q] = top[q];
        }
        bar();
        if (tid < 128) {
            const int t = tid >> 3, head = tid & 7, r1 = (t * 16 + head * 2) * 16, r2 = r1 + 16;
            float f1[16], f2[16];
#pragma unroll
            for (int q = 0; q < 16; ++q) { f1[q] = key2f(TK[r1 + q]); f2[q] = key2f(TK[r2 + q]); }
            unsigned top[16];
#pragma unroll
            for (int q = 0; q < 16; ++q) top[q] = 0u;
#pragma unroll
            for (int i = 0; i < 16; ++i)
#pragma unroll
                for (int j = 0; j < 16; ++j)
                    if ((i + 1) * (j + 1) <= 16) { unsigned x = (f2key(f1[i] + f2[j]) & ~255u) | (unsigned)(255 - (i * 16 + j)); TOPK_INSERT(top, x); }
            float sv[16]; int id[16]; float mx = -3.0e38f;
#pragma unroll
            for (int q = 0; q < 16; ++q) {
                const int pos = 255 - (int)(top[q] & 255u), i = pos >> 4, j = pos & 15;
                const unsigned k1 = TK[r1 + i], k2 = TK[r2 + j];
                sv[q] = key2f(k1) + key2f(k2); id[q] = (127 - (int)(k1 & 127u)) * 128 + (127 - (int)(k2 & 127u)); mx = fmaxf(mx, sv[q]);
            }
            float den = 0.f;
#pragma unroll
            for (int q = 0; q < 16; ++q) { sv[q] = __expf(sv[q] - mx); den += sv[q]; }
            const float rden = 1.0f / den;
#pragma unroll
            for (int q = 0; q < 16; ++q) { EI[t * 128 + head * 16 + q] = id[q]; EG[t * 128 + head * 16 + q] = sv[q] * rden; }
        }
        bar();
#pragma unroll 1
        for (int tq = 0; tq < 2; ++tq) {
            const int tt = wid * 2 + tq; const size_t tok = tok0 + tt;
            if (tt >= nt) continue;
            const u32x4 xa = *(const u32x4*)(X1B + tok * 1024 + lane * 16), xb = *(const u32x4*)(X1B + tok * 1024 + lane * 16 + 8);
            f32x2 xf[8];
#pragma unroll
            for (int q = 0; q < 4; ++q) { xf[q] = (f32x2){bflo(xa[q]), bfhi(xa[q])}; xf[4 + q] = (f32x2){bflo(xb[q]), bfhi(xb[q])}; }
            const float rs = rsqrtf(ss1[tok] * (1.0f / 1024.0f) + EPS);
            f32x2 out2[8];
#pragma unroll
            for (int q = 0; q < 8; ++q) out2[q] = (f32x2){0.f, 0.f};
#pragma unroll 1
            for (int hf = 0; hf < 2; ++hf) {
                float dl = 0.f;
#pragma unroll 1
                for (int e0 = 0; e0 < 64; e0 += 8) {
                    u32x4 w[8]; float rsc[8];
#pragma unroll
                    for (int u = 0; u < 8; ++u) { const int idx = __builtin_amdgcn_readfirstlane(EI[tt * 128 + hf * 64 + e0 + u]); w[u] = *(const u32x4*)(PUq + (size_t)idx * 1024 + lane * 16); rsc[u] = PUS[idx]; }
#pragma unroll
                    for (int u = 0; u < 8; ++u) {
                        f32x2 acc = {0.f, 0.f};
#pragma unroll
                        for (int q = 0; q < 4; ++q) { acc += xf[2 * q] * __builtin_amdgcn_cvt_pk_f32_fp8((int)w[u][q], false); acc += xf[2 * q + 1] * __builtin_amdgcn_cvt_pk_f32_fp8((int)w[u][q], true); }
                        const float d = red64(acc.x + acc.y) * rsc[u];
                        dl = (lane == e0 + u) ? d : dl;
                    }
                }
                const float z = dl * rs, act = 0.5f * z * (1.0f + erff(z * 0.70710678f));
                const float cl = EG[tt * 128 + hf * 64 + lane] * act;
#pragma unroll 1
                for (int e0 = 0; e0 < 64; e0 += 8) {
                    u32x4 w[8]; float cc[8];
#pragma unroll
                    for (int u = 0; u < 8; ++u) { const int idx = __builtin_amdgcn_readfirstlane(EI[tt * 128 + hf * 64 + e0 + u]); w[u] = *(const u32x4*)(PVq + (size_t)idx * 1024 + lane * 16);
                        cc[u] = __int_as_float(__builtin_amdgcn_readlane(__float_as_int(cl), e0 + u)) * PVS[idx]; }
#pragma unroll
                    for (int u = 0; u < 8; ++u) { const f32x2 c2 = {cc[u], cc[u]};
#pragma unroll
                        for (int q = 0; q < 4; ++q) { out2[2 * q] += c2 * __builtin_amdgcn_cvt_pk_f32_fp8((int)w[u][q], false); out2[2 * q + 1] += c2 * __builtin_amdgcn_cvt_pk_f32_fp8((int)w[u][q], true); } }
                }
            }
            float out[16];
#pragma unroll
            for (int q = 0; q < 8; ++q) { out[2 * q] = out2[q].x; out[2 * q + 1] = out2[q].y; }
            const float* xr = a->out + tok * 1024 + lane * 16; float* xw = (float*)(a->ws + W_P1) + tok * 1024 + lane * 16; float sq = 0.f; unsigned pk[8];
#pragma unroll
            for (int q = 0; q < 4; ++q) { f32x4 v = *(const f32x4*)(xr + q * 4);
#pragma unroll
                for (int j = 0; j < 4; ++j) { v[j] += out[q * 4 + j]; sq += v[j] * v[j]; }
                *(f32x4*)(xw + q * 4) = v; pk[2 * q] = cvt_pk_bf16(v[0], v[1]); pk[2 * q + 1] = cvt_pk_bf16(v[2], v[3]); }
            *(u32x4*)(X2B + tok * 1024 + lane * 16) = (u32x4){pk[0], pk[1], pk[2], pk[3]}; *(u32x4*)(X2B + tok * 1024 + lane * 16 + 8) = (u32x4){pk[4], pk[5], pk[6], pk[7]};
            sq = red64(sq);
            if (lane == 0) ss2[tok] = sq;
        }
        bar();
    }
}

__device__ __forceinline__ void phase_final(KA a) {
    f32x4* X = (f32x4*)a->out; const float* ss3 = (const float*)(a->ws + W_SS) + 3 * TP; const f32x4* gn = (const f32x4*)a->in[I_NFIN];
    for (size_t i = (size_t)blockIdx.x * 512 + tidx(); i < (size_t)T * 256; i += (size_t)gridDim.x * 512) {
        const float rs = rsqrtf(ss3[i >> 8] * (1.0f / 1024.0f) + EPS);
        X[i] = X[i] * rs * gn[i & 255];
    }
}

__global__ void __launch_bounds__(512) hybrid_fwd(Args a_unused) {
    extern __shared__ __attribute__((aligned(16))) unsigned char lds_raw[];
    LAS unsigned char* lds = (LAS unsigned char*)lds_raw;
    cg::grid_group grid = cg::this_grid();
    KA a = (KA)__builtin_amdgcn_kernarg_segment_ptr();
    unsigned char* ws = a->ws;
    float* ss = (float*)(ws + W_SS);
    const int ph_lo = a->ph_lo, ph_hi = a->ph_hi;
#ifndef PROBE_REP
#define PROBE_REP 0
#endif
    unsigned* barcnt = (unsigned*)(ws + W_BAR); unsigned nbar = 0;
    if (ph_hi > 1000) grid.sync();
#define GRID_SYNC() do { ++nbar; grid_barrier(barcnt, nbar); } while (0)
#define PH_BEGIN(k) if (ph_lo <= (k) && (k) < ph_hi) { if ((k) > ph_lo) GRID_SYNC(); for (int rep_ = 0; rep_ < 1 + ((PROBE_REP >> (k)) & 1); ++rep_) { if (rep_) GRID_SYNC();
#define PH_END } }
    PH_BEGIN(0)  phase_prep(a, lds); PH_END
    PH_BEGIN(1)  { EpiU E; E.Z = (bf16_t*)a->out; E.XBC = (bf16_t*)(ws + W_XBC); E.RW = (bf16_t*)(ws + W_RW); E.G = (bf16_t*)(ws + W_G); E.DT = (float*)(ws + W_DT); E.ss0 = ss;
                  run_gemm<EpiU, false>(lds, (const bf16_t*)(ws + W_XB), 1024, (const bf16_t*)(ws + W_WIN), 1024, NU, 1024, E); } PH_END
    PH_BEGIN(2)  phase_mix(a, lds); PH_END
    PH_BEGIN(3)  phase_ssdnorm(a); PH_END
    PH_BEGIN(4)  { EpiMix<0> E0; E0.P = (float*)(ws + W_P1); E0.V = nullptr; E0.G = (const bf16_t*)(ws + W_G); E0.goff = 0;
                  run_gemm(lds, (const bf16_t*)a->out, 2048, (const bf16_t*)(ws + W_WOS), 2048, 1024, 2048, E0);
                  __threadfence(); __syncthreads();
                  EpiMix<1> E1; E1.P = (float*)(ws + W_P1); E1.V = (bf16_t*)(ws + W_V); E1.G = (const bf16_t*)(ws + W_G); E1.goff = 1024;
                  run_gemm(lds, (const bf16_t*)(ws + W_RW), 3328, (const bf16_t*)(ws + W_WOR), 1024, 1024, 1024, E1); } PH_END
    PH_BEGIN(5)  { EpiRes<0> E; E.xp = a->in[I_XP]; E.xs = a->in[I_XS]; E.X = a->out; E.XB = (bf16_t*)(ws + W_X1B); E.ss = ss + TP; E.ssin = nullptr; E.P = nullptr;
                  run_gemm(lds, (const bf16_t*)(ws + W_V), 1024, (const bf16_t*)(ws + W_WO), 1024, 1024, 1024, E); } PH_END
    PH_BEGIN(6)  { EpiQ E; E.O = (bf16_t*)(ws + W_Q); E.ld = 2048; E.ss = ss + TP;
                  run_gemm(lds, (const bf16_t*)(ws + W_X1B), 1024, (const bf16_t*)(ws + W_WQ), 1024, 2048, 1024, E); } PH_END
    PH_BEGIN(7)  phase_peer(a, lds); PH_END
    PH_BEGIN(8)  { EpiMix<2> E0; E0.P = (float*)(ws + W_PP); E0.V = nullptr; E0.G = nullptr; E0.goff = 0;
                  run_gemm(lds, (const bf16_t*)(ws + W_PB), 256, (const bf16_t*)(ws + W_WPP), 256, 1024, 256, E0);
                  __threadfence(); __syncthreads();
                  EpiRes<1> E; E.xp = (const float*)(ws + W_P1); E.xs = nullptr; E.X = a->out; E.XB = nullptr; E.ss = ss + 3 * TP; E.ssin = ss + 2 * TP; E.P = (const float*)(ws + W_PP);
                  run_gemm(lds, (const bf16_t*)(ws + W_X2B), 1024, (const bf16_t*)(ws + W_WPG), 1024, 1024, 1024, E); } PH_END
    PH_BEGIN(9) phase_final(a); PH_END
}

extern "C" void kernel_launch(void* const* d_in, const int* in_sizes, int n_in, void* d_out, int out_size, void* d_ws, size_t ws_size, hipStream_t stream) {
    static int grid = 0;
    if (grid == 0) {
        if (n_in != 40 || (size_t)out_size != O_END || ws_size < W_TOTAL) { fprintf(stderr, "kernel_launch: unexpected shapes: n_in %d out %d ws %zu (need %zu)\n", n_in, out_size, ws_size, (size_t)W_TOTAL); grid = -1; return; }
        int dev = 0, cus = 0, per_cu = 0;
        hipGetDevice(&dev); hipDeviceGetAttribute(&cus, hipDeviceAttributeMultiprocessorCount, dev);
        if (hipFuncSetAttribute((const void*)hybrid_fwd, hipFuncAttributeMaxDynamicSharedMemorySize, LDS_BYTES) != hipSuccess) { fprintf(stderr, "kernel_launch: hipFuncSetAttribute failed\n"); grid = -1; return; }
        if (hipOccupancyMaxActiveBlocksPerMultiprocessor(&per_cu, (const void*)hybrid_fwd, 512, LDS_BYTES) != hipSuccess || per_cu < 1) { fprintf(stderr, "kernel_launch: occupancy query says %d\n", per_cu); per_cu = 1; }
        (void)hipGetLastError();
        grid = cus * 1;
        if (grid > 256) grid = 256;
    }
    if (grid < 0) return;
    (void)hipMemsetAsync((unsigned char*)d_ws + W_BAR, 0, 4096, stream);
    Args a{};
    for (int i = 0; i < 40; ++i) a.in[i] = (const float*)d_in[i];
    a.out = (float*)d_out; a.ws = (unsigned char*)d_ws;
#if MULTI_LAUNCH
    for (int ph = 0; ph < NPHASE; ++ph) { a.ph_lo = ph; a.ph_hi = ph + 1; hipLaunchKernelGGL(hybrid_fwd, dim3(grid), dim3(512), LDS_BYTES, stream, a); }
#else
    a.ph_lo = 0; a.ph_hi = NPHASE;
    void* args[] = {&a};
    hipError_t e = hipLaunchCooperativeKernel((const void*)hybrid_fwd, dim3(grid), dim3(512), args, LDS_BYTES, stream);
    if (e != hipSuccess) fprintf(stderr, "kernel_launch: cooperative launch failed: %s (grid %d)\n", hipGetErrorString(e), grid);
#endif
}
```

```cpp
#include <hip/hip_runtime.h>
#include <hip/hip_cooperative_groups.h>
#include <cstdio>
namespace cg = cooperative_groups;
#ifndef MULTI_LAUNCH
#define MULTI_LAUNCH 0
#endif
__device__ __forceinline__ int tidx() { int t = threadIdx.x; asm volatile("" : "+v"(t)); return t; }
namespace pg8 {
#define PG8_LAS __attribute__((address_space(3)))
typedef unsigned short bf16_t;
typedef short bf16x8 __attribute__((ext_vector_type(8)));
typedef float f32x4 __attribute__((ext_vector_type(4)));
typedef unsigned u32x4 __attribute__((ext_vector_type(4)));
constexpr int BM = 256, BK = 64, HALF = 128, HTB = HALF * BK * 2  , STAGE_BYTES = 8 * HTB, NXCD = 8, WGM = 4;

__host__ __device__ __forceinline__ int lds_byte(int r, int c) { const int st = (r >> 4) * 2 + (c >> 5), rr = r & 15, cc = c & 31, ob = rr * 64 + cc * 2; return st * 1024 + (ob ^ (((ob >> 9) & 1) << 5)); }
__host__ __device__ __forceinline__ void stage_rc(int b, int& R, int& C) { const int st = b / 1024, sb = b % 1024, swz = sb ^ (((sb >> 9) & 1) << 5); R = (st >> 1) * 16 + swz / 64; C = (st & 1) * 32 + (swz % 64) / 2; }
__host__ __device__ __forceinline__ int perm32(int rho) { const int n = rho >> 4, i = rho & 15; return 8 * (i >> 2) + 4 * n + (i & 3); }

struct Unit { int pm, pn; };
struct Gemm { const bf16_t* A; const bf16_t* Bt; int M, N, K, lda, ldb; };

struct StaticOrder {
    int nM, nN, nwg, G, c;
    __host__ __device__ void init(int M, int N, int G_, int c_) { nM = M / BM; nN = N / BM; nwg = nM * nN; G = G_; c = c_; }
    __host__ __device__ bool next(int i, Unit& u) const {
        const long L = (long)i * G + c; if (L >= nwg) return false;
        int wgid = (int)L; { const int q = nwg / NXCD, r = nwg % NXCD, xcd = wgid % NXCD, off = wgid / NXCD; wgid = (xcd < r ? xcd * (q + 1) : r * (q + 1) + (xcd - r) * q) + off; }
        const int nig = WGM * nN, gid = wgid / nig, fm = gid * WGM, gsz = (nM - fm) < WGM ? (nM - fm) : WGM;
        u.pm = fm + ((wgid % nig) % gsz); u.pn = (wgid % nig) / gsz; return true;
    }
    __device__ __forceinline__ void a_ready(const Unit&) const {}
    __device__ __forceinline__ void done(const Unit&) const {}
};
__device__ __forceinline__ unsigned cvt_pk_bf16(float lo, float hi) { unsigned r; asm volatile("v_cvt_pk_bf16_f32 %0, %1, %2" : "=v"(r) : "v"(lo), "v"(hi)); return r; }
template <class Epi, class Sched>
__device__ __forceinline__ void gemm_phase(PG8_LAS unsigned char* lds, const Gemm g, const Sched& S, const Epi& E) {
    const int tid = tidx(), wid = __builtin_amdgcn_readfirstlane(tid >> 6), lane = tid & 63, wr = wid >> 2, wc = wid & 3, fr = lane & 15, fq = lane >> 4;
    const int K = g.K, nt = K / BK;
    unsigned voffA[2], voffB[2];
#pragma unroll
    for (int i = 0; i < 2; ++i) { int R, C; stage_rc(tid * 16 + i * 8192, R, C); const int Rb = Epi::PERM ? ((R & ~31) + perm32(R & 31)) : R;
        voffA[i] = (unsigned)(R * g.lda + C) * 2u; voffB[i] = (unsigned)(Rb * g.ldb + C) * 2u; }
    const size_t kstep = (size_t)(BK * 2);
    const size_t hstepA = (size_t)HALF * g.lda * 2, hstepB = (size_t)HALF * g.ldb * 2;
    const size_t tstepA = 2 * hstepA, tstepB = 2 * hstepB;
    const unsigned ldsw = (unsigned)wid * 1024u;
    const int aoff = lds_byte(wr * 64 + fr, fq * 8), boff = lds_byte(wc * 32 + fr, fq * 8);
#define PG8_SA(b, h) (((b) * 2 + (h)) * HTB)
#define PG8_SB(b, h) ((4 + (b) * 2 + (h)) * HTB)
#define PG8_STAGE(bufoff, gbase, voff) do { _Pragma("unroll") for (int _i = 0; _i < 2; ++_i) \
        __builtin_amdgcn_global_load_lds((const unsigned*)((const char*)(gbase) + (voff)[_i]), (PG8_LAS unsigned*)(lds + (bufoff) + ldsw + _i * 8192), 16, 0, 0); } while (0)
#define PG8_LDA(dst, b, h) do { _Pragma("unroll") for (int m = 0; m < 4; ++m) _Pragma("unroll") for (int k = 0; k < 2; ++k) dst[m][k] = *(const PG8_LAS bf16x8*)(lds + PG8_SA(b, h) + aoff + m * 2048 + k * 1024); } while (0)
#define PG8_LDB(dst, b, h) do { _Pragma("unroll") for (int n = 0; n < 2; ++n) _Pragma("unroll") for (int k = 0; k < 2; ++k) dst[n][k] = *(const PG8_LAS bf16x8*)(lds + PG8_SB(b, h) + boff + n * 2048 + k * 1024); } while (0)
#define PG8_MMA(ai, bj, At, Bt) do { __builtin_amdgcn_s_setprio(1); _Pragma("unroll") for (int m = 0; m < 4; ++m) _Pragma("unroll") for (int n = 0; n < 2; ++n) _Pragma("unroll") for (int k = 0; k < 2; ++k) \
        acc[ai][bj][m][n] = __builtin_amdgcn_mfma_f32_16x16x32_bf16(Bt[n][k], At[m][k], acc[ai][bj][m][n], 0, 0, 0); __builtin_amdgcn_s_setprio(0); } while (0)
#define PG8_WAIT_V(n) asm volatile("s_waitcnt vmcnt(" #n ")" ::: "memory")
#define PG8_WAIT_L(n) asm volatile("s_waitcnt lgkmcnt(" #n ")" ::: "memory")
#define PG8_BAR __builtin_amdgcn_s_barrier()
#define PG8_SCHED __builtin_amdgcn_sched_barrier(0)
    Unit cur, nxt; int ui = 0;
    if (!S.next(0, cur)) return;
    f32x4 acc[2][2][4][2];
#pragma unroll
    for (int a = 0; a < 2; ++a)
#pragma unroll
        for (int b = 0; b < 2; ++b)
#pragma unroll
            for (int m = 0; m < 4; ++m)
#pragma unroll
                for (int n = 0; n < 2; ++n) acc[a][b][m][n] = (f32x4){0.f, 0.f, 0.f, 0.f};
    bf16x8 At[4][2], B0[2][2], B1[2][2];
    const char* cA = (const char*)g.A + (size_t)cur.pm * tstepA; const char* cB = (const char*)g.Bt + (size_t)cur.pn * tstepB;
    S.a_ready(cur);
    PG8_STAGE(PG8_SB(0, 0), cB, voffB); PG8_STAGE(PG8_SA(0, 0), cA, voffA); PG8_STAGE(PG8_SB(0, 1), cB + hstepB, voffB); PG8_STAGE(PG8_SA(0, 1), cA + hstepA, voffA);
    if (wr == 1) PG8_BAR;
    PG8_WAIT_V(4); PG8_BAR;
    PG8_STAGE(PG8_SB(1, 0), cB + kstep, voffB); PG8_STAGE(PG8_SA(1, 0), cA + kstep, voffA); PG8_STAGE(PG8_SB(1, 1), cB + hstepB + kstep, voffB);
    PG8_WAIT_V(6); PG8_BAR;
    for (;;) {
        const bool has_next = S.next(ui + 1, nxt);
        const char* nA = has_next ? (const char*)g.A + (size_t)nxt.pm * tstepA : cA; const char* nB = has_next ? (const char*)g.Bt + (size_t)nxt.pn * tstepB : cB;
        for (int t = 0; t < nt; t += 2) {
            const bool last = (t == nt - 2);
            const char* a1 = cA + (size_t)(t + 1) * kstep;
            const char* a2 = last ? nA : cA + (size_t)(t + 2) * kstep; const char* b2 = last ? nB : cB + (size_t)(t + 2) * kstep;
            const char* a3 = a2 + kstep; const char* b3 = b2 + kstep;
            if (last && has_next) S.a_ready(nxt);
            PG8_LDB(B0, 0, 0); PG8_SCHED; PG8_LDA(At, 0, 0); PG8_STAGE(PG8_SA(1, 1), a1 + hstepA, voffA);
            PG8_WAIT_L(8); PG8_BAR; PG8_WAIT_L(0); PG8_MMA(0, 0, At, B0); PG8_BAR; PG8_SCHED;
            PG8_LDB(B1, 0, 1); PG8_STAGE(PG8_SB(0, 0), b2, voffB);
            PG8_BAR; PG8_WAIT_L(0); PG8_MMA(0, 1, At, B1); PG8_BAR;
            PG8_LDA(At, 0, 1); PG8_STAGE(PG8_SA(0, 0), a2, voffA);
            PG8_BAR; PG8_WAIT_L(0); PG8_MMA(1, 0, At, B0); PG8_BAR; PG8_SCHED;
            PG8_STAGE(PG8_SB(0, 1), b2 + hstepB, voffB);
            PG8_WAIT_V(6); PG8_BAR; PG8_MMA(1, 1, At, B1); PG8_BAR;
            PG8_LDB(B0, 1, 0); PG8_SCHED; PG8_LDA(At, 1, 0); PG8_STAGE(PG8_SA(0, 1), a2 + hstepA, voffA);
            PG8_WAIT_L(8); PG8_BAR; PG8_WAIT_L(0); PG8_MMA(0, 0, At, B0); PG8_BAR; PG8_SCHED;
            PG8_LDB(B1, 1, 1); PG8_STAGE(PG8_SB(1, 0), b3, voffB);
            PG8_BAR; PG8_WAIT_L(0); PG8_MMA(0, 1, At, B1); PG8_BAR;
            PG8_LDA(At, 1, 1); PG8_STAGE(PG8_SA(1, 0), a3, voffA);
            PG8_BAR; PG8_WAIT_L(0); PG8_MMA(1, 0, At, B0); PG8_BAR; PG8_SCHED;
            PG8_STAGE(PG8_SB(1, 1), b3 + hstepB, voffB);
            PG8_WAIT_V(6); PG8_BAR; PG8_MMA(1, 1, At, B1); PG8_BAR;
        }
        if constexpr (!Epi::AFTER_DRAIN) { E(acc, cur, wr, wc, fr, fq); S.done(cur); }
        if (!has_next) break;
#pragma unroll
        for (int a = 0; a < 2; ++a)
#pragma unroll
            for (int b = 0; b < 2; ++b)
#pragma unroll
                for (int m = 0; m < 4; ++m)
#pragma unroll
                    for (int n = 0; n < 2; ++n) acc[a][b][m][n] = (f32x4){0.f, 0.f, 0.f, 0.f};
        cur = nxt; cA = nA; cB = nB; ++ui;
    }
    PG8_WAIT_V(0);
    if (wr == 0) PG8_BAR;
    PG8_BAR;
    if constexpr (Epi::AFTER_DRAIN) { E.fused(acc, cur, wr, wc, fr, fq, lds, wid, lane); S.done(cur); }
#undef PG8_SA
#undef PG8_SB
#undef PG8_STAGE
#undef PG8_LDA
#undef PG8_LDB
#undef PG8_MMA
#undef PG8_WAIT_V
#undef PG8_WAIT_L
#undef PG8_BAR
#undef PG8_SCHED
}
}

#define LAS __attribute__((address_space(3)))
using pg8::bf16_t; using pg8::bf16x8; using pg8::f32x4; using pg8::u32x4; using pg8::cvt_pk_bf16;
typedef unsigned u32x2 __attribute__((ext_vector_type(2)));
typedef float f32x2 __attribute__((ext_vector_type(2)));
typedef __bf16 bfp2 __attribute__((ext_vector_type(2)));

constexpr int DM = 1024, NBAT = 8, SEQ = 2048, NPR = NBAT * SEQ, NSM = 128, T = NPR + NSM, TP = 16640;
constexpr int NU = 11776;
constexpr int SHIFT = 3328;
constexpr float EPS = 1e-6f;
constexpr size_t O_SSMP = (size_t)T * 1024, O_CONVP = O_SSMP + 8 * 32 * 64 * 128, O_WKVP = O_CONVP + 8 * 3 * 4096, O_SHIFTP = O_WKVP + 8 * 16 * 64 * 64,
                 O_SSMS = O_SHIFTP + 8 * 3328, O_CONVS = O_SSMS + (size_t)128 * 32 * 64 * 128, O_WKVS = O_CONVS + 128 * 3 * 4096, O_SHIFTS = O_WKVS + (size_t)128 * 16 * 64 * 64,
                 O_END = O_SHIFTS + 128 * 3328;
constexpr size_t W_WIN = 0, W_WOS = W_WIN + (size_t)NU * 1024 * 2, W_WOR = W_WOS + 1024 * 2048 * 2, W_WO = W_WOR + 1024 * 1024 * 2, W_WQ = W_WO + 1024 * 1024 * 2,
                 W_WPG = W_WQ + 2048 * 1024 * 2, W_WPP = W_WPG + 1024 * 1024 * 2, W_K12 = W_WPP + 1024 * 256 * 2, W_PU = W_K12 + 8 * 2 * 128 * 128 * 2,
                 W_PV = W_PU + (size_t)16384 * 1024 * 2, W_XB = W_PV + (size_t)16384 * 1024 * 2, W_XBC = W_XB + (size_t)TP * 1024 * 2, W_RW = W_XBC + (size_t)TP * 4096 * 2,
                 W_G = W_RW + (size_t)TP * 3328 * 2, W_DT = W_G + (size_t)TP * 2048 * 2, W_PB = W_DT + (size_t)TP * 32 * 4, W_SS = W_PB + (size_t)TP * 256 * 2,
                 W_SSQ = W_SS + (size_t)4 * TP * 4, W_END = W_SSQ + (size_t)TP * 8 * 4;
constexpr size_t W_BAR = W_END, W_TOTAL = W_END + 4096;
constexpr size_t W_P1 = W_XBC, W_X1B = W_XBC + (size_t)TP * 1024 * 4, W_V = W_XB, W_X2B = W_XB, W_Q = W_RW, W_PP = W_RW;
constexpr int LDS_BYTES = 155648;
constexpr int NPHASE = 10;

struct Args { const float* in[40]; float* out; unsigned char* ws; int ph_lo, ph_hi; };
typedef const Args __attribute__((address_space(4)))* KA;

enum { I_XP = 0, I_XS, I_PP, I_PS, I_SSSM, I_SCONV, I_SWKV, I_SSHIFT, I_NMIX, I_WIN, I_CONVW, I_CONVB, I_DTB, I_ALOG, I_DSKIP, I_SSMN, I_WOSSM, I_MU, I_W0, I_W2, I_A0, I_A2, I_G2,
       I_KK, I_KA, I_RK, I_LNG, I_LNB, I_WORW, I_WOUT, I_NFFN, I_WQ, I_K1, I_K2, I_PU, I_PV, I_NPLE, I_WPG, I_WPP, I_NFIN };

__device__ __forceinline__ float bf2f(bf16_t b) { return __uint_as_float(((unsigned)b) << 16); }
__device__ __forceinline__ float bflo(unsigned w) { return __uint_as_float(w << 16); }
__device__ __forceinline__ float bfhi(unsigned w) { return __uint_as_float(w & 0xffff0000u); }
__device__ __forceinline__ bf16_t f2bf(float f) { return (bf16_t)(cvt_pk_bf16(f, 0.f) & 0xffffu); }
__device__ __forceinline__ float sigm(float x) { return __builtin_amdgcn_rcpf(1.0f + __expf(-x)); }
__device__ __forceinline__ float tanh_fast(float x) { return 2.0f * sigm(2.0f * x) - 1.0f; }
template <int CTRL> __device__ __forceinline__ float dppm(float x) { return __int_as_float(__builtin_amdgcn_update_dpp(0, __float_as_int(x), CTRL, 0xF, 0xF, true)); }
__device__ __forceinline__ float red8(float x) { x += dppm<0xB1>(x); x += dppm<0x4E>(x); x += dppm<0x141>(x); return x; }
__device__ __forceinline__ float red16(float x) { x = red8(x); x += dppm<0x140>(x); return x; }
__device__ __forceinline__ float red64(float x) { x = red16(x); x += __shfl_xor(x, 16); x += __shfl_xor(x, 32); return x; }
__device__ __forceinline__ f32x4 mfma16(bf16x8 a, bf16x8 b, f32x4 c) { return __builtin_amdgcn_mfma_f32_16x16x32_bf16(a, b, c, 0, 0, 0); }
__device__ __forceinline__ void bar() { __syncthreads(); }
__device__ __forceinline__ void bar_lds() { asm volatile("s_waitcnt lgkmcnt(0)\n\ts_barrier" ::: "memory"); }

__device__ __forceinline__ void peer_quant_row(KA a, int r) {
    const int lane = tidx() & 63; unsigned char* ws = a->ws;
    const bool isv = r >= 16384; const int e = r & 16383;
    const float* src = (isv ? a->in[I_PV] : a->in[I_PU]) + (size_t)e * 1024 + lane * 16;
    f32x4 v[4]; float amax = 0.f;
#pragma unroll
    for (int q = 0; q < 4; ++q) { v[q] = *(const f32x4*)(src + q * 4); if (!isv) v[q] = v[q] * *(const f32x4*)(a->in[I_NFFN] + lane * 16 + q * 4);
        amax = fmaxf(amax, fmaxf(fmaxf(fabsf(v[q][0]), fabsf(v[q][1])), fmaxf(fabsf(v[q][2]), fabsf(v[q][3])))); }
#pragma unroll
    for (int off = 1; off < 64; off <<= 1) amax = fmaxf(amax, __shfl_xor(amax, off));
    const float sc = amax > 0.f ? 224.0f / amax : 1.0f;
    u32x4 w;
#pragma unroll
    for (int q = 0; q < 4; ++q) { int p = __builtin_amdgcn_cvt_pk_fp8_f32(v[q][0] * sc, v[q][1] * sc, 0, false); p = __builtin_amdgcn_cvt_pk_fp8_f32(v[q][2] * sc, v[q][3] * sc, p, true); w[q] = (unsigned)p; }
    unsigned char* dst = ws + (isv ? W_PV : W_PU);
    *(u32x4*)(dst + (size_t)e * 1024 + lane * 16) = w;
    if (lane == 0) ((float*)(dst + 16777216))[e] = amax > 0.f ? amax * (1.0f / 224.0f) : 1.0f;
}

constexpr int N_LATE_JOBS = 14848;
__device__ __forceinline__ void late_transpose_job(KA a, int job) {
    const int lane = tidx() & 63; unsigned char* ws = a->ws;
    const float* src; const float* gain = nullptr; bf16_t* dst; int ld, K, r;
    if (job < 4096) { r = job; src = a->in[I_WOSSM]; gain = a->in[I_SSMN]; dst = (bf16_t*)(ws + W_WOS); ld = 1024; K = 2048; }
    else if (job < 6144) { r = job - 4096; src = a->in[I_WORW]; dst = (bf16_t*)(ws + W_WOR); ld = 1024; K = 1024; }
    else if (job < 8192) { r = job - 6144; src = a->in[I_WOUT]; dst = (bf16_t*)(ws + W_WO); ld = 1024; K = 1024; }
    else if (job < 12288) { r = job - 8192; src = a->in[I_WQ]; gain = a->in[I_NFFN]; dst = (bf16_t*)(ws + W_WQ); ld = 2048; K = 1024; }
    else if (job < 14336) { r = job - 12288; src = a->in[I_WPG]; gain = a->in[I_NPLE]; dst = (bf16_t*)(ws + W_WPG); ld = 1024; K = 1024; }
    else { r = job - 14336; src = a->in[I_WPP]; dst = (bf16_t*)(ws + W_WPP); ld = 1024; K = 256; }
    const int nk = K >> 3, nb = r / nk, kb = r - nb * nk, n = nb * 64 + lane, k0 = kb * 8;
    float v[8];
#pragma unroll
    for (int j = 0; j < 8; ++j) v[j] = src[(size_t)(k0 + j) * ld + n];
    if (gain) {
#pragma unroll
        for (int j = 0; j < 8; ++j) v[j] *= gain[k0 + j]; }
    u32x4 w; w.x = cvt_pk_bf16(v[0], v[1]); w.y = cvt_pk_bf16(v[2], v[3]); w.z = cvt_pk_bf16(v[4], v[5]); w.w = cvt_pk_bf16(v[6], v[7]);
    *(u32x4*)(dst + (size_t)n * K + k0) = w;
}

__device__ __forceinline__ void grid_barrier(unsigned* cnt, unsigned round) {
    __syncthreads();
    if (tidx() < 64) {
        if (tidx() == 0) {
            const unsigned nW = gridDim.x, ng = nW < 8u ? nW : 8u, g = blockIdx.x % ng, gsz = (nW - g + ng - 1) / ng;
            const unsigned old = __hip_atomic_fetch_add(cnt + 64 * (1 + g), 1u, __ATOMIC_ACQ_REL, __HIP_MEMORY_SCOPE_AGENT);
            if (old + 1 == round * gsz) __hip_atomic_fetch_add(cnt, 1u, __ATOMIC_RELEASE, __HIP_MEMORY_SCOPE_AGENT);
            while (__hip_atomic_load(cnt, __ATOMIC_RELAXED, __HIP_MEMORY_SCOPE_AGENT) < round * ng) __builtin_amdgcn_s_sleep(2);
        }
        __builtin_amdgcn_fence(__ATOMIC_ACQUIRE, "agent");
    }
    __syncthreads();
}

__device__ __forceinline__ int win_colmap(int n) { if (n < 6144) return n; if (n < 11520) return n + 32; if (n < 11552) return 6144 + (n - 11520); return -1; }

__device__ __forceinline__ void transpose_tile(LAS float* tl, const float* __restrict__ src, int ld, const float* __restrict__ gain, bf16_t* __restrict__ dst, int K, int k0, int n0, bool remap) {
    const int tid = tidx(), nn = tid & 63, kk0 = tid >> 6;
    const int sc = remap ? win_colmap(n0 + nn) : n0 + nn;
#pragma unroll
    for (int i = 0; i < 8; ++i) { const int k = kk0 + i * 8; float v = 0.f; if (sc >= 0) { v = src[(size_t)(k0 + k) * ld + sc]; if (gain) v *= gain[k0 + k]; } tl[k * 65 + nn] = v; }
    bar();
    const int n = tid >> 3, ks = (tid & 7) * 8;
    u32x4 w; w.x = cvt_pk_bf16(tl[(ks + 0) * 65 + n], tl[(ks + 1) * 65 + n]); w.y = cvt_pk_bf16(tl[(ks + 2) * 65 + n], tl[(ks + 3) * 65 + n]);
    w.z = cvt_pk_bf16(tl[(ks + 4) * 65 + n], tl[(ks + 5) * 65 + n]); w.w = cvt_pk_bf16(tl[(ks + 6) * 65 + n], tl[(ks + 7) * 65 + n]);
    *(u32x4*)(dst + (size_t)(n0 + n) * K + k0 + ks) = w;
    bar();
}

__device__ __forceinline__ void phase_prep(KA a, LAS unsigned char* lds) {
    const int tid = tidx(), nW = gridDim.x, wg = blockIdx.x;
    LAS float* tl = (LAS float*)lds;
    unsigned char* ws = a->ws;
    {
        const float* src = a->in[I_WIN]; const float* gain = a->in[I_NMIX]; bf16_t* dst = (bf16_t*)(ws + W_WIN);
        const int nn = tid & 63, kk0 = tid >> 6;
        float v[8];
#define WIN_LOAD(t_) do { const int k0_ = ((t_) & 15) * 64, n0_ = ((t_) >> 4) * 64; const int sc_ = win_colmap(n0_ + nn); \
            _Pragma("unroll") for (int i = 0; i < 8; ++i) { const int k = kk0 + i * 8; v[i] = 0.f; if (sc_ >= 0) v[i] = src[(size_t)(k0_ + k) * 11552 + sc_] * gain[k0_ + k]; } } while (0)
        if (wg < 2944) WIN_LOAD(wg);
        for (int t = wg; t < 2944; t += nW) {
            const int k0 = (t & 15) * 64, n0 = (t >> 4) * 64;
#pragma unroll
            for (int i = 0; i < 8; ++i) tl[(kk0 + i * 8) * 65 + nn] = v[i];
            if (t + nW < 2944) WIN_LOAD(t + nW);
            bar_lds();
            const int n = tid >> 3, ks = (tid & 7) * 8;
            u32x4 w; w.x = cvt_pk_bf16(tl[(ks + 0) * 65 + n], tl[(ks + 1) * 65 + n]); w.y = cvt_pk_bf16(tl[(ks + 2) * 65 + n], tl[(ks + 3) * 65 + n]);
            w.z = cvt_pk_bf16(tl[(ks + 4) * 65 + n], tl[(ks + 5) * 65 + n]); w.w = cvt_pk_bf16(tl[(ks + 6) * 65 + n], tl[(ks + 7) * 65 + n]);
            *(u32x4*)(dst + (size_t)(n0 + n) * 1024 + k0 + ks) = w;
            bar_lds();
        }
    }
    const size_t gt = (size_t)wg * 512 + tid, gs = (size_t)nW * 512;
    {
        bf16_t* kd = (bf16_t*)(ws + W_K12);
        for (size_t i = gt; i < (size_t)2 * 131072; i += gs) {
            const int half = (int)(i >= 131072), j = (int)(i - (size_t)half * 131072), h = j >> 14, nd = j & 16383;
            kd[((size_t)(h * 2 + half) << 14) + nd] = f2bf(half ? a->in[I_K2][j] : a->in[I_K1][j]);
        }
        u32x2* pb = (u32x2*)(ws + W_PB);
        for (size_t i = gt; i < (size_t)TP * 64; i += gs) {
            const size_t row = i >> 6; f32x4 v = {0.f, 0.f, 0.f, 0.f};
            if (row < (size_t)NPR) v = ((const f32x4*)a->in[I_PP])[i]; else if (row < (size_t)T) v = ((const f32x4*)a->in[I_PS])[i - (size_t)NPR * 64];
            u32x2 o; o.x = cvt_pk_bf16(v[0], v[1]); o.y = cvt_pk_bf16(v[2], v[3]); pb[i] = o;
        }
        float* ss = (float*)(ws + W_SS);
        for (size_t i = gt; i < (size_t)3 * TP; i += gs) ss[TP + i] = 0.f;
        float* ssq = (float*)(ws + W_SSQ);
        for (size_t i = gt; i < (size_t)TP * 8; i += gs) ssq[i] = 0.f;
    }
    {
        const int lane = tid & 63, wv = wg * 8 + (tid >> 6), nwv = nW * 8;
        u32x2* xb = (u32x2*)(ws + W_XB); float* ss0 = (float*)(ws + W_SS);
        for (int row = wv; row < TP; row += nwv) {
            const f32x4* src = row < NPR ? (const f32x4*)(a->in[I_XP] + (size_t)row * 1024) : (const f32x4*)(a->in[I_XS] + (size_t)(row - NPR) * 1024);
            float s = 0.f; f32x4 v[4];
#pragma unroll
            for (int i = 0; i < 4; ++i) {
                v[i] = (f32x4){0.f, 0.f, 0.f, 0.f}; if (row < T) v[i] = src[i * 64 + lane];
                s += v[i][0] * v[i][0] + v[i][1] * v[i][1] + v[i][2] * v[i][2] + v[i][3] * v[i][3];
            }
            s = red64(s);
            const float rs = rsqrtf(s * (1.0f / 1024.0f) + EPS);
#pragma unroll
            for (int i = 0; i < 4; ++i) { u32x2 o; o.x = cvt_pk_bf16(v[i][0] * rs, v[i][1] * rs); o.y = cvt_pk_bf16(v[i][2] * rs, v[i][3] * rs); xb[(size_t)row * 256 + i * 64 + lane] = o; }
            if (lane == 0) ss0[row] = s;
        }
    }
}

typedef const f32x4 (&AccRef)[2][2][4][2];
struct EpiU {
    static constexpr bool PERM = true, AFTER_DRAIN = false;
    bf16_t *Z, *XBC, *RW, *G; float* DT; const float* ss0;
    __device__ __forceinline__ void operator()(AccRef acc, const pg8::Unit& u, int wr, int wc, int fr, int fq) const {
        const int row0 = u.pm * 256 + wr * 64 + fr, pn = u.pn;
        bf16_t* base; int ld, colt, kind;
        if (pn < 8) { base = Z; ld = 2048; colt = pn * 256; kind = 0; }
        else if (pn < 24) { base = XBC; ld = 4096; colt = (pn - 8) * 256; kind = 1; }
        else if (pn < 37) { base = RW; ld = 3328; colt = (pn - 24) * 256; kind = 1; }
        else if (pn < 45) { base = G; ld = 2048; colt = (pn - 37) * 256; kind = 2; }
        else { base = nullptr; ld = 0; colt = 0; kind = 3; }
        const int col0 = colt + wc * 32 + 8 * fq;
#pragma unroll
        for (int ai = 0; ai < 2; ++ai)
#pragma unroll
            for (int m = 0; m < 4; ++m) {
                const int row = row0 + ai * 128 + m * 16;
                const float rs = 1.0f;
                if (kind == 3) {
                    if (wc == 0) { const f32x4 v0 = acc[ai][0][m][0] * rs, v1 = acc[ai][0][m][1] * rs; *(f32x4*)(DT + (size_t)row * 32 + 8 * fq) = v0; *(f32x4*)(DT + (size_t)row * 32 + 8 * fq + 4) = v1; }
                } else if (kind != 0 || row < T) {
#pragma unroll
                    for (int bj = 0; bj < 2; ++bj) {
                        f32x4 v0 = acc[ai][bj][m][0] * rs, v1 = acc[ai][bj][m][1] * rs;
                        if (kind == 2) {
#pragma unroll
                            for (int j = 0; j < 4; ++j) { v0[j] = sigm(v0[j]); v1[j] = sigm(v1[j]); } }
                        u32x4 w; w.x = cvt_pk_bf16(v0[0], v0[1]); w.y = cvt_pk_bf16(v0[2], v0[3]); w.z = cvt_pk_bf16(v1[0], v1[1]); w.w = cvt_pk_bf16(v1[2], v1[3]);
                        *(u32x4*)(base + (size_t)row * ld + col0 + bj * 128) = w;
                    }
                }
            }
    }
};
struct EpiQ {
    static constexpr bool PERM = true, AFTER_DRAIN = false;
    bf16_t* O; int ld; const float* ss;
    static constexpr bool HAS_SS = false;
    __device__ __forceinline__ float* ssp() const { return nullptr; }
    __device__ __forceinline__ float elem(int row, int c, float v) const { O[(size_t)row * ld + c] = f2bf(v * rsqrtf(ss[row] * (1.0f / 1024.0f) + EPS)); return 0.f; }
    __device__ __forceinline__ void operator()(AccRef acc, const pg8::Unit& u, int wr, int wc, int fr, int fq) const {
        const int row0 = u.pm * 256 + wr * 64 + fr, col0 = u.pn * 256 + wc * 32 + 8 * fq;
        float rsv[8];
#pragma unroll
        for (int i = 0; i < 8; ++i) rsv[i] = ss[row0 + (i >> 2) * 128 + (i & 3) * 16];
#pragma unroll
        for (int i = 0; i < 8; ++i) rsv[i] = rsqrtf(rsv[i] * (1.0f / 1024.0f) + EPS);
#pragma unroll
        for (int ai = 0; ai < 2; ++ai)
#pragma unroll
            for (int m = 0; m < 4; ++m) {
                const int row = row0 + ai * 128 + m * 16; const float rs = rsv[ai * 4 + m];
#pragma unroll
                for (int bj = 0; bj < 2; ++bj) {
                    const f32x4 v0 = acc[ai][bj][m][0] * rs, v1 = acc[ai][bj][m][1] * rs;
                    u32x4 w; w.x = cvt_pk_bf16(v0[0], v0[1]); w.y = cvt_pk_bf16(v0[2], v0[3]); w.z = cvt_pk_bf16(v1[0], v1[1]); w.w = cvt_pk_bf16(v1[2], v1[3]);
                    *(u32x4*)(O + (size_t)row * ld + col0 + bj * 128) = w;
                }
            }
    }
};
template <int MODE> struct EpiMix {
    static constexpr bool PERM = false, AFTER_DRAIN = false;
    float* P; bf16_t* V; const bf16_t* G; int goff;
    static constexpr bool HAS_SS = false;
    __device__ __forceinline__ float* ssp() const { return nullptr; }
    __device__ __forceinline__ float elem(int row, int c, float v) const {
        if (MODE != 2) v *= bf2f(G[(size_t)row * 2048 + goff + c]);
        if (MODE == 1) V[(size_t)row * 1024 + c] = f2bf(v + P[(size_t)row * 1024 + c]); else P[(size_t)row * 1024 + c] = v;
        return 0.f; }
    __device__ __forceinline__ void operator()(AccRef acc, const pg8::Unit& u, int wr, int wc, int fr, int fq) const {
        const int row0 = u.pm * 256 + wr * 64 + fr, col0 = u.pn * 256 + wc * 32 + 4 * fq;
#pragma unroll
        for (int ai = 0; ai < 2; ++ai)
#pragma unroll
            for (int mp = 0; mp < 2; ++mp) {
                u32x2 gw[2][4]; f32x4 pv[2][4];
#pragma unroll
                for (int mm = 0; mm < 2; ++mm) { const int row = row0 + ai * 128 + (mp * 2 + mm) * 16;
#pragma unroll
                    for (int f = 0; f < 4; ++f) { const int c = col0 + (f >> 1) * 128 + (f & 1) * 16;
                        if (MODE != 2) gw[mm][f] = *(const u32x2*)(G + (size_t)row * 2048 + goff + c);
                        if (MODE == 1) pv[mm][f] = *(const f32x4*)(P + (size_t)row * 1024 + c); } }
#pragma unroll
                for (int mm = 0; mm < 2; ++mm) { const int m = mp * 2 + mm, row = row0 + ai * 128 + m * 16;
#pragma unroll
                    for (int f = 0; f < 4; ++f) { const int bj = f >> 1, n = f & 1, c = col0 + bj * 128 + n * 16; f32x4 v = acc[ai][bj][m][n];
                        if (MODE != 2) { v[0] *= bflo(gw[mm][f].x); v[1] *= bfhi(gw[mm][f].x); v[2] *= bflo(gw[mm][f].y); v[3] *= bfhi(gw[mm][f].y); }
                        if (MODE == 1) { v = v + pv[mm][f]; u32x2 o; o.x = cvt_pk_bf16(v[0], v[1]); o.y = cvt_pk_bf16(v[2], v[3]); *(u32x2*)(V + (size_t)row * 1024 + c) = o; }
                        else *(f32x4*)(P + (size_t)row * 1024 + c) = v; } }
                asm volatile("" ::: "memory");
            }
    }
};
template <int MODE> struct EpiRes {
    static constexpr bool PERM = false, AFTER_DRAIN = false;
    const float* xp; const float* xs; float* X; bf16_t* XB; float* ss; const float* ssin; const float* P;
    static constexpr bool HAS_SS = true;
    __device__ __forceinline__ float* ssp() const { return ss; }
    __device__ __forceinline__ float elem(int row, int c, float v) const {
        if (MODE == 0) v += xs[(size_t)(row - NPR) * 1024 + c];
        else v = xp[(size_t)row * 1024 + c] + sigm(v * rsqrtf(ssin[row] * (1.0f / 1024.0f) + EPS)) * P[(size_t)row * 1024 + c];
        X[(size_t)row * 1024 + c] = v; if (MODE == 0) XB[(size_t)row * 1024 + c] = f2bf(v);
        return v; }
    __device__ __forceinline__ void operator()(AccRef acc, const pg8::Unit& u, int wr, int wc, int fr, int fq) const {
        const int row0 = u.pm * 256 + wr * 64 + fr, col0 = u.pn * 256 + wc * 32 + 4 * fq;
#pragma unroll
        for (int ai = 0; ai < 2; ++ai)
#pragma unroll
            for (int mp = 0; mp < 2; ++mp) {
                f32x4 xin[2][4], pv[2][4]; float rsr[2];
#pragma unroll
                for (int mm = 0; mm < 2; ++mm) { const int row = row0 + ai * 128 + (mp * 2 + mm) * 16, rowc = row < T ? row : 0;
                    const float* src = MODE == 0 ? (rowc < NPR ? xp + (size_t)rowc * 1024 : xs + (size_t)(rowc - NPR) * 1024) : xp + (size_t)rowc * 1024;
                    rsr[mm] = MODE == 1 ? ssin[rowc] : 0.f;
#pragma unroll
                    for (int f = 0; f < 4; ++f) { const int c = col0 + (f >> 1) * 128 + (f & 1) * 16; xin[mm][f] = *(const f32x4*)(src + c); if (MODE == 1) pv[mm][f] = *(const f32x4*)(P + (size_t)rowc * 1024 + c); } }
#pragma unroll
                for (int mm = 0; mm < 2; ++mm) { const int m = mp * 2 + mm, row = row0 + ai * 128 + m * 16;
                    const float rs = MODE == 1 ? rsqrtf(rsr[mm] * (1.0f / 1024.0f) + EPS) : 0.f; float sq = 0.f;
#pragma unroll
                    for (int f = 0; f < 4; ++f) { const int bj = f >> 1, n = f & 1, c = col0 + bj * 128 + n * 16; f32x4 v = acc[ai][bj][m][n];
                        if (MODE == 1) {
#pragma unroll
                            for (int j = 0; j < 4; ++j) v[j] = sigm(v[j] * rs) * pv[mm][f][j]; }
                        v = v + xin[mm][f];
                        if (row < T) { *(f32x4*)(X + (size_t)row * 1024 + c) = v;
                            if (MODE == 0) { u32x2 o; o.x = cvt_pk_bf16(v[0], v[1]); o.y = cvt_pk_bf16(v[2], v[3]); *(u32x2*)(XB + (size_t)row * 1024 + c) = o; } }
                        sq += v[0] * v[0] + v[1] * v[1] + v[2] * v[2] + v[3] * v[3]; }
                    sq += __shfl_xor(sq, 16); sq += __shfl_xor(sq, 32);
                    if (fq == 0 && row < T) atomicAdd(ss + row, sq); }
                asm volatile("" ::: "memory");
            }
    }
};
template <class Epi> __device__ __forceinline__ void sample_gemm(const bf16_t* A, int lda, const bf16_t* Bt, int ldb, int N, int K, const Epi& E) {
    const int tid = tidx(), lane = tid & 63, wid = tid >> 6, quad = lane >> 4, l16 = lane & 15;
    for (int sl = blockIdx.x; sl < N / 16; sl += gridDim.x) {
        const bf16_t* ap = A + (size_t)(NPR + wid * 16 + l16) * lda + quad * 8; const bf16_t* bp = Bt + (size_t)(sl * 16 + l16) * ldb + quad * 8;
        f32x4 acc = {0.f, 0.f, 0.f, 0.f};
#pragma unroll 8
        for (int kk = 0; kk < K / 32; ++kk) acc = mfma16(*(const bf16x8*)(ap + kk * 32), *(const bf16x8*)(bp + kk * 32), acc);
#pragma unroll
        for (int j = 0; j < 4; ++j) { const int row = NPR + wid * 16 + quad * 4 + j; const float r = E.elem(row, sl * 16 + l16, acc[j]);
            if (Epi::HAS_SS) { const float sq = red16(r * r); if (l16 == 0) atomicAdd(E.ssp() + row, sq); } }
    }
}
template <class Epi, bool split_samples = true> __device__ __forceinline__ void run_gemm(LAS unsigned char* lds, const bf16_t* A, int lda, const bf16_t* Bt, int ldb, int N, int K, const Epi& E) {
    pg8::Gemm g; g.A = A; g.Bt = Bt; g.M = split_samples ? NPR : TP; g.N = N; g.K = K; g.lda = lda; g.ldb = ldb;
    pg8::StaticOrder S; S.init(g.M, N, gridDim.x, blockIdx.x);
    pg8::gemm_phase<Epi, pg8::StaticOrder>(lds, g, S, E);
    if constexpr (split_samples) sample_gemm(A, lda, Bt, ldb, N, K, E);
}

__device__ __forceinline__ void rwkv_prompt_item(KA a, LAS unsigned char* lds, int b, int h) {
    const int item_ = b * 16 + h;
    const int tid = tidx(), lane = tid & 63, wid = tid >> 6, quad = lane >> 4, l16 = lane & 15;
    LAS bf16_t* WdT = (LAS bf16_t*)(lds);
    LAS bf16_t* WaT = (LAS bf16_t*)(lds + 9216);
    LAS bf16_t* WgT = (LAS bf16_t*)(lds + 18432);
    LAS bf16_t* AL = (LAS bf16_t*)(lds + 35840);
    LAS float* RAW = (LAS float*)(lds + 52736);
    LAS float* sR = (LAS float*)(lds + 78080);
    LAS float* sW = sR + 2048; LAS float* sK = sW + 2048; LAS float* sV = sK + 2048; LAS float* sA = sV + 2048; LAS float* sB = sA + 2048; LAS float* sG = sB + 2048; LAS float* sY = sG + 2048;
    LAS float* sBon = sY + 2048;
    bf16_t* RW = (bf16_t*)(a->ws + W_RW);
    const float* mu = a->in[I_MU];
    for (int i = tid; i < 4096; i += 512) { const int k = i >> 6, n = i & 63; WdT[n * 72 + k] = f2bf(a->in[I_W2][k * 1024 + h * 64 + n]); WaT[n * 72 + k] = f2bf(a->in[I_A2][k * 1024 + h * 64 + n]); }
    for (int i = tid; i < 8192; i += 512) { const int k = i >> 6, n = i & 63; WgT[n * 136 + k] = f2bf(a->in[I_G2][k * 1024 + h * 64 + n]); }
    if (tid < 192) RAW[tid] = 0.f;
    const int et = tid >> 4, j0 = (tid & 15) * 4;
    LAS float* CT = sBon + 32;
    if (tid < 64) { const int c = h * 64 + tid; CT[tid] = mu[c]; CT[64 + tid] = mu[1024 + c]; CT[128 + tid] = mu[2048 + c]; CT[192 + tid] = a->in[I_W0][c]; CT[256 + tid] = a->in[I_A0][c];
        CT[320 + tid] = a->in[I_KK][c]; CT[384 + tid] = a->in[I_KA][c]; CT[448 + tid] = a->in[I_RK][c]; CT[512 + tid] = a->in[I_LNG][c]; CT[576 + tid] = a->in[I_LNB][c]; }
    else if (tid >= 256) CT[640 + tid - 256] = mu[3072 + tid - 256];
    const int li0 = (tid & 15) * 16;
    const int srow = (wid & 3) * 16 + (lane >> 3) * 2, c0 = (lane & 7) * 8;
    f32x2 S[4], S1[4];
#pragma unroll
    for (int i = 0; i < 4; ++i) { S[i] = (f32x2){0.f, 0.f}; S1[i] = (f32x2){0.f, 0.f}; }
    bar();
    u32x2 pr[3]; u32x4 cA, cB, pA, pB;
#define RWKV_PREFETCH(chn) do { const size_t nb_ = (size_t)b * 2048 + (chn) * 32; \
        _Pragma("unroll") for (int ii = 0; ii < 3; ++ii) { const int i = tid + ii * 512, t = i / 48, rem = i - t * 48, part = rem >> 4, jj = (rem & 15) * 4; pr[ii] = *(const u32x2*)(RW + (nb_ + t) * 3328 + part * 1024 + h * 64 + jj); } \
        const bf16_t* cp = RW + (nb_ + et) * 3328 + 3072 + li0; cA = *(const u32x4*)cp; cB = *(const u32x4*)(cp + 8); \
        pA = (u32x4){0u, 0u, 0u, 0u}; pB = pA; if ((chn) > 0 || et > 0) { pA = *(const u32x4*)(cp - 3328); pB = *(const u32x4*)(cp - 3328 + 8); } } while (0)
    RWKV_PREFETCH(0);
#pragma unroll 1
    for (int ch = 0; ch < 64; ++ch) {
        const size_t base = (size_t)b * 2048 + ch * 32;
#pragma unroll
        for (int ii = 0; ii < 3; ++ii) {
            const int i = tid + ii * 512, t = i / 48, rem = i - t * 48, part = rem >> 4, jj = (rem & 15) * 4;
            const u32x2 w = pr[ii];
            *(LAS f32x4*)(RAW + (t + 1) * 192 + part * 64 + jj) = (f32x4){bflo(w.x), bfhi(w.x), bflo(w.y), bfhi(w.y)};
        }
        {
            float o[16];
#pragma unroll
            for (int q = 0; q < 8; ++q) {
                const unsigned cw = q < 4 ? cA[q] : cB[q - 4], pw = q < 4 ? pA[q] : pB[q - 4];
                const float m0 = CT[640 + li0 + 2 * q], m1 = CT[640 + li0 + 2 * q + 1];
                const float x0 = bflo(cw), x1 = bfhi(cw);
                o[2 * q] = x0 + (bflo(pw) - x0) * m0; o[2 * q + 1] = x1 + (bfhi(pw) - x1) * m1;
            }
            if (li0 < 64) {
#pragma unroll
                for (int q = 0; q < 16; ++q) o[q] = tanh_fast(o[q]); }
            else if (li0 >= 128) {
#pragma unroll
                for (int q = 0; q < 16; ++q) o[q] = sigm(o[q]); }
            u32x4 w0, w1;
            w0.x = cvt_pk_bf16(o[0], o[1]); w0.y = cvt_pk_bf16(o[2], o[3]); w0.z = cvt_pk_bf16(o[4], o[5]); w0.w = cvt_pk_bf16(o[6], o[7]);
            w1.x = cvt_pk_bf16(o[8], o[9]); w1.y = cvt_pk_bf16(o[10], o[11]); w1.z = cvt_pk_bf16(o[12], o[13]); w1.w = cvt_pk_bf16(o[14], o[15]);
            *(LAS u32x4*)(AL + et * 264 + li0) = w0; *(LAS u32x4*)(AL + et * 264 + li0 + 8) = w1;
        }
        bar_lds();
        {
            const int rb = wid >> 2, cb = wid & 3;
            const LAS bf16_t* ar = AL + (rb * 16 + l16) * 264 + quad * 8;
            f32x4 lw = {0.f, 0.f, 0.f, 0.f}, la = lw, lg = lw;
#pragma unroll
            for (int kk = 0; kk < 2; ++kk) {
                lw = mfma16(*(const LAS bf16x8*)(ar + kk * 32), *(const LAS bf16x8*)(WdT + (cb * 16 + l16) * 72 + kk * 32 + quad * 8), lw);
                la = mfma16(*(const LAS bf16x8*)(ar + 64 + kk * 32), *(const LAS bf16x8*)(WaT + (cb * 16 + l16) * 72 + kk * 32 + quad * 8), la);
            }
#pragma unroll
            for (int kk = 0; kk < 4; ++kk) lg = mfma16(*(const LAS bf16x8*)(ar + 128 + kk * 32), *(const LAS bf16x8*)(WgT + (cb * 16 + l16) * 136 + kk * 32 + quad * 8), lg);
#pragma unroll
            for (int j = 0; j < 4; ++j) { const int o = (rb * 16 + quad * 4 + j) * 64 + cb * 16 + l16; sW[o] = lw[j]; sA[o] = la[j]; sG[o] = lg[j]; }
        }
        bar_lds();
        {
            float kkf[4], al[4]; float ssk = 0.f, bon = 0.f;
            const f32x4 c_mur = *(const LAS f32x4*)(CT + j0), c_muk = *(const LAS f32x4*)(CT + 64 + j0), c_muv = *(const LAS f32x4*)(CT + 128 + j0), c_w0 = *(const LAS f32x4*)(CT + 192 + j0),
                        c_a0 = *(const LAS f32x4*)(CT + 256 + j0), c_kk = *(const LAS f32x4*)(CT + 320 + j0), c_ka = *(const LAS f32x4*)(CT + 384 + j0), c_rk = *(const LAS f32x4*)(CT + 448 + j0);
            const int ob = et * 64 + j0;
            const f32x4 rc4 = *(const LAS f32x4*)(RAW + (et + 1) * 192 + j0), rp4 = *(const LAS f32x4*)(RAW + et * 192 + j0), kc4 = *(const LAS f32x4*)(RAW + (et + 1) * 192 + 64 + j0), kp4 = *(const LAS f32x4*)(RAW + et * 192 + 64 + j0),
                        vc4 = *(const LAS f32x4*)(RAW + (et + 1) * 192 + 128 + j0), vp4 = *(const LAS f32x4*)(RAW + et * 192 + 128 + j0), lw4 = *(const LAS f32x4*)(sW + ob), la4 = *(const LAS f32x4*)(sA + ob);
            f32x4 r4, d4, k4, v4, a4, b4;
#pragma unroll
            for (int q = 0; q < 4; ++q) {
                const float r = rc4[q] + (rp4[q] - rc4[q]) * c_mur[q], k = kc4[q] + (kp4[q] - kc4[q]) * c_muk[q], v = vc4[q] + (vp4[q] - vc4[q]) * c_muv[q];
                const float dec = __expf(-0.60653066f * sigm(c_w0[q] + lw4[q]));
                al[q] = sigm(c_a0[q] + la4[q]);
                kkf[q] = k * c_kk[q]; ssk += kkf[q] * kkf[q];
                const float kn = k * (1.0f + (al[q] - 1.0f) * c_ka[q]); bon += r * kn * c_rk[q];
                r4[q] = r; d4[q] = dec; k4[q] = kn; v4[q] = v;
            }
            ssk = red16(ssk); bon = red16(bon);
            const float inv = rsqrtf(ssk + 1e-12f);
#pragma unroll
            for (int q = 0; q < 4; ++q) { const float kk = kkf[q] * inv; a4[q] = -kk; b4[q] = kk * al[q]; }
            *(LAS f32x4*)(sR + ob) = r4; *(LAS f32x4*)(sW + ob) = d4; *(LAS f32x4*)(sK + ob) = k4; *(LAS f32x4*)(sV + ob) = v4; *(LAS f32x4*)(sA + ob) = a4; *(LAS f32x4*)(sB + ob) = b4;
            if ((tid & 15) == 0) sBon[et] = bon;
        }
        bar_lds();
        if (ch < 63) RWKV_PREFETCH(ch + 1);
        if (wid < 4) {
            const LAS float* sp = sR + c0;
            f32x4 nr0 = *(const LAS f32x4*)(sp), nr1 = *(const LAS f32x4*)(sp + 4), nw0 = *(const LAS f32x4*)(sp + 2048), nw1 = *(const LAS f32x4*)(sp + 2048 + 4);
            f32x4 nk0 = *(const LAS f32x4*)(sp + 4096), nk1 = *(const LAS f32x4*)(sp + 4096 + 4), na0 = *(const LAS f32x4*)(sp + 8192), na1 = *(const LAS f32x4*)(sp + 8192 + 4);
            f32x4 nb0 = *(const LAS f32x4*)(sp + 10240), nb1 = *(const LAS f32x4*)(sp + 10240 + 4); f32x2 nv = *(const LAS f32x2*)(sV + srow);
#pragma unroll 2
            for (int t = 0; t < 32; ++t) {
                const f32x4 r0 = nr0, r1 = nr1, w0 = nw0, w1 = nw1, k0 = nk0, k1 = nk1, a0 = na0, a1 = na1, b0 = nb0, b1 = nb1; const f32x2 v2 = nv;
                {
                    const int tn = t < 31 ? t + 1 : 31; const LAS float* sn = sR + tn * 64 + c0;
                    nr0 = *(const LAS f32x4*)(sn); nr1 = *(const LAS f32x4*)(sn + 4); nw0 = *(const LAS f32x4*)(sn + 2048); nw1 = *(const LAS f32x4*)(sn + 2048 + 4);
                    nk0 = *(const LAS f32x4*)(sn + 4096); nk1 = *(const LAS f32x4*)(sn + 4096 + 4); na0 = *(const LAS f32x4*)(sn + 8192); na1 = *(const LAS f32x4*)(sn + 8192 + 4);
                    nb0 = *(const LAS f32x4*)(sn + 10240); nb1 = *(const LAS f32x4*)(sn + 10240 + 4); nv = *(const LAS f32x2*)(sV + tn * 64 + srow);
                }
                const f32x2 av[4] = {{a0[0], a0[1]}, {a0[2], a0[3]}, {a1[0], a1[1]}, {a1[2], a1[3]}}, bv[4] = {{b0[0], b0[1]}, {b0[2], b0[3]}, {b1[0], b1[1]}, {b1[2], b1[3]}};
                const f32x2 wv[4] = {{w0[0], w0[1]}, {w0[2], w0[3]}, {w1[0], w1[1]}, {w1[2], w1[3]}}, kv[4] = {{k0[0], k0[1]}, {k0[2], k0[3]}, {k1[0], k1[1]}, {k1[2], k1[3]}};
                const f32x2 rv[4] = {{r0[0], r0[1]}, {r0[2], r0[3]}, {r1[0], r1[1]}, {r1[2], r1[3]}};
                f32x2 p = S[0] * av[0]; p = S[1] * av[1] + p; p = S[2] * av[2] + p; p = S[3] * av[3] + p;
                f32x2 p1 = S1[0] * av[0]; p1 = S1[1] * av[1] + p1; p1 = S1[2] * av[2] + p1; p1 = S1[3] * av[3] + p1;
                const float sa = red8(p.x + p.y), sa1 = red8(p1.x + p1.y);
                const f32x2 vv = {v2.x, v2.x}, sav = {sa, sa}, vv1 = {v2.y, v2.y}, sav1 = {sa1, sa1};
#pragma unroll
                for (int i = 0; i < 4; ++i) { const f32x2 u = S[i] * wv[i] + vv * kv[i]; S[i] = sav * bv[i] + u; const f32x2 u1 = S1[i] * wv[i] + vv1 * kv[i]; S1[i] = sav1 * bv[i] + u1; }
                f32x2 y2 = S[0] * rv[0]; y2 = S[1] * rv[1] + y2; y2 = S[2] * rv[2] + y2; y2 = S[3] * rv[3] + y2;
                f32x2 y3 = S1[0] * rv[0]; y3 = S1[1] * rv[1] + y3; y3 = S1[2] * rv[2] + y3; y3 = S1[3] * rv[3] + y3;
                const float y = red8(y2.x + y2.y), y1 = red8(y3.x + y3.y);
                if ((lane & 7) == 0) *(LAS f32x2*)(sY + t * 64 + srow) = (f32x2){y, y1};
            }
        } else {
            const int slot_ = (item_ * 4 + (wid - 4)) * 64 + ch;
            peer_quant_row(a, slot_);
            if (slot_ < N_LATE_JOBS) late_transpose_job(a, slot_);
        }
        bar_lds();
        {
            const int ob = et * 64 + j0;
            const f32x4 y4 = *(const LAS f32x4*)(sY + ob), v4 = *(const LAS f32x4*)(sV + ob), g4 = *(const LAS f32x4*)(sG + ob);
            float y[4]; float s = 0.f;
#pragma unroll
            for (int q = 0; q < 4; ++q) { y[q] = y4[q]; s += y[q]; }
            const float mean = red16(s) * (1.0f / 64.0f); float vs = 0.f;
#pragma unroll
            for (int q = 0; q < 4; ++q) { y[q] -= mean; vs += y[q] * y[q]; }
            const float inv = rsqrtf(red16(vs) * (1.0f / 64.0f) + 64e-5f), bon = sBon[et];
            const f32x4 c_lg = *(const LAS f32x4*)(CT + 512 + j0), c_lb = *(const LAS f32x4*)(CT + 576 + j0);
            float o[4];
#pragma unroll
            for (int q = 0; q < 4; ++q) o[q] = ((y[q] * inv * c_lg[q] + c_lb[q]) + bon * v4[q]) * g4[q];
            u32x2 w; w.x = cvt_pk_bf16(o[0], o[1]); w.y = cvt_pk_bf16(o[2], o[3]);
            *(u32x2*)(RW + (base + et) * 3328 + h * 64 + j0) = w;
            if (tid < 192) RAW[tid] = RAW[32 * 192 + tid];
        }
        bar_lds();
    }
    {
        if (wid < 4) {
            float* ws_ = a->out + O_WKVP + ((size_t)(b * 16 + h) * 64 + srow) * 64 + c0;
            *(f32x4*)ws_ = (f32x4){S[0].x, S[0].y, S[1].x, S[1].y}; *(f32x4*)(ws_ + 4) = (f32x4){S[2].x, S[2].y, S[3].x, S[3].y};
            *(f32x4*)(ws_ + 64) = (f32x4){S1[0].x, S1[0].y, S1[1].x, S1[1].y}; *(f32x4*)(ws_ + 68) = (f32x4){S1[2].x, S1[2].y, S1[3].x, S1[3].y};
        }
        if (tid < 192) a->out[O_SHIFTP + (size_t)b * 3328 + (tid >> 6) * 1024 + h * 64 + (tid & 63)] = RAW[tid];
        if (h == 0 && tid < 256) a->out[O_SHIFTP + (size_t)b * 3328 + 3072 + tid] = bf2f(RW[((size_t)b * 2048 + 2047) * 3328 + 3072 + tid]);
    }
    bar();
}

__device__ __forceinline__ void rwkv_sample_wave(KA a, LAS float* wl, int b, int h) {
    const int lane = tidx() & 63, c = h * 64 + lane;
    bf16_t* RW = (bf16_t*)(a->ws + W_RW);
    const float* mu = a->in[I_MU]; const float* prevs = a->in[I_SSHIFT] + (size_t)b * 3328;
    const size_t row = (size_t)NPR + b;
    {
        const int i0 = lane * 4;
        const u32x2 cw = *(const u32x2*)(RW + row * 3328 + 3072 + i0); const f32x4 pv = *(const f32x4*)(prevs + 3072 + i0), mv = *(const f32x4*)(mu + 3072 + i0);
        f32x4 cur = {bflo(cw.x), bfhi(cw.x), bflo(cw.y), bfhi(cw.y)}, xs = cur + (pv - cur) * mv, o;
#pragma unroll
        for (int q = 0; q < 4; ++q) o[q] = lane < 16 ? tanh_fast(xs[q]) : (lane < 32 ? xs[q] : sigm(xs[q]));
        *(LAS f32x4*)(wl + i0) = o;
        if (h == 0) *(f32x4*)(a->out + O_SHIFTS + (size_t)b * 3328 + 3072 + i0) = cur;
    }
    float rr, kk_, vv;
    {
        const float rc = bf2f(RW[row * 3328 + c]), kc = bf2f(RW[row * 3328 + 1024 + c]), vc = bf2f(RW[row * 3328 + 2048 + c]);
        rr = rc + (prevs[c] - rc) * mu[c]; kk_ = kc + (prevs[1024 + c] - kc) * mu[1024 + c]; vv = vc + (prevs[2048 + c] - vc) * mu[2048 + c];
        float* so = a->out + O_SHIFTS + (size_t)b * 3328; so[c] = rc; so[1024 + c] = kc; so[2048 + c] = vc;
    }
    float lw = 0.f, la = 0.f, lg = 0.f;
    {
        const float* pw = a->in[I_W2] + c; const float* pa = a->in[I_A2] + c; const float* pg = a->in[I_G2] + c;
#pragma unroll 8
        for (int k = 0; k < 64; ++k) { lw += wl[k] * pw[0]; la += wl[64 + k] * pa[0]; pw += 1024; pa += 1024; }
        asm volatile("" ::: "memory");
#pragma unroll 16
        for (int k = 0; k < 128; ++k) { lg += wl[128 + k] * pg[0]; pg += 1024; }
        asm volatile("" ::: "memory");
    }
    const float dec = __expf(-0.60653066f * sigm(a->in[I_W0][c] + lw)), al = sigm(a->in[I_A0][c] + la);
    const float kkf = kk_ * a->in[I_KK][c], ssk = red64(kkf * kkf), kn = kk_ * (1.0f + (al - 1.0f) * a->in[I_KA][c]), bon = red64(rr * kn * a->in[I_RK][c]);
    const float kkn = kkf * rsqrtf(ssk + 1e-12f);
    LAS float* vw = wl + 256;
    vw[lane] = rr; vw[64 + lane] = dec; vw[128 + lane] = kn; vw[192 + lane] = -kkn; vw[256 + lane] = kkn * al;
    const size_t so = ((size_t)(b * 16 + h) * 64 + lane) * 64;
    float sa = 0.f;
#pragma unroll 8
    for (int q = 0; q < 16; ++q) { const f32x4 Sv = *(const f32x4*)(a->in[I_SWKV] + so + q * 4), av = *(const LAS f32x4*)(vw + 192 + q * 4); sa += Sv[0] * av[0] + Sv[1] * av[1] + Sv[2] * av[2] + Sv[3] * av[3]; }
    float y = 0.f;
#pragma unroll 8
    for (int q = 0; q < 16; ++q) {
        const f32x4 wv = *(const LAS f32x4*)(vw + 64 + q * 4), kv = *(const LAS f32x4*)(vw + 128 + q * 4), bv = *(const LAS f32x4*)(vw + 256 + q * 4), rv = *(const LAS f32x4*)(vw + q * 4);
        f32x4 Sv = *(const f32x4*)(a->in[I_SWKV] + so + q * 4);
        Sv = Sv * wv + kv * vv + bv * sa;
        y += Sv[0] * rv[0] + Sv[1] * rv[1] + Sv[2] * rv[2] + Sv[3] * rv[3];
        *(f32x4*)(a->out + O_WKVS + so + q * 4) = Sv;
    }
    const float mean = red64(y) * (1.0f / 64.0f), d = y - mean, var = red64(d * d) * (1.0f / 64.0f);
    const float o = ((d * rsqrtf(var + 64e-5f) * a->in[I_LNG][c] + a->in[I_LNB][c]) + bon * vv) * lg;
    RW[row * 3328 + c] = f2bf(o);
}

__device__ __forceinline__ float softplusf_(float x) { return x > 20.f ? x : log1pf(__expf(x)); }
__device__ __forceinline__ void ssd_prompt_item(KA a, LAS unsigned char* lds, int b, int hd) {
    const int tid = tidx(), lane = tid & 63, wid = tid >> 6, quad = lane >> 4, l16 = lane & 15, g = hd >> 2;
    LAS bf16_t* Cb = (LAS bf16_t*)(lds);
    LAS bf16_t* Bb = (LAS bf16_t*)(lds + 17408);
    LAS bf16_t* BT = (LAS bf16_t*)(lds + 34816);
    LAS bf16_t* XT = (LAS bf16_t*)(lds + 53248);
    LAS bf16_t* XTd = (LAS bf16_t*)(lds + 62464);
    LAS bf16_t* Mb = (LAS bf16_t*)(lds + 71680);
    LAS bf16_t* Hb = (LAS bf16_t*)(lds + 80896);
    LAS float* sdt = (LAS float*)(lds + 98304); LAS float* sac = sdt + 64; LAS float* seac = sac + 64; LAS float* sdd = seac + 64; LAS float* sdec = sdd + 64;
    const bf16_t* XBC = (const bf16_t*)(a->ws + W_XBC); const float* DT = (const float*)(a->ws + W_DT); bf16_t* Z = (bf16_t*)a->out; float* ssq = (float*)(a->ws + W_SSQ);
    const int cg_ = tid % 40, strip = tid / 40;
    int ccol, kind, loc;
    if (cg_ < 8) { kind = 0; loc = cg_ * 8; ccol = hd * 64 + loc; } else if (cg_ < 24) { kind = 1; loc = (cg_ - 8) * 8; ccol = 2048 + g * 128 + loc; } else { kind = 2; loc = (cg_ - 24) * 8; ccol = 3072 + g * 128 + loc; }
    LAS float* CW = sdec + 64;
    if (tid < 40) {
#pragma unroll
        for (int q = 0; q < 8; ++q) { CW[tid * 40 + 32 + q] = a->in[I_CONVB][ccol + q];
#pragma unroll
            for (int k = 0; k < 4; ++k) CW[tid * 40 + k * 8 + q] = a->in[I_CONVW][k * 4096 + ccol + q]; }
    }
    u32x4 rows[11]; float dtn = 0.f;
#define SSD_PREFETCH(chn) do { if (tid < 320) { _Pragma("unroll") for (int k = 0; k < 11; ++k) { const int tg = (chn) * 64 + strip * 8 - 3 + k; rows[k] = (u32x4){0u, 0u, 0u, 0u}; \
            if (tg >= 0) rows[k] = *(const u32x4*)(XBC + ((size_t)b * 2048 + tg) * 4096 + ccol); } } else if (wid == 7) dtn = DT[((size_t)b * 2048 + (chn) * 64 + lane) * 32 + hd]; } while (0)
    SSD_PREFETCH(0);
    bar();
    const float Ah = -__expf(a->in[I_ALOG][hd]), dtb = a->in[I_DTB][hd], dsk = a->in[I_DSKIP][hd];
    const int pt = wid >> 1, ntb = (wid & 1) * 4;
    f32x4 hacc[4];
#pragma unroll
    for (int i = 0; i < 4; ++i) hacc[i] = (f32x4){0.f, 0.f, 0.f, 0.f};
#pragma unroll 1
    for (int ch = 0; ch < 32; ++ch) {
        const size_t row0 = (size_t)b * 2048 + ch * 64;
        bf16_t zq[2][4];
#pragma unroll
        for (int tt = 0; tt < 2; ++tt) { const int tile = wid * 2 + tt, lt = tile >> 2, pc = tile & 3;
#pragma unroll
            for (int j = 0; j < 4; ++j) zq[tt][j] = Z[(row0 + lt * 16 + quad * 4 + j) * 2048 + hd * 64 + pc * 16 + l16]; }
        if (tid < 320) {
#pragma unroll
            for (int hq = 0; hq < 2; ++hq) {
                f32x2 cwp[4][2], cbp[2], xr[11][2];
                { const f32x4 t0 = *(const LAS f32x4*)(CW + cg_ * 40 + hq * 4), t1 = *(const LAS f32x4*)(CW + cg_ * 40 + 8 + hq * 4), t2 = *(const LAS f32x4*)(CW + cg_ * 40 + 16 + hq * 4),
                              t3 = *(const LAS f32x4*)(CW + cg_ * 40 + 24 + hq * 4), tb = *(const LAS f32x4*)(CW + cg_ * 40 + 32 + hq * 4);
                  cwp[0][0] = (f32x2){t0[0], t0[1]}; cwp[0][1] = (f32x2){t0[2], t0[3]}; cwp[1][0] = (f32x2){t1[0], t1[1]}; cwp[1][1] = (f32x2){t1[2], t1[3]};
                  cwp[2][0] = (f32x2){t2[0], t2[1]}; cwp[2][1] = (f32x2){t2[2], t2[3]}; cwp[3][0] = (f32x2){t3[0], t3[1]}; cwp[3][1] = (f32x2){t3[2], t3[3]};
                  cbp[0] = (f32x2){tb[0], tb[1]}; cbp[1] = (f32x2){tb[2], tb[3]}; }
#pragma unroll
                for (int k = 0; k < 11; ++k) { const unsigned wa_ = rows[k][2 * hq], wb_ = rows[k][2 * hq + 1]; xr[k][0] = (f32x2){bflo(wa_), bfhi(wa_)}; xr[k][1] = (f32x2){bflo(wb_), bfhi(wb_)}; }
                const int lc = loc + hq * 4;
                unsigned colpk[4][4];
#pragma unroll
                for (int rp = 0; rp < 4; ++rp) {
                    float o[2][4];
#pragma unroll
                    for (int rr = 0; rr < 2; ++rr) { const int r = rp * 2 + rr;
#pragma unroll
                        for (int pq = 0; pq < 2; ++pq) {
                            f32x2 v = cwp[0][pq] * xr[r][pq] + cbp[pq]; v = cwp[1][pq] * xr[r + 1][pq] + v; v = cwp[2][pq] * xr[r + 2][pq] + v; v = cwp[3][pq] * xr[r + 3][pq] + v;
                            o[rr][2 * pq] = v.x * sigm(v.x); o[rr][2 * pq + 1] = v.y * sigm(v.y); }
                        if (kind != 0) { const int s = strip * 8 + r;
                            u32x2 pk; pk.x = cvt_pk_bf16(o[rr][0], o[rr][1]); pk.y = cvt_pk_bf16(o[rr][2], o[rr][3]);
                            if (kind == 1) *(LAS u32x2*)(Bb + s * 136 + lc) = pk; else *(LAS u32x2*)(Cb + s * 136 + lc) = pk; } }
#pragma unroll
                    for (int q = 0; q < 4; ++q) colpk[q][rp] = cvt_pk_bf16(o[0][q], o[1][q]);
                }
                if (kind != 2) {
                    LAS bf16_t* TT = kind == 0 ? XT : BT;
#pragma unroll
                    for (int q = 0; q < 4; ++q) *(LAS u32x4*)(TT + (lc + q) * 72 + strip * 8) = (u32x4){colpk[q][0], colpk[q][1], colpk[q][2], colpk[q][3]};
                }
                asm volatile("" ::: "memory");
            }
        } else if (wid == 7) {
            const float dtv = softplusf_(dtn + dtb);
            float x = dtv * Ah;
#pragma unroll
            for (int off = 1; off < 64; off <<= 1) { const float t = __shfl_up(x, off); if (lane >= off) x += t; }
            const float last = __shfl(x, 63);
            sdt[lane] = dtv; sac[lane] = x; seac[lane] = __expf(x); sdd[lane] = __expf(last - x) * dtv; if (lane == 63) sdec[0] = __expf(x);
        }
#pragma unroll
        for (int i = 0; i < 4; ++i)
#pragma unroll
            for (int j = 0; j < 4; ++j) Hb[(pt * 16 + quad * 4 + j) * 136 + (ntb + i) * 16 + l16] = f2bf(hacc[i][j]);
        if (ch < 31) SSD_PREFETCH(ch + 1);
        bar_lds();
        {
            const int p = tid >> 3, s8 = (tid & 7) * 8;
            const u32x4 w = *(const LAS u32x4*)(XT + p * 72 + s8); u32x4 o;
#pragma unroll
            for (int q = 0; q < 4; ++q) o[q] = cvt_pk_bf16(bflo(w[q]) * sdd[s8 + 2 * q], bfhi(w[q]) * sdd[s8 + 2 * q + 1]);
            *(LAS u32x4*)(XTd + p * 72 + s8) = o;
        }
#pragma unroll
        for (int tt = 0; tt < 2; ++tt) {
            const int tile = wid * 2 + tt, lt = tile >> 2, st = tile & 3;
            f32x4 acc = {0.f, 0.f, 0.f, 0.f};
            if (st <= lt) {
#pragma unroll
                for (int kk = 0; kk < 4; ++kk) acc = mfma16(*(const LAS bf16x8*)(Cb + (lt * 16 + l16) * 136 + kk * 32 + quad * 8), *(const LAS bf16x8*)(Bb + (st * 16 + l16) * 136 + kk * 32 + quad * 8), acc);
            }
            const int s = st * 16 + l16; const float as = sac[s], ds = sdt[s];
#pragma unroll
            for (int j = 0; j < 4; ++j) { const int l = lt * 16 + quad * 4 + j; const float v = (s <= l) ? acc[j] * __expf(fminf(sac[l] - as, 0.f)) * ds : 0.f; Mb[l * 72 + s] = f2bf(v); }
        }
        bar_lds();
#pragma unroll
        for (int tt = 0; tt < 2; ++tt) {
            const int tile = wid * 2 + tt, lt = tile >> 2, pc = tile & 3;
            f32x4 acc = {0.f, 0.f, 0.f, 0.f};
#pragma unroll
            for (int kk = 0; kk < 4; ++kk) acc = mfma16(*(const LAS bf16x8*)(Cb + (lt * 16 + l16) * 136 + kk * 32 + quad * 8), *(const LAS bf16x8*)(Hb + (pc * 16 + l16) * 136 + kk * 32 + quad * 8), acc);
#pragma unroll
            for (int j = 0; j < 4; ++j) acc[j] *= seac[lt * 16 + quad * 4 + j];
#pragma unroll
            for (int kk = 0; kk < 2; ++kk) acc = mfma16(*(const LAS bf16x8*)(Mb + (lt * 16 + l16) * 72 + kk * 32 + quad * 8), *(const LAS bf16x8*)(XT + (pc * 16 + l16) * 72 + kk * 32 + quad * 8), acc);
            const int p = pc * 16 + l16;
#pragma unroll
            for (int j = 0; j < 4; ++j) {
                const int l = lt * 16 + quad * 4 + j;
                const float yv = acc[j] + dsk * bf2f(XT[p * 72 + l]);
                bf16_t* zp = Z + (row0 + l) * 2048 + hd * 64 + p;
                const float z = bf2f(zq[tt][j]), yg = yv * z * sigm(z);
                *zp = f2bf(yg);
                const float sq = red16(yg * yg);
                if (l16 == 0) atomicAdd(ssq + (row0 + l) * 8 + g, sq);
            }
        }
        {
            const float dec = sdec[0];
#pragma unroll
            for (int i = 0; i < 4; ++i) {
                hacc[i] = hacc[i] * dec;
#pragma unroll
                for (int kk = 0; kk < 2; ++kk) hacc[i] = mfma16(*(const LAS bf16x8*)(XTd + (pt * 16 + l16) * 72 + kk * 32 + quad * 8), *(const LAS bf16x8*)(BT + ((ntb + i) * 16 + l16) * 72 + kk * 32 + quad * 8), hacc[i]);
            }
        }
        bar_lds();
    }
#pragma unroll
    for (int i = 0; i < 4; ++i)
#pragma unroll
        for (int j = 0; j < 4; ++j) a->out[O_SSMP + ((size_t)(b * 32 + hd) * 64 + pt * 16 + quad * 4 + j) * 128 + (ntb + i) * 16 + l16] = hacc[i][j];
}

__device__ __forceinline__ float conv1_(KA a, const bf16_t* XBC, int b, size_t row, int col) {
    const float* sc = a->in[I_SCONV] + (size_t)b * 12288 + col;
    const float v = a->in[I_CONVB][col] + a->in[I_CONVW][col] * sc[0] + a->in[I_CONVW][4096 + col] * sc[4096] + a->in[I_CONVW][8192 + col] * sc[8192] + a->in[I_CONVW][12288 + col] * bf2f(XBC[row * 4096 + col]);
    return v * sigm(v);
}
__device__ __forceinline__ void ssd_sample_wave(KA a, LAS float* wl, int b, int hd) {
    const int lane = tidx() & 63, g = hd >> 2;
    const bf16_t* XBC = (const bf16_t*)(a->ws + W_XBC); const float* DT = (const float*)(a->ws + W_DT); bf16_t* Z = (bf16_t*)a->out; float* ssq = (float*)(a->ws + W_SSQ);
    const size_t row = (size_t)NPR + b;
    const float xv = conv1_(a, XBC, b, row, hd * 64 + lane);
    wl[lane] = conv1_(a, XBC, b, row, 2048 + g * 128 + lane); wl[64 + lane] = conv1_(a, XBC, b, row, 2048 + g * 128 + 64 + lane);
    wl[128 + lane] = conv1_(a, XBC, b, row, 3072 + g * 128 + lane); wl[192 + lane] = conv1_(a, XBC, b, row, 3072 + g * 128 + 64 + lane);
    const float dtv = softplusf_(DT[row * 32 + hd] + a->in[I_DTB][hd]), dA = __expf(-__expf(a->in[I_ALOG][hd]) * dtv), xdt = dtv * xv;
    const size_t so = ((size_t)(b * 32 + hd) * 64 + lane) * 128;
    float y = 0.f;
#pragma unroll 8
    for (int q = 0; q < 32; ++q) {
        f32x4 hv = *(const f32x4*)(a->in[I_SSSM] + so + q * 4); const f32x4 Bv = *(const LAS f32x4*)(wl + q * 4), Cv = *(const LAS f32x4*)(wl + 128 + q * 4);
        hv = hv * dA + Bv * xdt; y += hv[0] * Cv[0] + hv[1] * Cv[1] + hv[2] * Cv[2] + hv[3] * Cv[3];
        *(f32x4*)(a->out + O_SSMS + so + q * 4) = hv;
    }
    const float yv = y + a->in[I_DSKIP][hd] * xv;
    bf16_t* zp = Z + row * 2048 + hd * 64 + lane; const float z = bf2f(*zp), yg = yv * z * sigm(z);
    *zp = f2bf(yg);
    const float sq = red64(yg * yg);
    if (lane == 0) atomicAdd(ssq + row * 8 + g, sq);
}

__device__ __forceinline__ void phase_mix(KA a, LAS unsigned char* lds) {
    const int tid = tidx(), nW = gridDim.x, wg = blockIdx.x;
    const bf16_t* XBC = (const bf16_t*)(a->ws + W_XBC);
    const int half = nW / 2;
    if (wg < half) {
        for (int it = wg; it < 128; it += half) rwkv_prompt_item(a, lds, it >> 4, it & 15);
        bar();
        const int gw = wg * 8 + (tid >> 6), ngw = half * 8; LAS float* wl = (LAS float*)(lds + (tid >> 6) * 4096);
        for (int it = gw; it < 2048; it += ngw) rwkv_sample_wave(a, wl, it >> 4, it & 15);
    }
    else {
        const int w = wg - half, ns = nW - half;
        for (size_t i = (size_t)w * 512 + tid; i < (size_t)8 * 3 * 4096; i += (size_t)ns * 512) { const int c = (int)(i & 4095), j = (int)((i >> 12) % 3), b = (int)(i / 12288); a->out[O_CONVP + i] = bf2f(XBC[((size_t)b * 2048 + 2045 + j) * 4096 + c]); }
        for (size_t i = (size_t)w * 512 + tid; i < (size_t)128 * 3 * 4096; i += (size_t)ns * 512) { const int c = (int)(i & 4095), j = (int)((i >> 12) % 3), b = (int)(i / 12288);
            a->out[O_CONVS + i] = j < 2 ? a->in[I_SCONV][(size_t)b * 12288 + (j + 1) * 4096 + c] : bf2f(XBC[((size_t)NPR + b) * 4096 + c]); }
        {
            const int gw = w * 8 + (tid >> 6), ngw = ns * 8; LAS float* wl = (LAS float*)(lds + (tid >> 6) * 4096);
            for (int it = gw; it < 4096; it += ngw) ssd_sample_wave(a, wl, it >> 5, it & 31);
        }
        bar();
        for (int it = w; it < 256; it += ns) ssd_prompt_item(a, lds, it >> 5, it & 31);
    }
}

__device__ __forceinline__ void phase_ssdnorm(KA a) {
    u32x4* Z = (u32x4*)a->out; const float* ssq = (const float*)(a->ws + W_SSQ);
    for (size_t i = (size_t)blockIdx.x * 512 + tidx(); i < (size_t)T * 256; i += (size_t)gridDim.x * 512) {
        const size_t row = i >> 8; const int gi = (int)(i & 255) >> 5;
        const float rs = rsqrtf(ssq[row * 8 + gi] * (1.0f / 256.0f) + EPS);
        u32x4 w = Z[i];
#pragma unroll
        for (int q = 0; q < 4; ++q) w[q] = cvt_pk_bf16(bflo(w[q]) * rs, bfhi(w[q]) * rs);
        Z[i] = w;
    }
}

__device__ __forceinline__ unsigned f2key(float f) { const unsigned u = __float_as_uint(f); return (u & 0x80000000u) ? ~u : (u | 0x80000000u); }
__device__ __forceinline__ float key2f(unsigned k) { return __uint_as_float((k & 0x80000000u) ? (k & 0x7fffffffu) : ~k); }
#define TOPK_INSERT(top, x) do { _Pragma("unroll") for (int _q = 0; _q < 16; ++_q) { const unsigned _hi = max(top[_q], x); x = min(top[_q], x); top[_q] = _hi; } } while (0)

__device__ __forceinline__ void phase_peer(KA a, LAS unsigned char* lds) {
    const int tid = tidx(), lane = tid & 63, wid = tid >> 6, quad = lane >> 4, l16 = lane & 15;
    LAS float* S = (LAS float*)lds;
    LAS unsigned* TK = (LAS unsigned*)(lds + 132096);
    LAS int* EI = (LAS int*)lds;
    LAS float* EG = (LAS float*)(lds + 8192);
    const bf16_t* Q = (const bf16_t*)(a->ws + W_Q); const bf16_t* K12 = (const bf16_t*)(a->ws + W_K12);
    const unsigned char* PUq = a->ws + W_PU; const unsigned char* PVq = a->ws + W_PV; const float* PUS = (const float*)(a->ws + W_PU + 16777216); const float* PVS = (const float*)(a->ws + W_PV + 16777216);
    const bf16_t* X1B = (const bf16_t*)(a->ws + W_X1B); bf16_t* X2B = (bf16_t*)(a->ws + W_X2B);
    const float* ss1 = (const float*)(a->ws + W_SS) + TP; float* ss2 = (float*)(a->ws + W_SS) + 2 * TP;
    const int t_beg = (int)(((long)blockIdx.x * T) / gridDim.x), t_end = (int)(((long)(blockIdx.x + 1) * T) / gridDim.x);
    for (int tb = t_beg; tb < t_end; tb += 16) {
        const size_t tok0 = (size_t)tb; const int nt = (t_end - tb) < 16 ? (t_end - tb) : 16;
#pragma unroll 1
        for (int hq = 0; hq < 2; ++hq) {
            const int hh = wid * 2 + hq;
            bf16x8 af[4];
#pragma unroll
            for (int kk = 0; kk < 4; ++kk) af[kk] = *(const bf16x8*)(Q + (tok0 + (l16 < nt ? l16 : nt - 1)) * 2048 + hh * 128 + kk * 32 + quad * 8);
#pragma unroll 2
            for (int nt = 0; nt < 8; ++nt) {
                f32x4 acc = {0.f, 0.f, 0.f, 0.f};
#pragma unroll
                for (int kk = 0; kk < 4; ++kk) acc = mfma16(af[kk], *(const bf16x8*)(K12 + ((size_t)hh * 128 + nt * 16 + l16) * 128 + kk * 32 + quad * 8), acc);
#pragma unroll
                for (int j = 0; j < 4; ++j) S[((quad * 4 + j) * 16 + hh) * 129 + nt * 16 + l16] = acc[j];
            }
        }
        bar();
        if (tid < 256) {
            unsigned top[16];
#pragma unroll
            for (int q = 0; q < 16; ++q) top[q] = 0u;
            for (int i = 0; i < 128; ++i) { unsigned x = (f2key(S[tid * 129 + i]) & ~127u) | (unsigned)(127 - i); TOPK_INSERT(top, x); }
#pragma unroll
            for (int q = 0; q < 16; ++q) TK[tid * 16 + q] = top[q];
        }
        bar();
        if (tid < 128) {
            const int t = tid >> 3, head = tid & 7, r1 = (t * 16 + head * 2) * 16, r2 = r1 + 16;
            float f1[16], f2[16];
#pragma unroll
            for (int q = 0; q < 16; ++q) { f1[q] = key2f(TK[r1 + q]); f2[q] = key2f(TK[r2 + q]); }
            unsigned top[16];
#pragma unroll
            for (int q = 0; q < 16; ++q) top[q] = 0u;
#pragma unroll
            for (int i = 0; i < 16; ++i)
#pragma unroll
                for (int j = 0; j < 16; ++j)
                    if ((i + 1) * (j + 1) <= 16) { unsigned x = (f2key(f1[i] + f2[j]) & ~255u) | (unsigned)(255 - (i * 16 + j)); TOPK_INSERT(top, x); }
            float sv[16]; int id[16]; float mx = -3.0e38f;
#pragma unroll
            for (int q = 0; q < 16; ++q) {
                const int pos = 255 - (int)(top[q] & 255u), i = pos >> 4, j = pos & 15;
                const unsigned k1 = TK[r1 + i], k2 = TK[r2 + j];
                sv[q] = key2f(k1) + key2f(k2); id[q] = (127 - (int)(k1 & 127u)) * 128 + (127 - (int)(k2 & 127u)); mx = fmaxf(mx, sv[q]);
            }
            float den = 0.f;
#pragma unroll
            for (int q = 0; q < 16; ++q) { sv[q] = __expf(sv[q] - mx); den += sv[q]; }
            const float rden = 1.0f / den;
#pragma unroll
            for (int q = 0; q < 16; ++q) { EI[t * 128 + head * 16 + q] = id[q]; EG[t * 128 + head * 16 + q] = sv[q] * rden; }
        }
        bar();
#pragma unroll 1
        for (int tq = 0; tq < 2; ++tq) {
            const int tt = wid * 2 + tq; const size_t tok = tok0 + tt;
            if (tt >= nt) continue;
            const u32x4 xa = *(const u32x4*)(X1B + tok * 1024 + lane * 16), xb = *(const u32x4*)(X1B + tok * 1024 + lane * 16 + 8);
            f32x2 xf[8];
#pragma unroll
            for (int q = 0; q < 4; ++q) { xf[q] = (f32x2){bflo(xa[q]), bfhi(xa[q])}; xf[4 + q] = (f32x2){bflo(xb[q]), bfhi(xb[q])}; }
            const float rs = rsqrtf(ss1[tok] * (1.0f / 1024.0f) + EPS);
            f32x2 out2[8];
#pragma unroll
            for (int q = 0; q < 8; ++q) out2[q] = (f32x2){0.f, 0.f};
#pragma unroll 1
            for (int hf = 0; hf < 2; ++hf) {
                float dl = 0.f;
#pragma unroll 1
                for (int e0 = 0; e0 < 64; e0 += 8) {
                    u32x4 w[8]; float rsc[8];
#pragma unroll
                    for (int u = 0; u < 8; ++u) { const int idx = __builtin_amdgcn_readfirstlane(EI[tt * 128 + hf * 64 + e0 + u]); w[u] = *(const u32x4*)(PUq + (size_t)idx * 1024 + lane * 16); rsc[u] = PUS[idx]; }
#pragma unroll
                    for (int u = 0; u < 8; ++u) {
                        f32x2 acc = {0.f, 0.f};
#pragma unroll
                        for (int q = 0; q < 4; ++q) { acc += xf[2 * q] * __builtin_amdgcn_cvt_pk_f32_fp8((int)w[u][q], false); acc += xf[2 * q + 1] * __builtin_amdgcn_cvt_pk_f32_fp8((int)w[u][q], true); }
                        const float d = red64(acc.x + acc.y) * rsc[u];
                        dl = (lane == e0 + u) ? d : dl;
                    }
                }
                const float z = dl * rs, act = 0.5f * z * (1.0f + erff(z * 0.70710678f));
                const float cl = EG[tt * 128 + hf * 64 + lane] * act;
#pragma unroll 1
                for (int e0 = 0; e0 < 64; e0 += 8) {
                    u32x4 w[8]; float cc[8];
#pragma unroll
                    for (int u = 0; u < 8; ++u) { const int idx = __builtin_amdgcn_readfirstlane(EI[tt * 128 + hf * 64 + e0 + u]); w[u] = *(const u32x4*)(PVq + (size_t)idx * 1024 + lane * 16);
                        cc[u] = __int_as_float(__builtin_amdgcn_readlane(__float_as_int(cl), e0 + u)) * PVS[idx]; }
#pragma unroll
                    for (int u = 0; u < 8; ++u) { const f32x2 c2 = {cc[u], cc[u]};
#pragma unroll
                        for (int q = 0; q < 4; ++q) { out2[2 * q] += c2 * __builtin_amdgcn_cvt_pk_f32_fp8((int)w[u][q], false); out2[2 * q + 1] += c2 * __builtin_amdgcn_cvt_pk_f32_fp8((int)w[u][q], true); } }
                }
            }
            float out[16];
#pragma unroll
            for (int q = 0; q < 8; ++q) { out[2 * q] = out2[q].x; out[2 * q + 1] = out2[q].y; }
            const float* xr = a->out + tok * 1024 + lane * 16; float* xw = (float*)(a->ws + W_P1) + tok * 1024 + lane * 16; float sq = 0.f; unsigned pk[8];
#pragma unroll
            for (int q = 0; q < 4; ++q) { f32x4 v = *(const f32x4*)(xr + q * 4);
#pragma unroll
                for (int j = 0; j < 4; ++j) { v[j] += out[q * 4 + j]; sq += v[j] * v[j]; }
                *(f32x4*)(xw + q * 4) = v; pk[2 * q] = cvt_pk_bf16(v[0], v[1]); pk[2 * q + 1] = cvt_pk_bf16(v[2], v[3]); }
            *(u32x4*)(X2B + tok * 1024 + lane * 16) = (u32x4){pk[0], pk[1], pk[2], pk[3]}; *(u32x4*)(X2B + tok * 1024 + lane * 16 + 8) = (u32x4){pk[4], pk[5], pk[6], pk[7]};
            sq = red64(sq);
            if (lane == 0) ss2[tok] = sq;
        }
        bar();
    }
}

__device__ __forceinline__ void phase_final(KA a) {
    f32x4* X = (f32x4*)a->out; const float* ss3 = (const float*)(a->ws + W_SS) + 3 * TP; const f32x4* gn = (const f32x4*)a->in[I_NFIN];
    for (size_t i = (size_t)blockIdx.x * 512 + tidx(); i < (size_t)T * 256; i += (size_t)gridDim.x * 512) {
        const float rs = rsqrtf(ss3[i >> 8] * (1.0f / 1024.0f) + EPS);
        X[i] = X[i] * rs * gn[i & 255];
    }
}

__global__ void __launch_bounds__(512) hybrid_fwd(Args a_unused) {
    extern __shared__ __attribute__((aligned(16))) unsigned char lds_raw[];
    LAS unsigned char* lds = (LAS unsigned char*)lds_raw;
    cg::grid_group grid = cg::this_grid();
    KA a = (KA)__builtin_amdgcn_kernarg_segment_ptr();
    unsigned char* ws = a->ws;
    float* ss = (float*)(ws + W_SS);
    const int ph_lo = a->ph_lo, ph_hi = a->ph_hi;
#ifndef PROBE_REP
#define PROBE_REP 0
#endif
    unsigned* barcnt = (unsigned*)(ws + W_BAR); unsigned nbar = 0;
    if (ph_hi > 1000) grid.sync();
#define GRID_SYNC() do { ++nbar; grid_barrier(barcnt, nbar); } while (0)
#define PH_BEGIN(k) if (ph_lo <= (k) && (k) < ph_hi) { if ((k) > ph_lo) GRID_SYNC(); for (int rep_ = 0; rep_ < 1 + ((PROBE_REP >> (k)) & 1); ++rep_) { if (rep_) GRID_SYNC();
#define PH_END } }
    PH_BEGIN(0)  phase_prep(a, lds); PH_END
    PH_BEGIN(1)  { EpiU E; E.Z = (bf16_t*)a->out; E.XBC = (bf16_t*)(ws + W_XBC); E.RW = (bf16_t*)(ws + W_RW); E.G = (bf16_t*)(ws + W_G); E.DT = (float*)(ws + W_DT); E.ss0 = ss;
                  run_gemm<EpiU, false>(lds, (const bf16_t*)(ws + W_XB), 1024, (const bf16_t*)(ws + W_WIN), 1024, NU, 1024, E); } PH_END
    PH_BEGIN(2)  phase_mix(a, lds); PH_END
    PH_BEGIN(3)  phase_ssdnorm(a); PH_END
    PH_BEGIN(4)  { EpiMix<0> E0; E0.P = (float*)(ws + W_P1); E0.V = nullptr; E0.G = (const bf16_t*)(ws + W_G); E0.goff = 0;
                  run_gemm(lds, (const bf16_t*)a->out, 2048, (const bf16_t*)(ws + W_WOS), 2048, 1024, 2048, E0);
                  __threadfence(); __syncthreads();
                  EpiMix<1> E1; E1.P = (float*)(ws + W_P1); E1.V = (bf16_t*)(ws + W_V); E1.G = (const bf16_t*)(ws + W_G); E1.goff = 1024;
                  run_gemm(lds, (const bf16_t*)(ws + W_RW), 3328, (const bf16_t*)(ws + W_WOR), 1024, 1024, 1024, E1); } PH_END
    PH_BEGIN(5)  { EpiRes<0> E; E.xp = a->in[I_XP]; E.xs = a->in[I_XS]; E.X = a->out; E.XB = (bf16_t*)(ws + W_X1B); E.ss = ss + TP; E.ssin = nullptr; E.P = nullptr;
                  run_gemm(lds, (const bf16_t*)(ws + W_V), 1024, (const bf16_t*)(ws + W_WO), 1024, 1024, 1024, E); } PH_END
    PH_BEGIN(6)  { EpiQ E; E.O = (bf16_t*)(ws + W_Q); E.ld = 2048; E.ss = ss + TP;
                  run_gemm(lds, (const bf16_t*)(ws + W_X1B), 1024, (const bf16_t*)(ws + W_WQ), 1024, 2048, 1024, E); } PH_END
    PH_BEGIN(7)  phase_peer(a, lds); PH_END
    PH_BEGIN(8)  { EpiMix<2> E0; E0.P = (float*)(ws + W_PP); E0.V = nullptr; E0.G = nullptr; E0.goff = 0;
                  run_gemm(lds, (const bf16_t*)(ws + W_PB), 256, (const bf16_t*)(ws + W_WPP), 256, 1024, 256, E0);
                  __threadfence(); __syncthreads();
                  EpiRes<1> E; E.xp = (const float*)(ws + W_P1); E.xs = nullptr; E.X = a->out; E.XB = nullptr; E.ss = ss + 3 * TP; E.ssin = ss + 2 * TP; E.P = (const float*)(ws + W_PP);
                  run_gemm(lds, (const bf16_t*)(ws + W_X2B), 1024, (const bf16_t*)(ws + W_WPG), 1024, 1024, 1024, E); } PH_END
    PH_BEGIN(9) phase_final(a); PH_END
}

extern "C" void kernel_launch(void* const* d_in, const int* in_sizes, int n_in, void* d_out, int out_size, void* d_ws, size_t ws_size, hipStream_t stream) {
    static int grid = 0;
    if (grid == 0) {
        if (n_in != 40 || (size_t)out_size != O_END || ws_size < W_TOTAL) { fprintf(stderr, "kernel_launch: unexpected shapes: n_in %d out %d ws %zu (need %zu)\n", n_in, out_size, ws_size, (size_t)W_TOTAL); grid = -1; return; }
        int dev = 0, cus = 0, per_cu = 0;
        hipGetDevice(&dev); hipDeviceGetAttribute(&cus, hipDeviceAttributeMultiprocessorCount, dev);
        if (hipFuncSetAttribute((const void*)hybrid_fwd, hipFuncAttributeMaxDynamicSharedMemorySize, LDS_BYTES) != hipSuccess) { fprintf(stderr, "kernel_launch: hipFuncSetAttribute failed\n"); grid = -1; return; }
        if (hipOccupancyMaxActiveBlocksPerMultiprocessor(&per_cu, (const void*)hybrid_fwd, 512, LDS_BYTES) != hipSuccess || per_cu < 1) { fprintf(stderr, "kernel_launch: occupancy query says %d\n", per_cu); per_cu = 1; }
        (void)hipGetLastError();
        grid = cus * 1;
        if (grid > 256) grid = 256;
    }
    if (grid < 0) return;
    (void)hipMemsetAsync((unsigned char*)d_ws + W_BAR, 0, 4096, stream);
    Args a{};
    for (int i = 0; i < 40; ++i) a.in[i] = (const float*)d_in[i];
    a.out = (float*)d_out; a.ws = (unsigned char*)d_ws;
#if MULTI_LAUNCH
    for (int ph = 0; ph < NPHASE; ++ph) { a.ph_lo = ph; a.ph_hi = ph + 1; hipLaunchKernelGGL(hybrid_fwd, dim3(grid), dim3(512), LDS_BYTES, stream, a); }
#else
    a.ph_lo = 0; a.ph_hi = NPHASE;
    void* args[] = {&a};
    hipError_t e = hipLaunchCooperativeKernel((const void*)hybrid_fwd, dim3(grid), dim3(512), args, LDS_BYTES, stream);
    if (e != hipSuccess) fprintf(stderr, "kernel_launch: cooperative launch failed: %s (grid %d)\n", hipGetErrorString(e), grid);
#endif
}
```
